# Optimizing an MI355X kernel written in HIP

```python
import math
import jax, jax.numpy as jnp
from jax import lax
import numpy as np

D_MODEL = 1024
BATCH = 4
SEQ = 8192
DEPTH = 2

N_A_LAYERS = DEPTH // 2
N_B_LAYERS = DEPTH - N_A_LAYERS
N_HEADS = 16
HEAD_DIM = 64
N_KV_GROUPS = 4
HEADS_PER_GROUP = N_HEADS // N_KV_GROUPS
D_FF = 4 * D_MODEL
CONV_WIDTH = 3
CMP_BLOCK = 32
CMP_STRIDE = 16
SEL_BLOCK = 64
SEL_TOP_N = 16
WINDOW = 512
PHI_HIDDEN = 256
N_BUCKETS = 32
MAX_DISTANCE = 128
Q_BLOCK = 128
EPS = 1e-6
NEG_INF = -1e30
FORCED_SCORE = 1e9

kernel_name = "yoco_shortconv_nsa_hybrid"


def rms_norm(x, g):
    xf = x.astype(jnp.float32)
    y = xf * lax.rsqrt(jnp.mean(xf * xf, axis=-1, keepdims=True) + EPS)
    return (y * g.astype(jnp.float32)).astype(x.dtype)


def t5_bucket(dist):
    dist = jnp.maximum(dist, 0)
    max_exact = N_BUCKETS // 2
    logd = jnp.log(jnp.maximum(dist, 1).astype(jnp.float32) / max_exact)
    large = max_exact + (logd / math.log(MAX_DISTANCE / max_exact)
                         * (N_BUCKETS - max_exact)).astype(jnp.int32)
    large = jnp.minimum(large, N_BUCKETS - 1)
    return jnp.where(dist < max_exact, dist, large)


def short_conv_mixer(h, w_in, conv_w, w_out):
    S = h.shape[1]
    b_gate, c_gate, u = jnp.split(h @ w_in, 3, axis=-1)
    v = c_gate * u
    vp = jnp.pad(v, ((0, 0), (CONV_WIDTH - 1, 0), (0, 0)))
    conv = sum(conv_w[k] * vp[:, k:k + S] for k in range(CONV_WIDTH))
    return (b_gate * conv) @ w_out


def squared_relu_mlp(h, w1, w2):
    return jnp.square(jax.nn.relu(h @ w1)) @ w2


def compress_blocks(t, pe, w1, w2):
    B, S, G, dh = t.shape
    chunks = t.reshape(B, S // CMP_STRIDE, CMP_STRIDE, G, dh)
    blocks = jnp.concatenate([chunks[:, :-1], chunks[:, 1:]], axis=2)
    blocks = blocks + pe[None, None, :, None, :]
    n_cmp = blocks.shape[1]
    flat = jnp.moveaxis(blocks, 2, 3).reshape(B, n_cmp, G, CMP_BLOCK * dh)
    return jax.nn.silu(flat @ w1) @ w2


def nsa_shared_kv(h, w_kv, cmp_pe_k, cmp_pe_v, phi_k_w1, phi_k_w2, phi_v_w1, phi_v_w2):
    B, S, _ = h.shape
    kv = (h @ w_kv).reshape(B, S, 6, N_KV_GROUPS, HEAD_DIM)
    k_raw, v_raw = kv[:, :, 0], kv[:, :, 1]
    k_sel, v_sel = kv[:, :, 2], kv[:, :, 3]
    k_win, v_win = kv[:, :, 4], kv[:, :, 5]
    k_cmp = compress_blocks(k_raw, cmp_pe_k, phi_k_w1, phi_k_w2)
    v_cmp = compress_blocks(v_raw, cmp_pe_v, phi_v_w1, phi_v_w2)
    return (k_cmp, v_cmp, k_sel, v_sel, k_win, v_win)


def nsa_attention(q, gates, k_cmp, v_cmp, k_sel, v_sel, k_win, v_win, rel_bias):
    B, S, G, Hg, dh = q.shape
    n_cmp = k_cmp.shape[1]
    n_selb = S // SEL_BLOCK
    top_n = min(SEL_TOP_N, n_selb)
    n_qb = S // Q_BLOCK
    bias_g = rel_bias.reshape(N_BUCKETS, G, Hg)

    cmp_end = jnp.arange(n_cmp) * CMP_STRIDE + CMP_BLOCK - 1
    ratio = SEL_BLOCK // CMP_STRIDE
    span = CMP_BLOCK // CMP_STRIDE
    offs = (jnp.arange(ratio)[:, None] - jnp.arange(span)[None, :]).reshape(-1)
    map_idx = ratio * jnp.arange(n_selb)[:, None] + offs[None, :]
    map_ok = (map_idx >= 0) & (map_idx < n_cmp)
    map_idx = jnp.clip(map_idx, 0, n_cmp - 1)

    k_sel_bg = jnp.transpose(k_sel.reshape(B, n_selb, SEL_BLOCK, G, dh), (0, 3, 1, 2, 4))
    v_sel_bg = jnp.transpose(v_sel.reshape(B, n_selb, SEL_BLOCK, G, dh), (0, 3, 1, 2, 4))
    k_win_p = jnp.pad(k_win, ((0, 0), (WINDOW, 0), (0, 0), (0, 0)))
    v_win_p = jnp.pad(v_win, ((0, 0), (WINDOW, 0), (0, 0), (0, 0)))
    b_ix = jnp.arange(B)[:, None, None, None]
    g_ix = jnp.arange(G)[None, None, :, None]
    jb = jnp.arange(n_selb)

    def one_block(qb):
        t0 = qb * Q_BLOCK
        qt = lax.dynamic_slice_in_dim(q, t0, Q_BLOCK, axis=1)
        gt = lax.dynamic_slice_in_dim(gates, t0, Q_BLOCK, axis=1)
        pos = t0 + jnp.arange(Q_BLOCK)

        d_c = pos[:, None] - cmp_end[None, :]
        valid_c = d_c >= 0
        bias_c = jnp.transpose(bias_g[t5_bucket(d_c)], (0, 2, 3, 1)).astype(jnp.float32)
        logit_c = jnp.einsum('bqghd,bngd->bqghn', qt, k_cmp).astype(jnp.float32) + bias_c[None]
        logit_c = jnp.where(valid_c[None, :, None, None, :], logit_c, NEG_INF)
        has_any = jnp.any(valid_c, axis=-1).astype(jnp.float32)
        p_c = jax.nn.softmax(logit_c, axis=-1) * has_any[None, :, None, None, None]
        o_c = jnp.einsum('bqghn,bngd->bqghd', p_c.astype(v_cmp.dtype), v_cmp)

        imp = p_c.sum(axis=3)
        imp_s = jnp.sum(jnp.where(map_ok, jnp.take(imp, map_idx, axis=-1), 0.0), axis=-1)
        cb = pos // SEL_BLOCK
        forced = (jb[None, :] == 0) | (jb[None, :] == cb[:, None]) | (jb[None, :] == cb[:, None] - 1)
        future = jb[None, :] > cb[:, None]
        score = jnp.where(forced[None, :, None, :], FORCED_SCORE, imp_s)
        score = jnp.where(future[None, :, None, :], NEG_INF, score)
        top_s, top_idx = lax.top_k(score, top_n)
        blk_ok = top_s > NEG_INF * 0.5

        ks = k_sel_bg[b_ix, g_ix, top_idx].reshape(B, Q_BLOCK, G, top_n * SEL_BLOCK, dh)
        vs = v_sel_bg[b_ix, g_ix, top_idx].reshape(B, Q_BLOCK, G, top_n * SEL_BLOCK, dh)
        kpos = (top_idx[..., None] * SEL_BLOCK + jnp.arange(SEL_BLOCK)).reshape(B, Q_BLOCK, G, -1)
        blk_ok_k = jnp.repeat(blk_ok, SEL_BLOCK, axis=-1)
        d_s = pos[None, :, None, None] - kpos
        valid_s = blk_ok_k & (d_s >= 0)
        bias_s = jnp.transpose(bias_g[t5_bucket(d_s), g_ix], (0, 1, 2, 4, 3)).astype(jnp.float32)
        logit_s = jnp.einsum('bqghd,bqgkd->bqghk', qt, ks).astype(jnp.float32) + bias_s
        logit_s = jnp.where(valid_s[:, :, :, None, :], logit_s, NEG_INF)
        p_s = jax.nn.softmax(logit_s, axis=-1)
        o_s = jnp.einsum('bqghk,bqgkd->bqghd', p_s.astype(vs.dtype), vs)

        kw = lax.dynamic_slice_in_dim(k_win_p, t0, Q_BLOCK + WINDOW, axis=1)
        vw = lax.dynamic_slice_in_dim(v_win_p, t0, Q_BLOCK + WINDOW, axis=1)
        wpos = t0 - WINDOW + jnp.arange(Q_BLOCK + WINDOW)
        d_w = pos[:, None] - wpos[None, :]
        valid_w = (d_w >= 0) & (d_w < WINDOW) & (wpos[None, :] >= 0)
        bias_w = jnp.transpose(bias_g[t5_bucket(d_w)], (0, 2, 3, 1)).astype(jnp.float32)
        logit_w = jnp.einsum('bqghd,bkgd->bqghk', qt, kw).astype(jnp.float32) + bias_w[None]
        logit_w = jnp.where(valid_w[None, :, None, None, :], logit_w, NEG_INF)
        p_w = jax.nn.softmax(logit_w, axis=-1)
        o_w = jnp.einsum('bqghk,bkgd->bqghd', p_w.astype(vw.dtype), vw)

        o = gt[..., 0:1] * o_c + gt[..., 1:2] * o_s + gt[..., 2:3] * o_w
        return o.astype(q.dtype)

    o = lax.map(one_block, jnp.arange(n_qb))
    return jnp.moveaxis(o, 0, 1).reshape(B, S, G, Hg, dh)


def nsa_mixer(h, w_qg, w_o, shared, rel_bias):
    B, S, _ = h.shape
    qg = h @ w_qg
    q = qg[..., :N_HEADS * HEAD_DIM].reshape(B, S, N_KV_GROUPS, HEADS_PER_GROUP, HEAD_DIM)
    q = q * (HEAD_DIM ** -0.5)
    gates = jax.nn.sigmoid(qg[..., N_HEADS * HEAD_DIM:].astype(jnp.float32))
    gates = gates.reshape(B, S, N_KV_GROUPS, HEADS_PER_GROUP, 3)
    k_cmp, v_cmp, k_sel, v_sel, k_win, v_win = shared
    o = nsa_attention(q, gates, k_cmp, v_cmp, k_sel, v_sel, k_win, v_win, rel_bias)
    return o.reshape(B, S, N_HEADS * HEAD_DIM) @ w_o


def setup_inputs(seed: int = 0) -> dict:
    key = jax.random.key(seed)
    ks = jax.random.split(key, 22)
    f32 = jnp.float32
    D, H, G, dh = D_MODEL, N_HEADS, N_KV_GROUPS, HEAD_DIM

    def nrm(k, shape, scale):
        return jax.random.normal(k, shape, f32) * scale

    return {
        "x": nrm(ks[0], (BATCH, SEQ, D), 1.0),
        "rel_bias": nrm(ks[1], (N_BUCKETS, H), 0.5),
        "norm_mix": 1.0 + nrm(ks[2], (DEPTH, D), 0.1),
        "norm_mlp": 1.0 + nrm(ks[3], (DEPTH, D), 0.1),
        "mlp_w1": nrm(ks[4], (DEPTH, D, D_FF), D ** -0.5),
        "mlp_w2": nrm(ks[5], (DEPTH, D_FF, D), 0.5 * D_FF ** -0.5),
        "a_w_in": nrm(ks[6], (N_A_LAYERS, D, 3 * D), D ** -0.5),
        "a_conv_w": nrm(ks[7], (N_A_LAYERS, CONV_WIDTH, D), CONV_WIDTH ** -0.5),
        "a_w_out": nrm(ks[8], (N_A_LAYERS, D, D), D ** -0.5),
        "kv_norm": 1.0 + nrm(ks[9], (D,), 0.1),
        "w_kv": nrm(ks[10], (D, 6 * G * dh), D ** -0.5),
        "cmp_pe_k": nrm(ks[11], (CMP_BLOCK, dh), 0.1),
        "cmp_pe_v": nrm(ks[12], (CMP_BLOCK, dh), 0.1),
        "phi_k_w1": nrm(ks[13], (CMP_BLOCK * dh, PHI_HIDDEN), (CMP_BLOCK * dh) ** -0.5),
        "phi_k_w2": nrm(ks[14], (PHI_HIDDEN, dh), PHI_HIDDEN ** -0.5),
        "phi_v_w1": nrm(ks[15], (CMP_BLOCK * dh, PHI_HIDDEN), (CMP_BLOCK * dh) ** -0.5),
        "phi_v_w2": nrm(ks[16], (PHI_HIDDEN, dh), PHI_HIDDEN ** -0.5),
        "b_w_qg": nrm(ks[17], (N_B_LAYERS, D, H * dh + 3 * H), D ** -0.5),
        "b_w_o": nrm(ks[18], (N_B_LAYERS, H * dh, D), (H * dh) ** -0.5),
        "final_norm": 1.0 + nrm(ks[19], (D,), 0.1),
    }


def reference(x, rel_bias, norm_mix, norm_mlp, mlp_w1, mlp_w2, a_w_in, a_conv_w, a_w_out,
              kv_norm, w_kv, cmp_pe_k, cmp_pe_v, phi_k_w1, phi_k_w2, phi_v_w1, phi_v_w2,
              b_w_qg, b_w_o, final_norm):
    shared = None
    for layer in range(DEPTH):
        h = rms_norm(x, norm_mix[layer])
        if layer < N_A_LAYERS:
            x = x + short_conv_mixer(h, a_w_in[layer], a_conv_w[layer], a_w_out[layer])
        else:
            i = layer - N_A_LAYERS
            x = x + nsa_mixer(h, b_w_qg[i], b_w_o[i], shared, rel_bias)
        x = x + squared_relu_mlp(rms_norm(x, norm_mlp[layer]), mlp_w1[layer], mlp_w2[layer])
        if layer == N_A_LAYERS - 1:
            shared = nsa_shared_kv(rms_norm(x, kv_norm), w_kv, cmp_pe_k, cmp_pe_v,
                                   phi_k_w1, phi_k_w2, phi_v_w1, phi_v_w2)
    return rms_norm(x, final_norm)
```

```cpp
#include <hip/hip_runtime.h>
#include <cstdio>
#include <cstdint>
namespace pg8 {
#define PG8_LAS __attribute__((address_space(3)))
typedef unsigned short bf16_t;
typedef short bf16x8 __attribute__((ext_vector_type(8)));
typedef float f32x4 __attribute__((ext_vector_type(4)));
typedef unsigned u32x4 __attribute__((ext_vector_type(4)));
constexpr int BM = 256, BK = 64, HALF = 128, HTB = HALF * BK * 2  , STAGE_BYTES = 8 * HTB, NXCD = 8, WGM = 8;

__host__ __device__ __forceinline__ int lds_byte(int r, int c) { const int st = (r >> 4) * 2 + (c >> 5), rr = r & 15, cc = c & 31, ob = rr * 64 + cc * 2; return st * 1024 + (ob ^ (((ob >> 9) & 1) << 5)); }
__host__ __device__ __forceinline__ void stage_rc(int b, int& R, int& C) { const int st = b / 1024, sb = b % 1024, swz = sb ^ (((sb >> 9) & 1) << 5); R = (st >> 1) * 16 + swz / 64; C = (st & 1) * 32 + (swz % 64) / 2; }
__host__ __device__ __forceinline__ int perm32(int rho) { const int n = rho >> 4, i = rho & 15; return 8 * (i >> 2) + 4 * n + (i & 3); }

struct Unit { int pm, pn; };
struct Gemm { const bf16_t* A; const bf16_t* Bt; int M, N, K; int a_gather; };

struct StaticOrder {
    int nM, nN, nwg, G, c;
    __host__ __device__ void init(int M, int N, int G_, int c_) { nM = M / BM; nN = N / BM; nwg = nM * nN; G = G_; c = c_; }
    __host__ __device__ bool next(int i, Unit& u) const {
        const long L = (long)i * G + c; if (L >= nwg) return false;
        int wgid = (int)L; { const int q = nwg / NXCD, r = nwg % NXCD, xcd = wgid % NXCD, off = wgid / NXCD; wgid = (xcd < r ? xcd * (q + 1) : r * (q + 1) + (xcd - r) * q) + off; }
        const int nig = WGM * nN, gid = wgid / nig, fm = gid * WGM, gsz = (nM - fm) < WGM ? (nM - fm) : WGM;
        u.pm = fm + ((wgid % nig) % gsz); u.pn = (wgid % nig) / gsz; return true;
    }
    __device__ __forceinline__ void a_ready(const Unit&) const {}
    __device__ __forceinline__ void done(const Unit&) const {}
};

__device__ __forceinline__ unsigned cvt_pk_bf16(float lo, float hi) { unsigned r; asm volatile("v_cvt_pk_bf16_f32 %0, %1, %2" : "=v"(r) : "v"(lo), "v"(hi)); return r; }
typedef float f32x2 __attribute__((ext_vector_type(2)));
typedef unsigned u32x2 __attribute__((ext_vector_type(2)));
constexpr float RMS_EPS = 1e-6f;
__device__ __forceinline__ float row_rstd(const float* ss, int r) { return __builtin_amdgcn_rsqf(ss[r] * (1.0f / 1024.0f) + RMS_EPS); }

struct EpiRes {
    static constexpr bool PERM = false, AFTER_DRAIN = false;
    const float* base; float* out; bf16_t* xb; float* ss;
    __device__ __forceinline__ void operator()(const f32x4 (&acc)[2][2][4][2], const Unit& u, int wr, int wc, int fr, int fq) const {
        const int col0 = u.pn * BM + wc * 32 + 4 * fq;
#pragma unroll
        for (int ai = 0; ai < 2; ++ai)
#pragma unroll
            for (int m = 0; m < 4; ++m) { const int r = u.pm * BM + ai * HALF + wr * 64 + m * 16 + fr; const size_t off = (size_t)r * 1024 + col0; float s = 0.f;
#pragma unroll
                for (int bj = 0; bj < 2; ++bj)
#pragma unroll
                    for (int n = 0; n < 2; ++n) { const f32x4 b = *(const f32x4*)(base + off + bj * HALF + n * 16); const f32x4 o = b + acc[ai][bj][m][n];
                        *(f32x4*)(out + off + bj * HALF + n * 16) = o; s += (o[0] * o[0] + o[1] * o[1]) + (o[2] * o[2] + o[3] * o[3]);
                        if (xb) { u32x2 w; w.x = cvt_pk_bf16(o[0], o[1]); w.y = cvt_pk_bf16(o[2], o[3]); *(u32x2*)(xb + off + bj * HALF + n * 16) = w; } }
                s += __shfl_xor(s, 16); s += __shfl_xor(s, 32);
                if (fq == 0) atomicAdd(ss + r, s); }
    }
};
struct EpiRelu2 {
    static constexpr bool PERM = true, AFTER_DRAIN = false;
    bf16_t* O; int ldc; const float* ss;
    __device__ __forceinline__ void operator()(const f32x4 (&acc)[2][2][4][2], const Unit& u, int wr, int wc, int fr, int fq) const {
        const int col0 = u.pn * BM + wc * 32 + 8 * fq;
#pragma unroll
        for (int ai = 0; ai < 2; ++ai)
#pragma unroll
            for (int m = 0; m < 4; ++m) { const int r = u.pm * BM + ai * HALF + wr * 64 + m * 16 + fr; const float rs = row_rstd(ss, r), s2 = rs * rs; bf16_t* rowp = O + (size_t)r * ldc + col0;
#pragma unroll
                for (int bj = 0; bj < 2; ++bj) { f32x4 v0 = acc[ai][bj][m][0], v1 = acc[ai][bj][m][1];
#pragma unroll
                    for (int j = 0; j < 4; ++j) { const float a = fmaxf(v0[j], 0.f), b = fmaxf(v1[j], 0.f); v0[j] = a * a * s2; v1[j] = b * b * s2; }
                    u32x4 w; w.x = cvt_pk_bf16(v0[0], v0[1]); w.y = cvt_pk_bf16(v0[2], v0[3]); w.z = cvt_pk_bf16(v1[0], v1[1]); w.w = cvt_pk_bf16(v1[2], v1[3]);
                    *(u32x4*)(rowp + bj * HALF) = w; } }
    }
};
struct EpiWin {
    static constexpr bool PERM = true, AFTER_DRAIN = false;
    bf16_t* BG; bf16_t* V; const float* ss;
    __device__ __forceinline__ void operator()(const f32x4 (&acc)[2][2][4][2], const Unit& u, int wr, int wc, int fr, int fq) const {
#pragma unroll
        for (int ai = 0; ai < 2; ++ai)
#pragma unroll
            for (int m = 0; m < 4; ++m) { const int r = u.pm * BM + ai * HALF + wr * 64 + m * 16 + fr; const float rs = row_rstd(ss, r);
                if (u.pn < 4) { bf16_t* rowp = BG + (size_t)r * 1024 + u.pn * BM + wc * 32 + 8 * fq;
#pragma unroll
                    for (int bj = 0; bj < 2; ++bj) { const f32x4 v0 = acc[ai][bj][m][0] * rs, v1 = acc[ai][bj][m][1] * rs;
                        u32x4 w; w.x = cvt_pk_bf16(v0[0], v0[1]); w.y = cvt_pk_bf16(v0[2], v0[3]); w.z = cvt_pk_bf16(v1[0], v1[1]); w.w = cvt_pk_bf16(v1[2], v1[3]);
                        *(u32x4*)(rowp + bj * HALF) = w; }
                } else { bf16_t* rowp = V + (size_t)r * 1024 + (u.pn - 4) * HALF + wc * 32 + 8 * fq; const float s2 = rs * rs;
                    const f32x4 v0 = acc[ai][0][m][0] * acc[ai][1][m][0] * s2, v1 = acc[ai][0][m][1] * acc[ai][1][m][1] * s2;
                    u32x4 w; w.x = cvt_pk_bf16(v0[0], v0[1]); w.y = cvt_pk_bf16(v0[2], v0[3]); w.z = cvt_pk_bf16(v1[0], v1[1]); w.w = cvt_pk_bf16(v1[2], v1[3]);
                    *(u32x4*)rowp = w; } }
    }
};
struct EpiKvq {
    static constexpr bool PERM = true, AFTER_DRAIN = false;
    bf16_t* O; size_t tstride; const float* ss;
    __device__ __forceinline__ void operator()(const f32x4 (&acc)[2][2][4][2], const Unit& u, int wr, int wc, int fr, int fq) const {
        bf16_t* base = O + (size_t)u.pn * tstride + wc * 32 + 8 * fq; const bool sig = (u.pn == 10);
#pragma unroll
        for (int ai = 0; ai < 2; ++ai)
#pragma unroll
            for (int m = 0; m < 4; ++m) { const int r = u.pm * BM + ai * HALF + wr * 64 + m * 16 + fr; const float rs = row_rstd(ss, r); bf16_t* rowp = base + (size_t)r * 256;
#pragma unroll
                for (int bj = 0; bj < 2; ++bj) { f32x4 v0 = acc[ai][bj][m][0] * rs, v1 = acc[ai][bj][m][1] * rs;
                    if (sig) {
#pragma unroll
                        for (int j = 0; j < 4; ++j) { v0[j] = 1.0f / (1.0f + __expf(-v0[j])); v1[j] = 1.0f / (1.0f + __expf(-v1[j])); } }
                    u32x4 w; w.x = cvt_pk_bf16(v0[0], v0[1]); w.y = cvt_pk_bf16(v0[2], v0[3]); w.z = cvt_pk_bf16(v1[0], v1[1]); w.w = cvt_pk_bf16(v1[2], v1[3]);
                    *(u32x4*)(rowp + bj * HALF) = w; } }
    }
};
struct EpiPhi {
    static constexpr bool PERM = true, AFTER_DRAIN = false;
    bf16_t* O; const float* bias;
    __device__ __forceinline__ void operator()(const f32x4 (&acc)[2][2][4][2], const Unit& u, int wr, int wc, int fr, int fq) const {
        const int col0 = wc * 32 + 8 * fq;
        f32x4 bv[2][2];
#pragma unroll
        for (int bj = 0; bj < 2; ++bj)
#pragma unroll
            for (int n = 0; n < 2; ++n) bv[bj][n] = *(const f32x4*)(bias + col0 + bj * HALF + 4 * n);
#pragma unroll
        for (int ai = 0; ai < 2; ++ai)
#pragma unroll
            for (int m = 0; m < 4; ++m) { const int r = u.pm * BM + ai * HALF + wr * 64 + m * 16 + fr; bf16_t* rowp = O + (size_t)r * 256 + col0;
#pragma unroll
                for (int bj = 0; bj < 2; ++bj) { f32x4 v0 = acc[ai][bj][m][0] + bv[bj][0], v1 = acc[ai][bj][m][1] + bv[bj][1];
#pragma unroll
                    for (int j = 0; j < 4; ++j) { v0[j] = v0[j] / (1.0f + __expf(-v0[j])); v1[j] = v1[j] / (1.0f + __expf(-v1[j])); }
                    u32x4 w; w.x = cvt_pk_bf16(v0[0], v0[1]); w.y = cvt_pk_bf16(v0[2], v0[3]); w.z = cvt_pk_bf16(v1[0], v1[1]); w.w = cvt_pk_bf16(v1[2], v1[3]);
                    *(u32x4*)(rowp + bj * HALF) = w; } }
    }
};
struct PhiOrder {
    int c;
    __device__ __forceinline__ bool next(int i, Unit& u) const { if (i > 0 || c >= 64) return false; u.pm = c & 31; u.pn = 0; return true; }
    __device__ __forceinline__ void a_ready(const Unit&) const {}
    __device__ __forceinline__ void done(const Unit&) const {}
};
template <class Epi, class Sched, bool ALIGN_EPI = false, bool SP2 = false>
__device__ __forceinline__ void gemm_phase(PG8_LAS unsigned char* lds, const Gemm g, const Sched& S, const Epi& E) {
    const int tid = threadIdx.x, wid = __builtin_amdgcn_readfirstlane(tid >> 6), lane = tid & 63, wr = wid >> 2, wc = wid & 3, fr = lane & 15, fq = lane >> 4;
    const int K = g.K, nt = K / BK;
    unsigned voffA[2], voffB[2];
#pragma unroll
    for (int i = 0; i < 2; ++i) { int R, C; stage_rc(tid * 16 + i * 8192, R, C); const int Rb = Epi::PERM ? ((R & ~31) + perm32(R & 31)) : R;
        voffA[i] = g.a_gather ? (unsigned)((R >> 2) * 8192 + (R & 3) * 128 + C * 2) : (unsigned)(R * K + C) * 2u; voffB[i] = (unsigned)(Rb * K + C) * 2u; }
    const size_t kstep = (size_t)(BK * 2);
    const size_t hstep = (size_t)HALF * K * 2;
    const size_t tstep = 2 * hstep;
    const size_t kstepA = g.a_gather ? (size_t)512 : kstep, hstepA = g.a_gather ? (size_t)262144 : hstep, tstepA = g.a_gather ? (size_t)524288 : tstep;
    const unsigned ldsw = (unsigned)wid * 1024u;
    const int aoff = lds_byte(wr * 64 + fr, fq * 8), boff = lds_byte(wc * 32 + fr, fq * 8);
#define PG8_SA(b, h) (((b) * 2 + (h)) * HTB)
#define PG8_SB(b, h) ((4 + (b) * 2 + (h)) * HTB)
#define PG8_STAGE(bufoff, gbase, voff) do { _Pragma("unroll") for (int _i = 0; _i < 2; ++_i) \
        __builtin_amdgcn_global_load_lds((const unsigned*)((const char*)(gbase) + (voff)[_i]), (PG8_LAS unsigned*)(lds + (bufoff) + ldsw + _i * 8192), 16, 0, 0); } while (0)
#define PG8_LDA(dst, b, h) do { _Pragma("unroll") for (int m = 0; m < 4; ++m) _Pragma("unroll") for (int k = 0; k < 2; ++k) dst[m][k] = *(const PG8_LAS bf16x8*)(lds + PG8_SA(b, h) + aoff + m * 2048 + k * 1024); } while (0)
#define PG8_LDB(dst, b, h) do { _Pragma("unroll") for (int n = 0; n < 2; ++n) _Pragma("unroll") for (int k = 0; k < 2; ++k) dst[n][k] = *(const PG8_LAS bf16x8*)(lds + PG8_SB(b, h) + boff + n * 2048 + k * 1024); } while (0)
#define PG8_MMA(ai, bj, At, Bt) do { __builtin_amdgcn_s_setprio(1); _Pragma("unroll") for (int m = 0; m < 4; ++m) _Pragma("unroll") for (int n = 0; n < 2; ++n) _Pragma("unroll") for (int k = 0; k < 2; ++k) \
        acc[ai][bj][m][n] = __builtin_amdgcn_mfma_f32_16x16x32_bf16(Bt[n][k], At[m][k], acc[ai][bj][m][n], 0, 0, 0); __builtin_amdgcn_s_setprio(0); } while (0)
#define PG8_WAIT_V(n) asm volatile("s_waitcnt vmcnt(" #n ")" ::: "memory")
#define PG8_WAIT_L(n) asm volatile("s_waitcnt lgkmcnt(" #n ")" ::: "memory")
#define PG8_BAR __builtin_amdgcn_s_barrier()
#define PG8_SCHED __builtin_amdgcn_sched_barrier(0)
    Unit cur, nxt; int ui = 0;
    if (!S.next(0, cur)) return;
    f32x4 acc[2][2][4][2];
#pragma unroll
    for (int a = 0; a < 2; ++a)
#pragma unroll
        for (int b = 0; b < 2; ++b)
#pragma unroll
            for (int m = 0; m < 4; ++m)
#pragma unroll
                for (int n = 0; n < 2; ++n) acc[a][b][m][n] = (f32x4){0.f, 0.f, 0.f, 0.f};
    bf16x8 At[4][2], B0[2][2], B1[2][2];
    const char* cA = (const char*)g.A + (size_t)cur.pm * tstepA; const char* cB = (const char*)g.Bt + (size_t)cur.pn * tstep;
    S.a_ready(cur);
    if constexpr (SP2) {
        PG8_STAGE(PG8_SB(0, 0), cB, voffB); PG8_STAGE(PG8_SB(0, 1), cB + hstep, voffB); PG8_STAGE(PG8_SA(0, 0), cA, voffA); PG8_STAGE(PG8_SA(0, 1), cA + hstepA, voffA);
        if (wr == 1) PG8_BAR;
        PG8_WAIT_V(2); PG8_BAR;
        PG8_STAGE(PG8_SB(1, 0), cB + kstep, voffB); PG8_STAGE(PG8_SA(1, 0), cA + kstepA, voffA); PG8_STAGE(PG8_SB(1, 1), cB + hstep + kstep, voffB);
        PG8_WAIT_V(6); PG8_BAR;
    } else {
        PG8_STAGE(PG8_SB(0, 0), cB, voffB); PG8_STAGE(PG8_SA(0, 0), cA, voffA); PG8_STAGE(PG8_SB(0, 1), cB + hstep, voffB); PG8_STAGE(PG8_SA(0, 1), cA + hstepA, voffA);
        if (wr == 1) PG8_BAR;
        PG8_WAIT_V(4); PG8_BAR;
        PG8_STAGE(PG8_SB(1, 0), cB + kstep, voffB); PG8_STAGE(PG8_SA(1, 0), cA + kstepA, voffA); PG8_STAGE(PG8_SB(1, 1), cB + hstep + kstep, voffB);
        PG8_WAIT_V(6); PG8_BAR;
    }
    for (;;) {
        const bool has_next = S.next(ui + 1, nxt);
        const char* nA = has_next ? (const char*)g.A + (size_t)nxt.pm * tstepA : cA; const char* nB = has_next ? (const char*)g.Bt + (size_t)nxt.pn * tstep : cB;
        for (int t = 0; t < nt; t += 2) {
            const bool last = (t == nt - 2);
            const char* a1 = cA + (size_t)(t + 1) * kstepA;
            const char* a2 = last ? nA : cA + (size_t)(t + 2) * kstepA; const char* b2 = last ? nB : cB + (size_t)(t + 2) * kstep;
            const char* a3 = a2 + kstepA; const char* b3 = b2 + kstep;
            if (last && has_next) S.a_ready(nxt);
            if constexpr (SP2) {
            PG8_LDB(B0, 0, 0); PG8_LDB(B1, 0, 1); PG8_SCHED; PG8_LDA(At, 0, 0); PG8_STAGE(PG8_SA(1, 1), a1 + hstepA, voffA);
            PG8_WAIT_V(8); PG8_WAIT_L(0); PG8_BAR; PG8_MMA(0, 0, At, B0); PG8_MMA(0, 1, At, B1); PG8_BAR; PG8_SCHED;
            PG8_LDA(At, 0, 1); PG8_STAGE(PG8_SB(0, 0), b2, voffB); PG8_STAGE(PG8_SB(0, 1), b2 + hstep, voffB); PG8_STAGE(PG8_SA(0, 0), a2, voffA);
            PG8_WAIT_V(8); PG8_WAIT_L(0); PG8_BAR; PG8_MMA(1, 0, At, B0); PG8_MMA(1, 1, At, B1); PG8_BAR; PG8_SCHED;
            PG8_LDB(B0, 1, 0); PG8_LDB(B1, 1, 1); PG8_SCHED; PG8_LDA(At, 1, 0); PG8_STAGE(PG8_SA(0, 1), a2 + hstepA, voffA);
            PG8_WAIT_V(8); PG8_WAIT_L(0); PG8_BAR; PG8_MMA(0, 0, At, B0); PG8_MMA(0, 1, At, B1); PG8_BAR; PG8_SCHED;
            PG8_LDA(At, 1, 1); PG8_STAGE(PG8_SB(1, 0), b3, voffB); PG8_STAGE(PG8_SB(1, 1), b3 + hstep, voffB); PG8_STAGE(PG8_SA(1, 0), a3, voffA);
            PG8_WAIT_V(8); PG8_WAIT_L(0); PG8_BAR; PG8_MMA(1, 0, At, B0); PG8_MMA(1, 1, At, B1); PG8_BAR; PG8_SCHED;
            } else {
            PG8_LDB(B0, 0, 0); PG8_SCHED; PG8_LDA(At, 0, 0); PG8_STAGE(PG8_SA(1, 1), a1 + hstepA, voffA);
            PG8_WAIT_L(8); PG8_BAR; PG8_WAIT_L(0); PG8_MMA(0, 0, At, B0); PG8_BAR; PG8_SCHED;
            PG8_LDB(B1, 0, 1); PG8_STAGE(PG8_SB(0, 0), b2, voffB);
            PG8_BAR; PG8_WAIT_L(0); PG8_MMA(0, 1, At, B1); PG8_BAR;
            PG8_LDA(At, 0, 1); PG8_STAGE(PG8_SA(0, 0), a2, voffA);
            PG8_BAR; PG8_WAIT_L(0); PG8_MMA(1, 0, At, B0); PG8_BAR; PG8_SCHED;
            PG8_STAGE(PG8_SB(0, 1), b2 + hstep, voffB);
            PG8_WAIT_V(6); PG8_BAR; PG8_MMA(1, 1, At, B1); PG8_BAR;
            PG8_LDB(B0, 1, 0); PG8_SCHED; PG8_LDA(At, 1, 0); PG8_STAGE(PG8_SA(0, 1), a2 + hstepA, voffA);
            PG8_WAIT_L(8); PG8_BAR; PG8_WAIT_L(0); PG8_MMA(0, 0, At, B0); PG8_BAR; PG8_SCHED;
            PG8_LDB(B1, 1, 1); PG8_STAGE(PG8_SB(1, 0), b3, voffB);
            PG8_BAR; PG8_WAIT_L(0); PG8_MMA(0, 1, At, B1); PG8_BAR;
            PG8_LDA(At, 1, 1); PG8_STAGE(PG8_SA(1, 0), a3, voffA);
            PG8_BAR; PG8_WAIT_L(0); PG8_MMA(1, 0, At, B0); PG8_BAR; PG8_SCHED;
            PG8_STAGE(PG8_SB(1, 1), b3 + hstep, voffB);
            PG8_WAIT_V(6); PG8_BAR; PG8_MMA(1, 1, At, B1); PG8_BAR;
            }
        }
        if constexpr (ALIGN_EPI) { if (wr == 0) PG8_BAR; }
        if constexpr (!Epi::AFTER_DRAIN) { E(acc, cur, wr, wc, fr, fq); S.done(cur); }
        if (!has_next) break;
#pragma unroll
        for (int a = 0; a < 2; ++a)
#pragma unroll
            for (int b = 0; b < 2; ++b)
#pragma unroll
                for (int m = 0; m < 4; ++m)
#pragma unroll
                    for (int n = 0; n < 2; ++n) acc[a][b][m][n] = (f32x4){0.f, 0.f, 0.f, 0.f};
        cur = nxt; cA = nA; cB = nB; ++ui;
        if constexpr (ALIGN_EPI) { if (wr == 1) PG8_BAR; }
    }
    PG8_WAIT_V(0);
    if constexpr (!ALIGN_EPI) { if (wr == 0) PG8_BAR; }
    PG8_BAR;
    if constexpr (Epi::AFTER_DRAIN) { E.fused(acc, cur, wr, wc, fr, fq, lds, wid, lane); S.done(cur); }
#undef PG8_SA
#undef PG8_SB
#undef PG8_STAGE
#undef PG8_LDA
#undef PG8_LDB
#undef PG8_MMA
#undef PG8_WAIT_V
#undef PG8_WAIT_L
#undef PG8_BAR
#undef PG8_SCHED
}
}

constexpr int NWAVES = 8;
constexpr int BATCH = 4, SEQ = 8192, DM = 1024, T = BATCH * SEQ, FF = 4096, NH = 16, HD = 64, NG = 4;
constexpr int NKVQ = 2816;
constexpr int PHI_ROWS = 8192;
constexpr size_t MiB = 1u << 20;
constexpr size_t WS_CTL = 0, CTL_ZERO_BYTES = 2 * MiB;
constexpr size_t WS_SS = 1 * MiB;
constexpr size_t WS_PHIB = WS_SS + 5 * 128 * 1024;
constexpr size_t WS_WIN = 2 * MiB, WS_WOUT = 8 * MiB, WS_W1 = 10 * MiB  , WS_W2 = 26 * MiB  , WS_WKVQ = 42 * MiB  , WS_WO = 48 * MiB, WS_PW1 = 50 * MiB  ;
constexpr size_t WS_KCMP = 53 * MiB, WS_VCMP = 54 * MiB;
constexpr size_t WS_PHIH = 56 * MiB;
constexpr size_t WS_XB = 64 * MiB;
constexpr size_t WS_H = 128 * MiB;
constexpr size_t WS_BG = 128 * MiB, WS_V = 192 * MiB;
constexpr size_t WS_KVQ = 128 * MiB, KVQ_TSTRIDE = (size_t)T * 256;
constexpr size_t WS_O = 304 * MiB;
constexpr size_t WS_END = 512 * MiB;
static_assert(WS_KVQ + 11 * KVQ_TSTRIDE * 2 <= WS_O && WS_O + (size_t)T * 1024 * 2 <= WS_H + (size_t)T * FF * 2 && WS_H + (size_t)T * FF * 2 <= WS_END, "ws map");
constexpr int CW_BAR = 4096;
constexpr int RING_OFF = 0, RING_BYTES = 131072;
constexpr int LDSCTL_OFF = RING_BYTES, MISC_OFF = LDSCTL_OFF + 320;
constexpr int LDS_BYTES = 147456;
#define GAS __attribute__((address_space(1)))
#define LAS __attribute__((address_space(3)))
typedef unsigned short bf16;
typedef unsigned v4u __attribute__((ext_vector_type(4)));
typedef float f32x4 __attribute__((ext_vector_type(4)));
typedef short bf16x8 __attribute__((ext_vector_type(8)));
typedef GAS unsigned gu32;
typedef GAS unsigned long long gu64;
#define RLX_AGENT __ATOMIC_RELAXED, __HIP_MEMORY_SCOPE_AGENT
#define LDS_WAIT() asm volatile("s_waitcnt lgkmcnt(0)" ::: "memory")
#define VM_WAIT() asm volatile("s_waitcnt vmcnt(0)" ::: "memory")
__device__ __forceinline__ unsigned long long rt() { return __builtin_amdgcn_s_memrealtime(); }
__device__ __forceinline__ unsigned f2bf(float f) { unsigned u = __builtin_bit_cast(unsigned, f); return (u + 0x7fffu + ((u >> 16) & 1u)) >> 16; }
__device__ __forceinline__ unsigned pk2(float lo, float hi) { return f2bf(lo) | (f2bf(hi) << 16); }

#define XB_TMO      128
#define XB_XCNT(j)  (256  + 64 * (j))
#define XB_XSUB(j)  (1280 + 64 * (j))
#define XB_XGEN(j)  (2304 + 64 * (j))
#define XB_TOP      3328
#define XB_TOPGEN   3392
#define XCD_BAR_WORDS 3456
#define XB_SPIN_CAP (1u << 18)

__device__ __forceinline__ unsigned xb_ld(unsigned* p)              { return __hip_atomic_load(p, __ATOMIC_RELAXED, __HIP_MEMORY_SCOPE_AGENT); }
__device__ __forceinline__ unsigned xb_add(unsigned* p, unsigned v) { return __hip_atomic_fetch_add(p, v, __ATOMIC_RELAXED, __HIP_MEMORY_SCOPE_AGENT); }
__device__ __forceinline__ unsigned xb_xcc_id() { return (unsigned)__builtin_amdgcn_s_getreg((3 << 11) | 20) & 0xFu; }
#define XB_SPIN(cond, bar) do { unsigned _sp = 0; while (cond) { __builtin_amdgcn_s_sleep(1); \
    if ((++_sp & 255u) == 0u) { if (xb_ld(&(bar)[XB_TMO])) break; if (_sp > XB_SPIN_CAP) { atomicAdd(&(bar)[XB_TMO], 1u); break; } } } } while (0)

struct XcdBarrier {
    unsigned* bar; unsigned x;
    volatile LAS unsigned* st;
};

__device__ __forceinline__ XcdBarrier xcd_barrier_post(unsigned* bar, volatile LAS unsigned* st) {
    XcdBarrier b; b.bar = bar; b.x = xb_xcc_id(); b.st = st;
    if (threadIdx.x == 0) (void)xb_add(&bar[XB_XCNT(b.x)], 1u);
    return b;
}
__device__ __forceinline__ void xcd_barrier_complete(unsigned* bar, unsigned x, unsigned& nloc, unsigned& nx) {
    const unsigned G = gridDim.x * gridDim.y * gridDim.z;
    unsigned sum, cnt, mine, sp = 0u;
    for (;;) {
        sum = 0u; cnt = 0u; mine = 0u;
#pragma unroll
        for (unsigned j = 0; j < 16; ++j) { const unsigned c = xb_ld(&bar[XB_XCNT(j)]); sum += c; cnt += (c > 0u) ? 1u : 0u; mine = (j == x) ? c : mine; }
        if (sum == G) break;
        __builtin_amdgcn_s_sleep(1);
        if ((++sp & 255u) == 0u) { if (xb_ld(&bar[XB_TMO])) break; if (sp > XB_SPIN_CAP) { atomicAdd(&bar[XB_TMO], 1u); break; } }
    }
    nloc = mine > 0u ? mine : 1u; nx = cnt > 0u ? cnt : 1u;
}

__device__ __forceinline__ void xcd_barrier(const XcdBarrier& b) {
    asm volatile("s_waitcnt vmcnt(0)" ::: "memory");
    __syncthreads();
    if (threadIdx.x == 0) {
        unsigned* bar = b.bar;
        __builtin_amdgcn_s_waitcnt(0);
        unsigned nloc = b.st[0], nx = b.st[1];
        if (nloc == 0u) { xcd_barrier_complete(bar, b.x, nloc, nx); b.st[0] = nloc; b.st[1] = nx; }
        const unsigned old = xb_add(&bar[XB_XSUB(b.x)], 1u);
        const unsigned gen = old / nloc;
        if (old + 1u == (gen + 1u) * nloc) {
            __builtin_amdgcn_fence(__ATOMIC_RELEASE, "agent");
            asm volatile("s_waitcnt vmcnt(0)" ::: "memory");
            const unsigned og = xb_add(&bar[XB_TOP], 1u);
            const unsigned tg = og / nx;
            if (og + 1u == (tg + 1u) * nx) xb_add(&bar[XB_TOPGEN], 1u);
            else XB_SPIN(xb_ld(&bar[XB_TOPGEN]) == tg, bar);
            __builtin_amdgcn_fence(__ATOMIC_ACQUIRE, "agent");
            xb_add(&bar[XB_XGEN(b.x)], 1u);
            asm volatile("s_waitcnt vmcnt(0)" ::: "memory");
        } else {
            XB_SPIN(xb_ld(&bar[XB_XGEN(b.x)]) == gen, bar);
            __builtin_amdgcn_fence(__ATOMIC_ACQUIRE, "agent");
            asm volatile("s_waitcnt vmcnt(0)" ::: "memory");
        }
    }
    __syncthreads();
}

struct Frame {
    LAS unsigned char* lds;
    volatile LAS unsigned* MISC;
    gu32* ctl;
    int tid, lane, wave;
    int vcu, G;
    const float* in[20];
    float* out; unsigned char* ws;
};
__device__ __forceinline__ float wave_sum(float v) {
#pragma unroll
    for (int o = 1; o < 64; o <<= 1) v += __shfl_xor(v, o);
    return v;
}
__device__ __forceinline__ float wave_max(float v) {
#pragma unroll
    for (int o = 1; o < 64; o <<= 1) v = fmaxf(v, __shfl_xor(v, o));
    return v;
}
__device__ __forceinline__ float bf2f(unsigned short b) { return __uint_as_float(((unsigned)b) << 16); }
__device__ __forceinline__ float bflo(unsigned w) { return __uint_as_float(w << 16); }
__device__ __forceinline__ float bfhi(unsigned w) { return __uint_as_float(w & 0xffff0000u); }

__device__ __forceinline__ void p0_transpose_item(const float* W, int ldw, int nvalid, const float* gain, float scale, bf16* WT, int K, int drow, int k0, int n0, LAS float* scr, int lane) {
#pragma unroll 8
    for (int i = 0; i < 32; ++i) { const int kk = 2 * i + (lane >> 5), n = n0 + (lane & 31);
        float v = (n < nvalid) ? W[(size_t)(k0 + kk) * ldw + n] : 0.f; if (gain) v *= gain[k0 + kk]; scr[kk * 33 + (lane & 31)] = v * scale; }
    LDS_WAIT(); asm volatile("" ::: "memory");
    const int c = lane & 7;
#pragma unroll
    for (int j = 0; j < 4; ++j) { const int n = (lane >> 3) + 8 * j; const LAS float* s = scr + (8 * c) * 33 + n;
        v4u o; o.x = pk2(s[0 * 33], s[1 * 33]); o.y = pk2(s[2 * 33], s[3 * 33]); o.z = pk2(s[4 * 33], s[5 * 33]); o.w = pk2(s[6 * 33], s[7 * 33]);
        *(GAS v4u*)(WT + (size_t)(drow + n) * K + k0 + 8 * c) = o; }
    LDS_WAIT(); asm volatile("" ::: "memory");
}
struct MatSpec { const float* W; int K, ldw, nvalid, niter; const float* gain; bf16* WT; int kind; };
__device__ __forceinline__ void p0_matrix_item(const MatSpec& m, int item, LAS float* scr, int lane) {
    const int nblk = m.niter / 32, kb = item / nblk, nb = item % nblk, k0 = 64 * kb, n0 = 32 * nb;
    int drow = n0; float scale = 1.f;
    if (m.kind == 1) { if (n0 >= 1024) { const int isu = n0 >= 2048, j = n0 - (isu ? 2048 : 1024); drow = 1024 + (j >> 7) * 256 + isu * 128 + (j & 127); } }
    else if (m.kind == 2) { if (n0 < 1024) { drow = 1536 + n0; scale = 0.125f; } else drow = 2560 + (n0 - 1024); }
    p0_transpose_item(m.W, m.ldw, m.nvalid, m.gain, scale, m.WT, m.K, drow, k0, n0, scr, lane);
}
__device__ __forceinline__ void p0_prologue(Frame& F) {
    LAS float* scr = (LAS float*)(F.lds + RING_OFF + F.wave * 16384);
    const int gw = F.vcu * NWAVES + F.wave, NGW = F.G * NWAVES;
    unsigned char* ws = F.ws;
    int it = gw;
#define DO_MAT(...) do { const MatSpec m_ = MatSpec{__VA_ARGS__}; const int n_ = (m_.K / 64) * (m_.niter / 32); _Pragma("unroll 1") for (; it < n_; it += NGW) p0_matrix_item(m_, it, scr, F.lane); it -= n_; } while (0)
    DO_MAT(F.in[6],  1024, 3072, 3072, 3072, F.in[2],           (bf16*)(ws + WS_WIN), 1);
    DO_MAT(F.in[8],  1024, 1024, 1024, 1024, nullptr,           (bf16*)(ws + WS_WOUT), 0);
    DO_MAT(F.in[4],  1024, 4096, 4096, 4096, F.in[3],           (bf16*)(ws + WS_W1), 0);
    DO_MAT(F.in[4] + (size_t)1024 * 4096, 1024, 4096, 4096, 4096, F.in[3] + 1024, (bf16*)(ws + WS_W1 + 8 * MiB), 0);
    DO_MAT(F.in[5],  4096, 1024, 1024, 1024, nullptr,           (bf16*)(ws + WS_W2), 0);
    DO_MAT(F.in[5] + (size_t)4096 * 1024, 4096, 1024, 1024, 1024, nullptr, (bf16*)(ws + WS_W2 + 8 * MiB), 0);
    DO_MAT(F.in[10], 1024, 1536, 1536, 1536, F.in[9],           (bf16*)(ws + WS_WKVQ), 0);
    DO_MAT(F.in[17], 1024, 1072, 1072, 1280, F.in[2] + 1024,    (bf16*)(ws + WS_WKVQ), 2);
    DO_MAT(F.in[18], 1024, 1024, 1024, 1024, nullptr,           (bf16*)(ws + WS_WO), 0);
    DO_MAT(F.in[13], 2048, 256, 256, 256, nullptr,              (bf16*)(ws + WS_PW1), 0);
    DO_MAT(F.in[15], 2048, 256, 256, 256, nullptr,              (bf16*)(ws + WS_PW1 + 1 * MiB), 0);
#undef DO_MAT
    { bf16* XB = (bf16*)(ws + WS_XB); float* ss0 = (float*)(ws + WS_SS);
      for (int m = gw; m < T; m += NGW) { const GAS f32x4* xr = (const GAS f32x4*)(F.in[0] + (size_t)m * DM) + F.lane; GAS unsigned long long* o8 = (GAS unsigned long long*)(XB + (size_t)m * DM) + F.lane; float s = 0.f;
#pragma unroll
          for (int j = 0; j < 4; ++j) { const f32x4 v = xr[64 * j]; s += (v.x * v.x + v.y * v.y) + (v.z * v.z + v.w * v.w); o8[64 * j] = (unsigned long long)pk2(v.x, v.y) | ((unsigned long long)pk2(v.z, v.w) << 32); }
          s = wave_sum(s); if (F.lane == 0) ss0[m] = s; } }
    { float* pb = (float*)(ws + WS_PHIB);
      for (int task = gw; task < 2 * 32 * 4; task += NGW) { const int side = task >> 7, kc = (task >> 2) & 31, cc = task & 3; const float* pe = F.in[side ? 12 : 11]; const float* w1 = F.in[side ? 15 : 13]; float a = 0.f;
          for (int kk = kc * 64; kk < kc * 64 + 64; ++kk) a += pe[kk] * w1[(size_t)kk * 256 + cc * 64 + F.lane];
          atomicAdd(pb + side * 256 + cc * 64 + F.lane, a); } }
}
__device__ __forceinline__ void conv_gate_phase(Frame& F) {
    bf16* BG = (bf16*)(F.ws + WS_BG); const bf16* V = (const bf16*)(F.ws + WS_V); const float* cw = F.in[7];
    const int gt = F.vcu * (NWAVES * 64) + F.tid, NGT = F.G * NWAVES * 64;
    for (int it = gt; it < T * 128; it += NGT) { const int row = it >> 7, c0 = (it & 127) * 8, t = row & (SEQ - 1);
        const v4u z = {0u, 0u, 0u, 0u};
        const v4u v2 = *(const v4u*)(V + (size_t)row * 1024 + c0);
        const v4u v1 = t >= 1 ? *(const v4u*)(V + (size_t)(row - 1) * 1024 + c0) : z;
        const v4u v0 = t >= 2 ? *(const v4u*)(V + (size_t)(row - 2) * 1024 + c0) : z;
        const v4u b = *(const v4u*)(BG + (size_t)row * 1024 + c0);
        const f32x4 w0a = *(const f32x4*)(cw + c0), w0b = *(const f32x4*)(cw + c0 + 4), w1a = *(const f32x4*)(cw + 1024 + c0), w1b = *(const f32x4*)(cw + 1024 + c0 + 4), w2a = *(const f32x4*)(cw + 2048 + c0), w2b = *(const f32x4*)(cw + 2048 + c0 + 4);
        float y[8];
#pragma unroll
        for (int j = 0; j < 4; ++j) { const unsigned a0 = v0[j], a1 = v1[j], a2 = v2[j], bb = b[j];
            const float wl0 = j < 2 ? w0a[2 * j] : w0b[2 * j - 4], wh0 = j < 2 ? w0a[2 * j + 1] : w0b[2 * j - 3];
            const float wl1 = j < 2 ? w1a[2 * j] : w1b[2 * j - 4], wh1 = j < 2 ? w1a[2 * j + 1] : w1b[2 * j - 3];
            const float wl2 = j < 2 ? w2a[2 * j] : w2b[2 * j - 4], wh2 = j < 2 ? w2a[2 * j + 1] : w2b[2 * j - 3];
            y[2 * j] = bflo(bb) * (wl0 * bflo(a0) + wl1 * bflo(a1) + wl2 * bflo(a2));
            y[2 * j + 1] = bfhi(bb) * (wh0 * bfhi(a0) + wh1 * bfhi(a1) + wh2 * bfhi(a2)); }
        v4u o; o.x = pk2(y[0], y[1]); o.y = pk2(y[2], y[3]); o.z = pk2(y[4], y[5]); o.w = pk2(y[6], y[7]);
        *(v4u*)(BG + (size_t)row * 1024 + c0) = o; }
}
__device__ __forceinline__ void phi2_phase(Frame& F) {
    LAS float* hs = (LAS float*)(F.lds + RING_OFF + F.wave * 8192);
    const int gw = F.vcu * NWAVES + F.wave, NGW = F.G * NWAVES;
    for (int task = gw; task < 2 * (PHI_ROWS / 8); task += NGW) { const int side = task / (PHI_ROWS / 8), r0 = (task % (PHI_ROWS / 8)) * 8;
        const bf16* H = (const bf16*)(F.ws + WS_PHIH) + (size_t)side * PHI_ROWS * 256 + (size_t)r0 * 256; const float* w2 = F.in[side ? 16 : 14];
#pragma unroll
        for (int j = 0; j < 4; ++j) { const v4u w = *(const v4u*)(H + F.lane * 32 + j * 8);
#pragma unroll
            for (int q = 0; q < 4; ++q) { hs[F.lane * 32 + j * 8 + 2 * q] = bflo(w[q]); hs[F.lane * 32 + j * 8 + 2 * q + 1] = bfhi(w[q]); } }
        LDS_WAIT(); asm volatile("" ::: "memory");
        float acc[8] = {0.f, 0.f, 0.f, 0.f, 0.f, 0.f, 0.f, 0.f};
        for (int c = 0; c < 256; c += 4) { const float wa = w2[(c + 0) * 64 + F.lane], wb = w2[(c + 1) * 64 + F.lane], wc = w2[(c + 2) * 64 + F.lane], wd = w2[(c + 3) * 64 + F.lane];
#pragma unroll
            for (int i = 0; i < 8; ++i) { const f32x4 h = *(const LAS f32x4*)(hs + i * 256 + c); acc[i] += h.x * wa + h.y * wb + h.z * wc + h.w * wd; } }
        bf16* O = (bf16*)(F.ws + (side ? WS_VCMP : WS_KCMP));
#pragma unroll
        for (int i = 0; i < 8; ++i) O[(size_t)(r0 + i) * 64 + F.lane] = (bf16)f2bf(acc[i]);
        LDS_WAIT(); asm volatile("" ::: "memory"); }
}
__device__ __forceinline__ void final_norm_phase(Frame& F) {
    const int gw = F.vcu * NWAVES + F.wave, NGW = F.G * NWAVES; const float* ss = (const float*)(F.ws + WS_SS) + 4 * T; const float* gn = F.in[19];
    f32x4 g4[4];
#pragma unroll
    for (int j = 0; j < 4; ++j) g4[j] = *((const f32x4*)gn + F.lane + 64 * j);
    for (int m = gw; m < T; m += NGW) { GAS f32x4* xr = (GAS f32x4*)(F.out + (size_t)m * DM) + F.lane; const float rs = __builtin_amdgcn_rsqf(ss[m] * (1.0f / 1024.0f) + 1e-6f);
#pragma unroll
        for (int j = 0; j < 4; ++j) { f32x4 v = xr[64 * j]; v = v * rs * g4[j]; xr[64 * j] = v; } }
}

__device__ __forceinline__ int t5_bucket_dev(int d) {
    if (d < 16) return d;
    int b = 16;
    b += (d >= 19); b += (d >= 21); b += (d >= 24); b += (d >= 27); b += (d >= 31); b += (d >= 35); b += (d >= 40); b += (d >= 46);
    b += (d >= 52); b += (d >= 59); b += (d >= 67); b += (d >= 77); b += (d >= 87); b += (d >= 99); b += (d >= 113);
    return b;
}
__device__ __forceinline__ void build_bias_table(Frame& F, LAS float* BT) {
    for (int i = F.tid; i < 128 * 16; i += NWAVES * 64) BT[i] = F.in[1][t5_bucket_dev(i >> 4) * 16 + (i & 15)];
}
__device__ __forceinline__ void attn_naive_phase(Frame& F) {
    LAS float* BT = (LAS float*)(F.lds + RING_OFF);
    LAS float* qs = (LAS float*)(F.lds + RING_OFF + 8192 + F.wave * 4096);
    LAS float* imp = qs + 256;
    LAS int* selb = (LAS int*)(imp + 512);
    LAS float* MC = (LAS float*)(selb + 16);
    LAS float* LG = (LAS float*)(F.lds + RING_OFF + 8192 + 8 * 4096 + F.wave * 8192);
    build_bias_table(F, BT);
    __syncthreads();
    const bf16* KVQ = (const bf16*)(F.ws + WS_KVQ);
    const bf16* GATES = KVQ + 10 * KVQ_TSTRIDE; const bf16* KCMP = (const bf16*)(F.ws + WS_KCMP); const bf16* VCMP = (const bf16*)(F.ws + WS_VCMP);
    bf16* O = (bf16*)(F.ws + WS_O);
    const int gw = F.vcu * NWAVES + F.wave, NGW = F.G * NWAVES, lane = F.lane;
#pragma unroll 1
    for (int task = gw; task < T * NG; task += NGW) {
        const int row = task >> 2, g = task & 3, b = row >> 13, pos = row & (SEQ - 1);
        { const bf16* qp = KVQ + (size_t)(6 + g) * KVQ_TSTRIDE + (size_t)row * 256 + lane * 4; const unsigned long long w = *(const unsigned long long*)qp;
          qs[lane * 4 + 0] = bflo((unsigned)w); qs[lane * 4 + 1] = bfhi((unsigned)w); qs[lane * 4 + 2] = bflo((unsigned)(w >> 32)); qs[lane * 4 + 3] = bfhi((unsigned)(w >> 32)); }
        LDS_WAIT(); asm volatile("" ::: "memory");
        const int nv = pos >= 31 ? ((pos - 31) >> 4) + 1 : 0;
        float oacc[4] = {0.f, 0.f, 0.f, 0.f};
#pragma unroll 1
        for (int br = 0; br < 3; ++br) {
            const bf16* Kt = br == 0 ? KCMP : KVQ + (size_t)(br == 1 ? 2 : 4) * KVQ_TSTRIDE; const bf16* Vt = br == 0 ? VCMP : KVQ + (size_t)(br == 1 ? 3 : 5) * KVQ_TSTRIDE;
            const int nc = br == 0 ? (nv + 63) >> 6 : (br == 1 ? 16 : 8);
            float m[4] = {-1e30f, -1e30f, -1e30f, -1e30f}, Z[4] = {0.f, 0.f, 0.f, 0.f}, o[4] = {0.f, 0.f, 0.f, 0.f};
#pragma unroll 1
            for (int c = 0; c < nc; ++c) { asm volatile("" ::: "memory");
                int ridx, dist; bool valid;
                if (br == 0) { const int n = c * 64 + lane; ridx = b * 512 + n; dist = pos - 16 * n - 31; valid = n < nv; }
                else if (br == 1) { const int bk = selb[c]; const int tok = bk * 64 + lane; ridx = b * SEQ + tok; dist = pos - tok; valid = (bk >= 0) && dist >= 0; }
                else { const int kp = pos - 511 + c * 64 + lane; ridx = b * SEQ + kp; dist = pos - kp; valid = kp >= 0; }
                const unsigned long long vmask = __ballot(valid);
                if (vmask == 0ull) continue;
                float l[4] = {0.f, 0.f, 0.f, 0.f};
                if (valid) { const v4u* kr = (const v4u*)(Kt + (size_t)ridx * 256 + g * 64);
#pragma unroll
                    for (int j = 0; j < 8; ++j) { const v4u w = kr[j]; float f[8];
#pragma unroll
                        for (int q = 0; q < 4; ++q) { f[2 * q] = bflo(w[q]); f[2 * q + 1] = bfhi(w[q]); }
#pragma unroll
                        for (int h = 0; h < 4; ++h) { const f32x4 qa = *(const LAS f32x4*)(qs + h * 64 + 8 * j), qb = *(const LAS f32x4*)(qs + h * 64 + 8 * j + 4);
                            l[h] += (f[0] * qa.x + f[1] * qa.y) + (f[2] * qa.z + f[3] * qa.w) + (f[4] * qb.x + f[5] * qb.y) + (f[6] * qb.z + f[7] * qb.w); } }
                    const int dd = dist < 127 ? dist : 127;
#pragma unroll
                    for (int h = 0; h < 4; ++h) l[h] += BT[dd * 16 + g * 4 + h]; }
                float p[4];
#pragma unroll
                for (int h = 0; h < 4; ++h) { const float lv = valid ? l[h] : -1e30f; const float mn = fmaxf(m[h], wave_max(lv)); const float sc = __expf(m[h] - mn);
                    p[h] = valid ? __expf(lv - mn) : 0.f; Z[h] = Z[h] * sc + wave_sum(p[h]); o[h] *= sc; m[h] = mn; }
                if (br == 0) {
#pragma unroll
                    for (int h = 0; h < 4; ++h) { LG[h * 512 + c * 64 + lane] = p[h]; if (lane == 0) MC[c * 4 + h] = m[h]; } }
                unsigned long long vm = vmask;
                while (vm) { const int ll = __builtin_ctzll(vm); vm &= vm - 1ull;
                    const int r = __builtin_amdgcn_readlane(ridx, ll); const float v = bf2f(Vt[(size_t)r * 256 + g * 64 + lane]);
#pragma unroll
                    for (int h = 0; h < 4; ++h) o[h] += __uint_as_float(__builtin_amdgcn_readlane(__float_as_uint(p[h]), ll)) * v; } }
            { const bf16* gp = GATES + (size_t)row * 256 + g * 12 + br;
#pragma unroll
              for (int h = 0; h < 4; ++h) { const float zi = Z[h] > 0.f ? 1.0f / Z[h] : 0.f; Z[h] = zi; oacc[h] += bf2f(gp[h * 3]) * o[h] * zi; } }
            if (br == 0) {
                LDS_WAIT(); asm volatile("" ::: "memory");
#pragma unroll 1
                for (int c = 0; c < 8; ++c) { const int n = c * 64 + lane; float s = 0.f;
                    if (c < nc) {
#pragma unroll
                        for (int h = 0; h < 4; ++h) s += LG[h * 512 + n] * __expf(MC[c * 4 + h] - m[h]) * Z[h]; }
                    imp[n] = s; }
                LDS_WAIT(); asm volatile("" ::: "memory");
                unsigned khi[2], klo[2]; const int cb = pos >> 6;
#pragma unroll
                for (int k = 0; k < 2; ++k) { const int j = lane + 64 * k; float s = 2.0f * (imp[4 * j] + imp[4 * j + 1] + imp[4 * j + 2]) + imp[4 * j + 3]; if (j > 0) s += imp[4 * j - 1];
                    const bool forced = (j == 0) || (j == cb) || (j == cb - 1), future = j > cb; const float sc = forced ? 1e9f : s;
                    khi[k] = future ? 0u : (__float_as_uint(sc) + 1u); klo[k] = 128u - (unsigned)j; }
                LDS_WAIT(); asm volatile("" ::: "memory");
#pragma unroll 1
                for (int i = 0; i < 16; ++i) { unsigned h, l; const bool first = (khi[0] > khi[1]) || (khi[0] == khi[1] && klo[0] > klo[1]); h = first ? khi[0] : khi[1]; l = first ? klo[0] : klo[1];
#pragma unroll
                    for (int off = 1; off < 64; off <<= 1) { const unsigned oh = __shfl_xor(h, off), ol = __shfl_xor(l, off); if (oh > h || (oh == h && ol > l)) { h = oh; l = ol; } }
                    h = __builtin_amdgcn_readfirstlane(h); l = __builtin_amdgcn_readfirstlane(l);
                    if (lane == 0) selb[i] = (h != 0u) ? 128 - (int)l : -1;
#pragma unroll
                    for (int k = 0; k < 2; ++k) if (klo[k] == l) { khi[k] = 0u; klo[k] = 0u; } }
                LDS_WAIT(); asm volatile("" ::: "memory");
            }
        }
#pragma unroll
        for (int h = 0; h < 4; ++h) O[(size_t)row * 1024 + (g * 4 + h) * 64 + lane] = (bf16)f2bf(oacc[h]);
    }
}

#ifndef MK_PER_PHASE
#define MK_PER_PHASE 0
#endif
constexpr int N_PHASES = 14;
struct Args { const float* in[20]; float* out; unsigned char* ws; int ph_lo, ph_hi, li, pad; };
__global__ void __launch_bounds__(NWAVES * 64, 2) nsa_fwd(Args args) {
    extern __shared__ __attribute__((aligned(16))) unsigned char lds[];
    Frame F;
    F.lds = (LAS unsigned char*)lds;
    F.MISC = (volatile LAS unsigned*)(F.lds + MISC_OFF);
    F.tid = threadIdx.x; F.lane = F.tid & 63; F.wave = __builtin_amdgcn_readfirstlane(F.tid >> 6);
    F.G = gridDim.x; { const int bx = blockIdx.x; F.vcu = (F.G % 8 == 0) ? (bx % 8) * (F.G / 8) + bx / 8 : bx; }
    unsigned char* ws = args.ws; F.ws = ws; F.out = args.out;
    F.ctl = (gu32*)(ws + WS_CTL);
#pragma unroll
    for (int i = 0; i < 20; ++i) F.in[i] = args.in[i];
    for (int u = F.tid; u < (LDS_BYTES - LDSCTL_OFF) / 4; u += NWAVES * 64) ((LAS unsigned*)(F.lds + LDSCTL_OFF))[u] = 0u;
    __syncthreads();
    XcdBarrier bar; bar.bar = (unsigned*)(F.ctl + CW_BAR); bar.x = 0; bar.st = nullptr;
    if (!MK_PER_PHASE) bar = xcd_barrier_post((unsigned*)(F.ctl + CW_BAR), F.MISC + 8);
#define GRID_BAR() do { if (!MK_PER_PHASE) xcd_barrier(bar); } while (0)
    const int lo = args.ph_lo, hi = args.ph_hi;
#define IN(k) (lo <= (k) && (k) < hi)
#define BOTH(k) (IN(k) && IN((k) + 1))
    bf16* XB = (bf16*)(ws + WS_XB); float* SS = (float*)(ws + WS_SS);
    const int bx = (int)blockIdx.x;

    if (IN(0)) { p0_prologue(F); if (BOTH(0)) GRID_BAR(); }
    if (IN(1)) {
        pg8::Gemm g{XB, (const bf16*)(ws + WS_WIN), T, 3072, DM, 0}; pg8::StaticOrder S; S.init(T, 3072, F.G, bx);
        pg8::EpiWin E{(bf16*)(ws + WS_BG), (bf16*)(ws + WS_V), SS};
        pg8::gemm_phase<pg8::EpiWin, pg8::StaticOrder, true, true>(F.lds + RING_OFF, g, S, E);
        if (BOTH(1)) GRID_BAR(); }
    if (IN(2)) { conv_gate_phase(F); if (BOTH(2)) GRID_BAR(); }
    if (IN(3)) {
        pg8::Gemm g{(const bf16*)(ws + WS_BG), (const bf16*)(ws + WS_WOUT), T, DM, DM, 0}; pg8::StaticOrder S; S.init(T, DM, F.G, bx);
        pg8::EpiRes E{F.in[0], F.out, XB, SS + T};
        pg8::gemm_phase<pg8::EpiRes, pg8::StaticOrder, true, true>(F.lds + RING_OFF, g, S, E);
        if (BOTH(3)) GRID_BAR(); }
    if (IN(4)) {
        pg8::Gemm g{XB, (const bf16*)(ws + WS_W1), T, FF, DM, 0}; pg8::StaticOrder S; S.init(T, FF, F.G, bx);
        pg8::EpiRelu2 E{(bf16*)(ws + WS_H), FF, SS + T};
        pg8::gemm_phase<pg8::EpiRelu2, pg8::StaticOrder, true, true>(F.lds + RING_OFF, g, S, E);
        if (BOTH(4)) GRID_BAR(); }
    if (IN(5)) {
        pg8::Gemm g{(const bf16*)(ws + WS_H), (const bf16*)(ws + WS_W2), T, DM, FF, 0}; pg8::StaticOrder S; S.init(T, DM, F.G, bx);
        pg8::EpiRes E{F.out, F.out, XB, SS + 2 * T};
        pg8::gemm_phase<pg8::EpiRes, pg8::StaticOrder, true, true>(F.lds + RING_OFF, g, S, E);
        if (BOTH(5)) GRID_BAR(); }
    if (IN(6)) {
        pg8::Gemm g{XB, (const bf16*)(ws + WS_WKVQ), T, NKVQ, DM, 0}; pg8::StaticOrder S; S.init(T, NKVQ, F.G, bx);
        pg8::EpiKvq E{(bf16*)(ws + WS_KVQ), KVQ_TSTRIDE, SS + 2 * T};
        pg8::gemm_phase<pg8::EpiKvq, pg8::StaticOrder, true, true>(F.lds + RING_OFF, g, S, E);
        if (BOTH(6)) GRID_BAR(); }
    if (IN(7)) {
        const int c = F.vcu, side = (c >> 5) & 1;
        pg8::Gemm g{(const bf16*)(ws + WS_KVQ) + (size_t)side * KVQ_TSTRIDE, (const bf16*)(ws + WS_PW1 + (size_t)side * MiB), PHI_ROWS, 256, 2048, 1}; pg8::PhiOrder S{c};
        pg8::EpiPhi E{(bf16*)(ws + WS_PHIH) + (size_t)side * PHI_ROWS * 256, (const float*)(ws + WS_PHIB) + side * 256};
        pg8::gemm_phase<pg8::EpiPhi, pg8::PhiOrder, false, true>(F.lds + RING_OFF, g, S, E);
        if (BOTH(7)) GRID_BAR(); }
    if (IN(8)) { phi2_phase(F); if (BOTH(8)) GRID_BAR(); }
    if (IN(9)) { attn_naive_phase(F); if (BOTH(9)) GRID_BAR(); }
    if (IN(10)) {
        pg8::Gemm g{(const bf16*)(ws + WS_O), (const bf16*)(ws + WS_WO), T, DM, DM, 0}; pg8::StaticOrder S; S.init(T, DM, F.G, bx);
        pg8::EpiRes E{F.out, F.out, XB, SS + 3 * T};
        pg8::gemm_phase<pg8::EpiRes, pg8::StaticOrder, true, true>(F.lds + RING_OFF, g, S, E);
        if (BOTH(10)) GRID_BAR(); }
    if (IN(11)) {
        pg8::Gemm g{XB, (const bf16*)(ws + WS_W1 + 8 * MiB), T, FF, DM, 0}; pg8::StaticOrder S; S.init(T, FF, F.G, bx);
        pg8::EpiRelu2 E{(bf16*)(ws + WS_H), FF, SS + 3 * T};
        pg8::gemm_phase<pg8::EpiRelu2, pg8::StaticOrder, true, true>(F.lds + RING_OFF, g, S, E);
        if (BOTH(11)) GRID_BAR(); }
    if (IN(12)) {
        pg8::Gemm g{(const bf16*)(ws + WS_H), (const bf16*)(ws + WS_W2 + 8 * MiB), T, DM, FF, 0}; pg8::StaticOrder S; S.init(T, DM, F.G, bx);
        pg8::EpiRes E{F.out, F.out, nullptr, SS + 4 * T};
        pg8::gemm_phase<pg8::EpiRes, pg8::StaticOrder, true, true>(F.lds + RING_OFF, g, S, E);
        if (BOTH(12)) GRID_BAR(); }
    if (IN(13)) { final_norm_phase(F); }
#undef IN
#undef BOTH
}

extern "C" void kernel_launch(void* const* d_in, const int* in_sizes, int n_in, void* d_out, int out_size, void* d_ws, size_t ws_size, hipStream_t stream) {
    static int grid = 0;
    if (grid == 0) {
        if (n_in != 20 || in_sizes[0] != T * DM || out_size != T * DM || ws_size < WS_END) { fprintf(stderr, "kernel_launch: unexpected shapes (n_in %d, in0 %d, out %d, ws %zu)\n", n_in, n_in > 0 ? in_sizes[0] : -1, out_size, ws_size); grid = -1; return; }
        int dev = 0, cus = 0, per_cu = 0;
        if (hipGetDevice(&dev) != hipSuccess || hipDeviceGetAttribute(&cus, hipDeviceAttributeMultiprocessorCount, dev) != hipSuccess) { grid = -1; return; }
        if (hipFuncSetAttribute((const void*)nsa_fwd, hipFuncAttributeMaxDynamicSharedMemorySize, LDS_BYTES) != hipSuccess) { fprintf(stderr, "kernel_launch: hipFuncSetAttribute failed\n"); grid = -1; return; }
        if (hipOccupancyMaxActiveBlocksPerMultiprocessor(&per_cu, (const void*)nsa_fwd, NWAVES * 64, LDS_BYTES) != hipSuccess || per_cu < 1) fprintf(stderr, "kernel_launch: occupancy query reports %d\n", per_cu);
        (void)hipGetLastError();
        grid = cus;
        if (grid != 256) fprintf(stderr, "kernel_launch: %d CUs (built for 256)\n", grid);
    }
    if (grid < 0) return;
    if (hipMemsetAsync((char*)d_ws + WS_CTL, 0, CTL_ZERO_BYTES, stream) != hipSuccess) return;
    Args a{};
    for (int i = 0; i < 20; ++i) a.in[i] = (const float*)d_in[i];
    a.out = (float*)d_out; a.ws = (unsigned char*)d_ws;
#if MK_PER_PHASE
    for (int p = 0; p < N_PHASES; ++p) { a.ph_lo = p; a.ph_hi = p + 1; a.li = p; hipLaunchKernelGGL(nsa_fwd, dim3(grid), dim3(NWAVES * 64), LDS_BYTES, stream, a); }
#else
    a.ph_lo = 0; a.ph_hi = N_PHASES; a.li = 0;
    hipLaunchKernelGGL(nsa_fwd, dim3(grid), dim3(NWAVES * 64), LDS_BYTES, stream, a);
#endif
}
```

```cpp
#include <hip/hip_runtime.h>
#include <cstdio>
#include <cstdint>
__device__ __forceinline__ int fresh_lane() { int l; asm volatile("v_mbcnt_lo_u32_b32 %0, -1, 0\n\tv_mbcnt_hi_u32_b32 %0, -1, %0" : "=v"(l)); return l; }
namespace pg8 {
#define PG8_LAS __attribute__((address_space(3)))
typedef unsigned short bf16_t;
typedef short bf16x8 __attribute__((ext_vector_type(8)));
typedef float f32x4 __attribute__((ext_vector_type(4)));
typedef unsigned u32x4 __attribute__((ext_vector_type(4)));
constexpr int BM = 256, BK = 64, HALF = 128, HTB = HALF * BK * 2  , STAGE_BYTES = 8 * HTB, NXCD = 8, WGM = 8;

__host__ __device__ __forceinline__ int lds_byte(int r, int c) { const int st = (r >> 4) * 2 + (c >> 5), rr = r & 15, cc = c & 31, ob = rr * 64 + cc * 2; return st * 1024 + (ob ^ (((ob >> 9) & 1) << 5)); }
__host__ __device__ __forceinline__ void stage_rc(int b, int& R, int& C) { const int st = b / 1024, sb = b % 1024, swz = sb ^ (((sb >> 9) & 1) << 5); R = (st >> 1) * 16 + swz / 64; C = (st & 1) * 32 + (swz % 64) / 2; }
__host__ __device__ __forceinline__ int perm32(int rho) { const int n = rho >> 4, i = rho & 15; return 8 * (i >> 2) + 4 * n + (i & 3); }

struct Unit { int pm, pn; };
struct Gemm { const bf16_t* A; const bf16_t* Bt; int M, N, K; int a_gather; };

struct StaticOrder {
    int nM, nN, nwg, G, c;
    __host__ __device__ void init(int M, int N, int G_, int c_) { nM = M / BM; nN = N / BM; nwg = nM * nN; G = G_; c = c_; }
    __host__ __device__ bool next(int i, Unit& u) const {
        const long L = (long)i * G + c; if (L >= nwg) return false;
        int wgid = (int)L; { const int q = nwg / NXCD, r = nwg % NXCD, xcd = wgid % NXCD, off = wgid / NXCD; wgid = (xcd < r ? xcd * (q + 1) : r * (q + 1) + (xcd - r) * q) + off; }
        const int nig = WGM * nN, gid = wgid / nig, fm = gid * WGM, gsz = (nM - fm) < WGM ? (nM - fm) : WGM;
        u.pm = fm + ((wgid % nig) % gsz); u.pn = (wgid % nig) / gsz; return true;
    }
    __device__ __forceinline__ void a_ready(const Unit&) const {}
    __device__ __forceinline__ void done(const Unit&) const {}
};

__device__ __forceinline__ unsigned cvt_pk_bf16(float lo, float hi) { unsigned r; asm volatile("v_cvt_pk_bf16_f32 %0, %1, %2" : "=v"(r) : "v"(lo), "v"(hi)); return r; }
typedef float f32x2 __attribute__((ext_vector_type(2)));
typedef unsigned u32x2 __attribute__((ext_vector_type(2)));
constexpr float RMS_EPS = 1e-6f;
__device__ __forceinline__ float row_rstd(const float* ss, int r) { return __builtin_amdgcn_rsqf(ss[r] * (1.0f / 1024.0f) + RMS_EPS); }

struct EpiRes {
    static constexpr bool PERM = true, AFTER_DRAIN = false;
    bf16_t* xb; float* ss;
    __device__ __forceinline__ void operator()(const f32x4 (&acc)[2][2][4][2], const Unit& u, int wr, int wc, int fr, int fq) const {
        const int col0 = u.pn * BM + wc * 32 + 8 * fq;
#pragma unroll
        for (int ai = 0; ai < 2; ++ai)
#pragma unroll
            for (int m = 0; m < 4; ++m) { const int r = u.pm * BM + ai * HALF + wr * 64 + m * 16 + fr; bf16_t* rowp = xb + (size_t)r * 1024 + col0; float s = 0.f;
#pragma unroll
                for (int bj = 0; bj < 2; ++bj) { const u32x4 b = *(const u32x4*)(rowp + bj * HALF); const f32x4 a0 = acc[ai][bj][m][0], a1 = acc[ai][bj][m][1];
                    const unsigned w0 = cvt_pk_bf16(__uint_as_float(b.x << 16) + a0[0], __uint_as_float(b.x & 0xffff0000u) + a0[1]), w1 = cvt_pk_bf16(__uint_as_float(b.y << 16) + a0[2], __uint_as_float(b.y & 0xffff0000u) + a0[3]);
                    const unsigned w2 = cvt_pk_bf16(__uint_as_float(b.z << 16) + a1[0], __uint_as_float(b.z & 0xffff0000u) + a1[1]), w3 = cvt_pk_bf16(__uint_as_float(b.w << 16) + a1[2], __uint_as_float(b.w & 0xffff0000u) + a1[3]);
                    u32x4 w; w.x = w0; w.y = w1; w.z = w2; w.w = w3; *(u32x4*)(rowp + bj * HALF) = w;
                    const float e0 = __uint_as_float(w0 << 16), e1 = __uint_as_float(w0 & 0xffff0000u), e2 = __uint_as_float(w1 << 16), e3 = __uint_as_float(w1 & 0xffff0000u);
                    const float e4 = __uint_as_float(w2 << 16), e5 = __uint_as_float(w2 & 0xffff0000u), e6 = __uint_as_float(w3 << 16), e7 = __uint_as_float(w3 & 0xffff0000u);
                    s += ((e0 * e0 + e1 * e1) + (e2 * e2 + e3 * e3)) + ((e4 * e4 + e5 * e5) + (e6 * e6 + e7 * e7)); }
                s += __shfl_xor(s, 16); s += __shfl_xor(s, 32);
                if (fq == 0) atomicAdd(ss + r, s); }
    }
};
struct EpiRelu2 {
    static constexpr bool PERM = true, AFTER_DRAIN = false;
    bf16_t* O; int ldc; const float* ss;
    __device__ __forceinline__ void operator()(const f32x4 (&acc)[2][2][4][2], const Unit& u, int wr, int wc, int fr, int fq) const {
        const int col0 = u.pn * BM + wc * 32 + 8 * fq;
#pragma unroll
        for (int ai = 0; ai < 2; ++ai)
#pragma unroll
            for (int m = 0; m < 4; ++m) { const int r = u.pm * BM + ai * HALF + wr * 64 + m * 16 + fr; const float rs = row_rstd(ss, r), s2 = rs * rs; bf16_t* rowp = O + (size_t)r * ldc + col0;
#pragma unroll
                for (int bj = 0; bj < 2; ++bj) { f32x4 v0 = acc[ai][bj][m][0], v1 = acc[ai][bj][m][1];
#pragma unroll
                    for (int j = 0; j < 4; ++j) { const float a = fmaxf(v0[j], 0.f), b = fmaxf(v1[j], 0.f); v0[j] = a * a * s2; v1[j] = b * b * s2; }
                    u32x4 w; w.x = cvt_pk_bf16(v0[0], v0[1]); w.y = cvt_pk_bf16(v0[2], v0[3]); w.z = cvt_pk_bf16(v1[0], v1[1]); w.w = cvt_pk_bf16(v1[2], v1[3]);
                    *(u32x4*)(rowp + bj * HALF) = w; } }
    }
};
struct EpiWin {
    static constexpr bool PERM = true, AFTER_DRAIN = false;
    bf16_t* BG; bf16_t* V; const float* ss;
    __device__ __forceinline__ void operator()(const f32x4 (&acc)[2][2][4][2], const Unit& u, int wr, int wc, int fr, int fq) const {
#pragma unroll
        for (int ai = 0; ai < 2; ++ai)
#pragma unroll
            for (int m = 0; m < 4; ++m) { const int r = u.pm * BM + ai * HALF + wr * 64 + m * 16 + fr; const float rs = row_rstd(ss, r);
                if (u.pn < 4) { bf16_t* rowp = BG + (size_t)r * 1024 + u.pn * BM + wc * 32 + 8 * fq;
#pragma unroll
                    for (int bj = 0; bj < 2; ++bj) { const f32x4 v0 = acc[ai][bj][m][0] * rs, v1 = acc[ai][bj][m][1] * rs;
                        u32x4 w; w.x = cvt_pk_bf16(v0[0], v0[1]); w.y = cvt_pk_bf16(v0[2], v0[3]); w.z = cvt_pk_bf16(v1[0], v1[1]); w.w = cvt_pk_bf16(v1[2], v1[3]);
                        *(u32x4*)(rowp + bj * HALF) = w; }
                } else { bf16_t* rowp = V + (size_t)r * 1024 + (u.pn - 4) * HALF + wc * 32 + 8 * fq; const float s2 = rs * rs;
                    const f32x4 v0 = acc[ai][0][m][0] * acc[ai][1][m][0] * s2, v1 = acc[ai][0][m][1] * acc[ai][1][m][1] * s2;
                    u32x4 w; w.x = cvt_pk_bf16(v0[0], v0[1]); w.y = cvt_pk_bf16(v0[2], v0[3]); w.z = cvt_pk_bf16(v1[0], v1[1]); w.w = cvt_pk_bf16(v1[2], v1[3]);
                    *(u32x4*)rowp = w; } }
    }
};
struct EpiKvq {
    static constexpr bool PERM = true, AFTER_DRAIN = false;
    bf16_t* O; size_t tstride; const float* ss;
    __device__ __forceinline__ void operator()(const f32x4 (&acc)[2][2][4][2], const Unit& u, int wr, int wc, int fr, int fq) const {
        bf16_t* base = O + (size_t)u.pn * tstride + wc * 32 + 8 * fq; const bool sig = (u.pn == 10);
#pragma unroll
        for (int ai = 0; ai < 2; ++ai)
#pragma unroll
            for (int m = 0; m < 4; ++m) { const int r = u.pm * BM + ai * HALF + wr * 64 + m * 16 + fr; const float rs = row_rstd(ss, r); bf16_t* rowp = base + (size_t)r * 256;
#pragma unroll
                for (int bj = 0; bj < 2; ++bj) { f32x4 v0 = acc[ai][bj][m][0] * rs, v1 = acc[ai][bj][m][1] * rs;
                    if (sig) {
#pragma unroll
                        for (int j = 0; j < 4; ++j) { v0[j] = 1.0f / (1.0f + __expf(-v0[j])); v1[j] = 1.0f / (1.0f + __expf(-v1[j])); } }
                    u32x4 w; w.x = cvt_pk_bf16(v0[0], v0[1]); w.y = cvt_pk_bf16(v0[2], v0[3]); w.z = cvt_pk_bf16(v1[0], v1[1]); w.w = cvt_pk_bf16(v1[2], v1[3]);
                    *(u32x4*)(rowp + bj * HALF) = w; } }
    }
};
struct EpiPhi {
    static constexpr bool PERM = true, AFTER_DRAIN = false;
    bf16_t* O; const float* bias;
    __device__ __forceinline__ void operator()(const f32x4 (&acc)[2][2][4][2], const Unit& u, int wr, int wc, int fr, int fq) const {
        const int col0 = wc * 32 + 8 * fq;
        f32x4 bv[2][2];
#pragma unroll
        for (int bj = 0; bj < 2; ++bj)
#pragma unroll
            for (int n = 0; n < 2; ++n) bv[bj][n] = *(const f32x4*)(bias + col0 + bj * HALF + 4 * n);
#pragma unroll
        for (int ai = 0; ai < 2; ++ai)
#pragma unroll
            for (int m = 0; m < 4; ++m) { const int r = u.pm * BM + ai * HALF + wr * 64 + m * 16 + fr; bf16_t* rowp = O + (size_t)r * 256 + col0;
#pragma unroll
                for (int bj = 0; bj < 2; ++bj) { f32x4 v0 = acc[ai][bj][m][0] + bv[bj][0], v1 = acc[ai][bj][m][1] + bv[bj][1];
#pragma unroll
                    for (int j = 0; j < 4; ++j) { v0[j] = v0[j] / (1.0f + __expf(-v0[j])); v1[j] = v1[j] / (1.0f + __expf(-v1[j])); }
                    u32x4 w; w.x = cvt_pk_bf16(v0[0], v0[1]); w.y = cvt_pk_bf16(v0[2], v0[3]); w.z = cvt_pk_bf16(v1[0], v1[1]); w.w = cvt_pk_bf16(v1[2], v1[3]);
                    *(u32x4*)(rowp + bj * HALF) = w; } }
    }
};
struct PhiOrder {
    int c;
    __device__ __forceinline__ bool next(int i, Unit& u) const { if (i > 0 || c >= 64) return false; u.pm = c & 31; u.pn = 0; return true; }
    __device__ __forceinline__ void a_ready(const Unit&) const {}
    __device__ __forceinline__ void done(const Unit&) const {}
};
template <class Epi, class Sched, bool ALIGN_EPI = false, bool SP2 = false>
__device__ __forceinline__ void gemm_phase(PG8_LAS unsigned char* lds, const Gemm g, const Sched& S, const Epi& E, const int wid  ) {
    const int lane = fresh_lane(), tid = wid * 64 + lane, wr = wid >> 2, wc = wid & 3, fr = lane & 15, fq = lane >> 4;
    const int K = g.K, nt = K / BK;
    unsigned voffA[2], voffB[2];
#pragma unroll
    for (int i = 0; i < 2; ++i) { int R, C; stage_rc(tid * 16 + i * 8192, R, C); const int Rb = Epi::PERM ? ((R & ~31) + perm32(R & 31)) : R;
        voffA[i] = g.a_gather ? (unsigned)((R >> 2) * 8192 + (R & 3) * 128 + C * 2) : (unsigned)(R * K + C) * 2u; voffB[i] = (unsigned)(Rb * K + C) * 2u; }
    const size_t kstep = (size_t)(BK * 2);
    const size_t hstep = (size_t)HALF * K * 2;
    const size_t tstep = 2 * hstep;
    const size_t kstepA = g.a_gather ? (size_t)512 : kstep, hstepA = g.a_gather ? (size_t)262144 : hstep, tstepA = g.a_gather ? (size_t)524288 : tstep;
    const unsigned ldsw = (unsigned)wid * 1024u;
    const int aoff = lds_byte(wr * 64 + fr, fq * 8), boff = lds_byte(wc * 32 + fr, fq * 8);
#define PG8_SA(b, h) (((b) * 2 + (h)) * HTB)
#define PG8_SB(b, h) ((4 + (b) * 2 + (h)) * HTB)
#define PG8_STAGE(bufoff, gbase, voff) do { _Pragma("unroll") for (int _i = 0; _i < 2; ++_i) \
        __builtin_amdgcn_global_load_lds((const unsigned*)((const char*)(gbase) + (voff)[_i]), (PG8_LAS unsigned*)(lds + (bufoff) + ldsw + _i * 8192), 16, 0, 0); } while (0)
#define PG8_LDA(dst, b, h) do { _Pragma("unroll") for (int m = 0; m < 4; ++m) _Pragma("unroll") for (int k = 0; k < 2; ++k) dst[m][k] = *(const PG8_LAS bf16x8*)(lds + PG8_SA(b, h) + aoff + m * 2048 + k * 1024); } while (0)
#define PG8_LDB(dst, b, h) do { _Pragma("unroll") for (int n = 0; n < 2; ++n) _Pragma("unroll") for (int k = 0; k < 2; ++k) dst[n][k] = *(const PG8_LAS bf16x8*)(lds + PG8_SB(b, h) + boff + n * 2048 + k * 1024); } while (0)
#define PG8_MMA(ai, bj, At, Bt) do { __builtin_amdgcn_s_setprio(1); _Pragma("unroll") for (int m = 0; m < 4; ++m) _Pragma("unroll") for (int n = 0; n < 2; ++n) _Pragma("unroll") for (int k = 0; k < 2; ++k) \
        acc[ai][bj][m][n] = __builtin_amdgcn_mfma_f32_16x16x32_bf16(Bt[n][k], At[m][k], acc[ai][bj][m][n], 0, 0, 0); __builtin_amdgcn_s_setprio(0); } while (0)
#define PG8_WAIT_V(n) asm volatile("s_waitcnt vmcnt(" #n ")" ::: "memory")
#define PG8_WAIT_L(n) asm volatile("s_waitcnt lgkmcnt(" #n ")" ::: "memory")
#define PG8_BAR __builtin_amdgcn_s_barrier()
#define PG8_SCHED __builtin_amdgcn_sched_barrier(0)
    Unit cur, nxt; int ui = 0;
    if (!S.next(0, cur)) return;
    f32x4 acc[2][2][4][2];
#pragma unroll
    for (int a = 0; a < 2; ++a)
#pragma unroll
        for (int b = 0; b < 2; ++b)
#pragma unroll
            for (int m = 0; m < 4; ++m)
#pragma unroll
                for (int n = 0; n < 2; ++n) acc[a][b][m][n] = (f32x4){0.f, 0.f, 0.f, 0.f};
    bf16x8 At[4][2], B0[2][2], B1[2][2];
    const char* cA = (const char*)g.A + (size_t)cur.pm * tstepA; const char* cB = (const char*)g.Bt + (size_t)cur.pn * tstep;
    S.a_ready(cur);
    if constexpr (SP2) {
        PG8_STAGE(PG8_SB(0, 0), cB, voffB); PG8_STAGE(PG8_SB(0, 1), cB + hstep, voffB); PG8_STAGE(PG8_SA(0, 0), cA, voffA); PG8_STAGE(PG8_SA(0, 1), cA + hstepA, voffA);
        if (wr == 1) PG8_BAR;
        PG8_WAIT_V(2); PG8_BAR;
        PG8_STAGE(PG8_SB(1, 0), cB + kstep, voffB); PG8_STAGE(PG8_SA(1, 0), cA + kstepA, voffA); PG8_STAGE(PG8_SB(1, 1), cB + hstep + kstep, voffB);
        PG8_WAIT_V(6); PG8_BAR;
    } else {
        PG8_STAGE(PG8_SB(0, 0), cB, voffB); PG8_STAGE(PG8_SA(0, 0), cA, voffA); PG8_STAGE(PG8_SB(0, 1), cB + hstep, voffB); PG8_STAGE(PG8_SA(0, 1), cA + hstepA, voffA);
        if (wr == 1) PG8_BAR;
        PG8_WAIT_V(4); PG8_BAR;
        PG8_STAGE(PG8_SB(1, 0), cB + kstep, voffB); PG8_STAGE(PG8_SA(1, 0), cA + kstepA, voffA); PG8_STAGE(PG8_SB(1, 1), cB + hstep + kstep, voffB);
        PG8_WAIT_V(6); PG8_BAR;
    }
    for (;;) {
        const bool has_next = S.next(ui + 1, nxt);
        const char* nA = has_next ? (const char*)g.A + (size_t)nxt.pm * tstepA : cA; const char* nB = has_next ? (const char*)g.Bt + (size_t)nxt.pn * tstep : cB;
        for (int t = 0; t < nt; t += 2) {
            const bool last = (t == nt - 2);
            const char* a1 = cA + (size_t)(t + 1) * kstepA;
            const char* a2 = last ? nA : cA + (size_t)(t + 2) * kstepA; const char* b2 = last ? nB : cB + (size_t)(t + 2) * kstep;
            const char* a3 = a2 + kstepA; const char* b3 = b2 + kstep;
            if (last && has_next) S.a_ready(nxt);
            if constexpr (SP2) {
            PG8_LDB(B0, 0, 0); PG8_LDB(B1, 0, 1); PG8_SCHED; PG8_LDA(At, 0, 0); PG8_STAGE(PG8_SA(1, 1), a1 + hstepA, voffA);
            PG8_WAIT_V(8); PG8_WAIT_L(0); PG8_BAR; PG8_MMA(0, 0, At, B0); PG8_MMA(0, 1, At, B1); PG8_BAR; PG8_SCHED;
            PG8_LDA(At, 0, 1); PG8_STAGE(PG8_SB(0, 0), b2, voffB); PG8_STAGE(PG8_SB(0, 1), b2 + hstep, voffB); PG8_STAGE(PG8_SA(0, 0), a2, voffA);
            PG8_WAIT_V(8); PG8_WAIT_L(0); PG8_BAR; PG8_MMA(1, 0, At, B0); PG8_MMA(1, 1, At, B1); PG8_BAR; PG8_SCHED;
            PG8_LDB(B0, 1, 0); PG8_LDB(B1, 1, 1); PG8_SCHED; PG8_LDA(At, 1, 0); PG8_STAGE(PG8_SA(0, 1), a2 + hstepA, voffA);
            PG8_WAIT_V(8); PG8_WAIT_L(0); PG8_BAR; PG8_MMA(0, 0, At, B0); PG8_MMA(0, 1, At, B1); PG8_BAR; PG8_SCHED;
            PG8_LDA(At, 1, 1); PG8_STAGE(PG8_SB(1, 0), b3, voffB); PG8_STAGE(PG8_SB(1, 1), b3 + hstep, voffB); PG8_STAGE(PG8_SA(1, 0), a3, voffA);
            PG8_WAIT_V(8); PG8_WAIT_L(0); PG8_BAR; PG8_MMA(1, 0, At, B0); PG8_MMA(1, 1, At, B1); PG8_BAR; PG8_SCHED;
            } else {
            PG8_LDB(B0, 0, 0); PG8_SCHED; PG8_LDA(At, 0, 0); PG8_STAGE(PG8_SA(1, 1), a1 + hstepA, voffA);
            PG8_WAIT_L(8); PG8_BAR; PG8_WAIT_L(0); PG8_MMA(0, 0, At, B0); PG8_BAR; PG8_SCHED;
            PG8_LDB(B1, 0, 1); PG8_STAGE(PG8_SB(0, 0), b2, voffB);
            PG8_BAR; PG8_WAIT_L(0); PG8_MMA(0, 1, At, B1); PG8_BAR;
            PG8_LDA(At, 0, 1); PG8_STAGE(PG8_SA(0, 0), a2, voffA);
            PG8_BAR; PG8_WAIT_L(0); PG8_MMA(1, 0, At, B0); PG8_BAR; PG8_SCHED;
            PG8_STAGE(PG8_SB(0, 1), b2 + hstep, voffB);
            PG8_WAIT_V(6); PG8_BAR; PG8_MMA(1, 1, At, B1); PG8_BAR;
            PG8_LDB(B0, 1, 0); PG8_SCHED; PG8_LDA(At, 1, 0); PG8_STAGE(PG8_SA(0, 1), a2 + hstepA, voffA);
            PG8_WAIT_L(8); PG8_BAR; PG8_WAIT_L(0); PG8_MMA(0, 0, At, B0); PG8_BAR; PG8_SCHED;
            PG8_LDB(B1, 1, 1); PG8_STAGE(PG8_SB(1, 0), b3, voffB);
            PG8_BAR; PG8_WAIT_L(0); PG8_MMA(0, 1, At, B1); PG8_BAR;
            PG8_LDA(At, 1, 1); PG8_STAGE(PG8_SA(1, 0), a3, voffA);
            PG8_BAR; PG8_WAIT_L(0); PG8_MMA(1, 0, At, B0); PG8_BAR; PG8_SCHED;
            PG8_STAGE(PG8_SB(1, 1), b3 + hstep, voffB);
            PG8_WAIT_V(6); PG8_BAR; PG8_MMA(1, 1, At, B1); PG8_BAR;
            }
        }
        if constexpr (ALIGN_EPI) { if (wr == 0) PG8_BAR; }
        if constexpr (!Epi::AFTER_DRAIN) { E(acc, cur, wr, wc, fr, fq); S.done(cur); }
        if (!has_next) break;
#pragma unroll
        for (int a = 0; a < 2; ++a)
#pragma unroll
            for (int b = 0; b < 2; ++b)
#pragma unroll
                for (int m = 0; m < 4; ++m)
#pragma unroll
                    for (int n = 0; n < 2; ++n) acc[a][b][m][n] = (f32x4){0.f, 0.f, 0.f, 0.f};
        cur = nxt; cA = nA; cB = nB; ++ui;
        if constexpr (ALIGN_EPI) { if (wr == 1) PG8_BAR; }
    }
    PG8_WAIT_V(0);
    if constexpr (!ALIGN_EPI) { if (wr == 0) PG8_BAR; }
    PG8_BAR;
    if constexpr (Epi::AFTER_DRAIN) { E.fused(acc, cur, wr, wc, fr, fq, lds, wid, lane); S.done(cur); }
#undef PG8_SA
#undef PG8_SB
#undef PG8_STAGE
#undef PG8_LDA
#undef PG8_LDB
#undef PG8_MMA
#undef PG8_WAIT_V
#undef PG8_WAIT_L
#undef PG8_BAR
#undef PG8_SCHED
}
}

constexpr int NWAVES = 8;
constexpr int BATCH = 4, SEQ = 8192, DM = 1024, T = BATCH * SEQ, FF = 4096, NH = 16, HD = 64, NG = 4;
constexpr int NKVQ = 2816;
constexpr int PHI_ROWS = 8192;
constexpr size_t MiB = 1u << 20;
constexpr size_t WS_CTL = 0, CTL_ZERO_BYTES = 2 * MiB;
constexpr size_t WS_SS = 1 * MiB;
constexpr size_t WS_PHIB = WS_SS + 5 * 128 * 1024;
constexpr size_t WS_WIN = 2 * MiB, WS_WOUT = 8 * MiB, WS_W1 = 10 * MiB  , WS_W2 = 26 * MiB  , WS_WKVQ = 42 * MiB  , WS_WO = 48 * MiB, WS_PW1 = 50 * MiB  ;
constexpr size_t WS_KCMP = 53 * MiB, WS_VCMP = 54 * MiB;
constexpr size_t WS_PHIH = 56 * MiB;
constexpr size_t WS_XB = 64 * MiB;
constexpr size_t WS_H = 128 * MiB;
constexpr size_t WS_BG = 128 * MiB, WS_V = 192 * MiB;
constexpr size_t WS_KVQ = 128 * MiB, KVQ_TSTRIDE = (size_t)T * 256;
constexpr size_t WS_O = 448 * MiB;
constexpr size_t WS_SELM = 384 * MiB;
constexpr size_t WS_VT = 400 * MiB;
constexpr size_t WS_END = 512 * MiB;
static_assert(WS_KVQ + 11 * KVQ_TSTRIDE * 2 <= WS_H + (size_t)T * FF * 2 && WS_H + (size_t)T * FF * 2 <= 384 * MiB && WS_O + (size_t)T * 1024 * 2 <= WS_END, "ws map");
constexpr int CW_BAR = 4096;
constexpr int RING_OFF = 0, RING_BYTES = 131072;
constexpr int LDS_BYTES = 163840;
constexpr int LDSCTL_OFF = LDS_BYTES - 512, MISC_OFF = LDSCTL_OFF + 320;
#define GAS __attribute__((address_space(1)))
#define LAS __attribute__((address_space(3)))
typedef unsigned short bf16;
typedef unsigned v4u __attribute__((ext_vector_type(4)));
typedef float f32x4 __attribute__((ext_vector_type(4)));
typedef short bf16x8 __attribute__((ext_vector_type(8)));
typedef GAS unsigned gu32;
typedef GAS unsigned long long gu64;
#define RLX_AGENT __ATOMIC_RELAXED, __HIP_MEMORY_SCOPE_AGENT
#define LDS_WAIT() asm volatile("s_waitcnt lgkmcnt(0)" ::: "memory")
#define VM_WAIT() asm volatile("s_waitcnt vmcnt(0)" ::: "memory")
__device__ __forceinline__ unsigned long long rt() { return __builtin_amdgcn_s_memrealtime(); }
__device__ __forceinline__ unsigned f2bf(float f) { unsigned u = __builtin_bit_cast(unsigned, f); return (u + 0x7fffu + ((u >> 16) & 1u)) >> 16; }
__device__ __forceinline__ unsigned pk2(float lo, float hi) { return f2bf(lo) | (f2bf(hi) << 16); }

#define XB_TMO      128
#define XB_XCNT(j)  (256  + 64 * (j))
#define XB_XSUB(j)  (1280 + 64 * (j))
#define XB_XGEN(j)  (2304 + 64 * (j))
#define XB_TOP      3328
#define XB_TOPGEN   3392
#define XCD_BAR_WORDS 3456
#define XB_SPIN_CAP (1u << 18)

__device__ __forceinline__ unsigned xb_ld(unsigned* p)              { return __hip_atomic_load(p, __ATOMIC_RELAXED, __HIP_MEMORY_SCOPE_AGENT); }
__device__ __forceinline__ unsigned xb_add(unsigned* p, unsigned v) { return __hip_atomic_fetch_add(p, v, __ATOMIC_RELAXED, __HIP_MEMORY_SCOPE_AGENT); }
__device__ __forceinline__ unsigned xb_xcc_id() { return (unsigned)__builtin_amdgcn_s_getreg((3 << 11) | 20) & 0xFu; }
#define XB_SPIN(cond, bar) do { unsigned _sp = 0; while (cond) { __builtin_amdgcn_s_sleep(1); \
    if ((++_sp & 255u) == 0u) { if (xb_ld(&(bar)[XB_TMO])) break; if (_sp > XB_SPIN_CAP) { atomicAdd(&(bar)[XB_TMO], 1u); break; } } } } while (0)

struct XcdBarrier {
    unsigned* bar; unsigned x; unsigned G;
    volatile LAS unsigned* st;
};

__device__ __forceinline__ XcdBarrier xcd_barrier_post(unsigned* bar, volatile LAS unsigned* st, bool leader  , unsigned G  ) {
    XcdBarrier b; b.bar = bar; b.x = xb_xcc_id(); b.st = st; b.G = G;
    if (leader) (void)xb_add(&bar[XB_XCNT(b.x)], 1u);
    return b;
}
__device__ __forceinline__ void xcd_barrier_complete(unsigned* bar, unsigned x, unsigned& nloc, unsigned& nx, const unsigned G) {
    unsigned sum, cnt, mine, sp = 0u;
    for (;;) {
        sum = 0u; cnt = 0u; mine = 0u;
#pragma unroll
        for (unsigned j = 0; j < 16; ++j) { const unsigned c = xb_ld(&bar[XB_XCNT(j)]); sum += c; cnt += (c > 0u) ? 1u : 0u; mine = (j == x) ? c : mine; }
        if (sum == G) break;
        __builtin_amdgcn_s_sleep(1);
        if ((++sp & 255u) == 0u) { if (xb_ld(&bar[XB_TMO])) break; if (sp > XB_SPIN_CAP) { atomicAdd(&bar[XB_TMO], 1u); break; } }
    }
    nloc = mine > 0u ? mine : 1u; nx = cnt > 0u ? cnt : 1u;
}

__device__ __forceinline__ void xcd_barrier(const XcdBarrier& b, bool leader  ) {
    asm volatile("s_waitcnt vmcnt(0)" ::: "memory");
    __syncthreads();
    if (leader) {
        unsigned* bar = b.bar;
        __builtin_amdgcn_s_waitcnt(0);
        unsigned nloc = b.st[0], nx = b.st[1];
        if (nloc == 0u) { xcd_barrier_complete(bar, b.x, nloc, nx, b.G); b.st[0] = nloc; b.st[1] = nx; }
        const unsigned old = xb_add(&bar[XB_XSUB(b.x)], 1u);
        const unsigned gen = old / nloc;
        if (old + 1u == (gen + 1u) * nloc) {
            __builtin_amdgcn_fence(__ATOMIC_RELEASE, "agent");
            asm volatile("s_waitcnt vmcnt(0)" ::: "memory");
            const unsigned og = xb_add(&bar[XB_TOP], 1u);
            const unsigned tg = og / nx;
            if (og + 1u == (tg + 1u) * nx) xb_add(&bar[XB_TOPGEN], 1u);
            else XB_SPIN(xb_ld(&bar[XB_TOPGEN]) == tg, bar);
            __builtin_amdgcn_fence(__ATOMIC_ACQUIRE, "agent");
            xb_add(&bar[XB_XGEN(b.x)], 1u);
            asm volatile("s_waitcnt vmcnt(0)" ::: "memory");
        } else {
            XB_SPIN(xb_ld(&bar[XB_XGEN(b.x)]) == gen, bar);
            __builtin_amdgcn_fence(__ATOMIC_ACQUIRE, "agent");
            asm volatile("s_waitcnt vmcnt(0)" ::: "memory");
        }
    }
    __syncthreads();
}

struct Frame {
    LAS unsigned char* lds;
    volatile LAS unsigned* MISC;
    gu32* ctl;
    int tid, lane, wave;
    int vcu, G;
    const float* const* in;
    float* out; unsigned char* ws;
};
__device__ __forceinline__ float wave_sum(float v) {
#pragma unroll
    for (int o = 1; o < 64; o <<= 1) v += __shfl_xor(v, o);
    return v;
}
__device__ __forceinline__ float wave_max(float v) {
#pragma unroll
    for (int o = 1; o < 64; o <<= 1) v = fmaxf(v, __shfl_xor(v, o));
    return v;
}
__device__ __forceinline__ float bf2f(unsigned short b) { return __uint_as_float(((unsigned)b) << 16); }
__device__ __forceinline__ float bflo(unsigned w) { return __uint_as_float(w << 16); }
__device__ __forceinline__ float bfhi(unsigned w) { return __uint_as_float(w & 0xffff0000u); }

__device__ __forceinline__ void p0_transpose_item(const float* W, int ldw, int nvalid, const float* gain, float scale, bf16* WT, int K, int drow, int k0, int n0, LAS float* scr, int lane) {
    float wv[32];
#pragma unroll
    for (int i = 0; i < 32; ++i) { const int kk = 2 * i + (lane >> 5), n = n0 + (lane & 31); wv[i] = (n < nvalid) ? W[(size_t)(k0 + kk) * ldw + n] : 0.f; }
#pragma unroll
    for (int i = 0; i < 32; ++i) { const int kk = 2 * i + (lane >> 5); float v = wv[i]; if (gain) v *= gain[k0 + kk]; scr[kk * 33 + (lane & 31)] = v * scale; }
    LDS_WAIT(); asm volatile("" ::: "memory");
    const int c = lane & 7;
#pragma unroll
    for (int j = 0; j < 4; ++j) { const int n = (lane >> 3) + 8 * j; const LAS float* s = scr + (8 * c) * 33 + n;
        v4u o; o.x = pk2(s[0 * 33], s[1 * 33]); o.y = pk2(s[2 * 33], s[3 * 33]); o.z = pk2(s[4 * 33], s[5 * 33]); o.w = pk2(s[6 * 33], s[7 * 33]);
        *(GAS v4u*)(WT + (size_t)(drow + n) * K + k0 + 8 * c) = o; }
    LDS_WAIT(); asm volatile("" ::: "memory");
}
struct MatSpec { const float* W; int K, ldw, nvalid, niter; const float* gain; bf16* WT; int kind; };
__device__ __forceinline__ void p0_matrix_item(const MatSpec& m, int item, LAS float* scr, int lane) {
    const int nblk = m.niter / 32, kb = item / nblk, nb = item % nblk, k0 = 64 * kb, n0 = 32 * nb;
    int drow = n0; float scale = 1.f;
    if (m.kind == 1) { if (n0 >= 1024) { const int isu = n0 >= 2048, j = n0 - (isu ? 2048 : 1024); drow = 1024 + (j >> 7) * 256 + isu * 128 + (j & 127); } }
    else if (m.kind == 2) { if (n0 < 1024) { drow = 1536 + n0; scale = 0.125f; } else drow = 2560 + (n0 - 1024); }
    p0_transpose_item(m.W, m.ldw, m.nvalid, m.gain, scale, m.WT, m.K, drow, k0, n0, scr, lane);
}
__device__ __forceinline__ void p0_prologue(Frame& F) {
    LAS float* scr = (LAS float*)(F.lds + RING_OFF + F.wave * 16384);
    const int gw = F.vcu * NWAVES + F.wave, NGW = F.G * NWAVES;
    unsigned char* ws = F.ws;
    int it = gw;
#define DO_MAT(...) do { const MatSpec m_ = MatSpec{__VA_ARGS__}; const int n_ = (m_.K / 64) * (m_.niter / 32); _Pragma("unroll 1") for (; it < n_; it += NGW) p0_matrix_item(m_, it, scr, F.lane); it -= n_; } while (0)
    DO_MAT(F.in[6],  1024, 3072, 3072, 3072, F.in[2],           (bf16*)(ws + WS_WIN), 1);
    DO_MAT(F.in[8],  1024, 1024, 1024, 1024, nullptr,           (bf16*)(ws + WS_WOUT), 0);
    DO_MAT(F.in[4],  1024, 4096, 4096, 4096, F.in[3],           (bf16*)(ws + WS_W1), 0);
    DO_MAT(F.in[4] + (size_t)1024 * 4096, 1024, 4096, 4096, 4096, F.in[3] + 1024, (bf16*)(ws + WS_W1 + 8 * MiB), 0);
    DO_MAT(F.in[5],  4096, 1024, 1024, 1024, nullptr,           (bf16*)(ws + WS_W2), 0);
    DO_MAT(F.in[5] + (size_t)4096 * 1024, 4096, 1024, 1024, 1024, nullptr, (bf16*)(ws + WS_W2 + 8 * MiB), 0);
    DO_MAT(F.in[10], 1024, 1536, 1536, 1536, F.in[9],           (bf16*)(ws + WS_WKVQ), 0);
    DO_MAT(F.in[17], 1024, 1072, 1072, 1280, F.in[2] + 1024,    (bf16*)(ws + WS_WKVQ), 2);
    DO_MAT(F.in[18], 1024, 1024, 1024, 1024, nullptr,           (bf16*)(ws + WS_WO), 0);
    DO_MAT(F.in[13], 2048, 256, 256, 256, nullptr,              (bf16*)(ws + WS_PW1), 0);
    DO_MAT(F.in[15], 2048, 256, 256, 256, nullptr,              (bf16*)(ws + WS_PW1 + 1 * MiB), 0);
#undef DO_MAT
    { bf16* XB = (bf16*)(ws + WS_XB); float* ss0 = (float*)(ws + WS_SS);
      for (int m = gw; m < T; m += 2 * NGW) { const int m2 = m + NGW;
          const GAS f32x4* xr = (const GAS f32x4*)(F.in[0] + (size_t)m * DM) + F.lane; const GAS f32x4* xr2 = (const GAS f32x4*)(F.in[0] + (size_t)m2 * DM) + F.lane;
          GAS unsigned long long* o8 = (GAS unsigned long long*)(XB + (size_t)m * DM) + F.lane; GAS unsigned long long* o82 = (GAS unsigned long long*)(XB + (size_t)m2 * DM) + F.lane;
          f32x4 va[4], vb[4];
#pragma unroll
          for (int j = 0; j < 4; ++j) { va[j] = xr[64 * j]; vb[j] = xr2[64 * j]; }
          float s = 0.f, s2 = 0.f;
#pragma unroll
          for (int j = 0; j < 4; ++j) { const f32x4 v = va[j], w = vb[j];
              const unsigned long long pa = (unsigned long long)pk2(v.x, v.y) | ((unsigned long long)pk2(v.z, v.w) << 32), pb = (unsigned long long)pk2(w.x, w.y) | ((unsigned long long)pk2(w.z, w.w) << 32);
              o8[64 * j] = pa; o82[64 * j] = pb;
              const float a0 = bflo((unsigned)pa), a1 = bfhi((unsigned)pa), a2 = bflo((unsigned)(pa >> 32)), a3 = bfhi((unsigned)(pa >> 32)); s += (a0 * a0 + a1 * a1) + (a2 * a2 + a3 * a3);
              const float b0 = bflo((unsigned)pb), b1 = bfhi((unsigned)pb), b2 = bflo((unsigned)(pb >> 32)), b3 = bfhi((unsigned)(pb >> 32)); s2 += (b0 * b0 + b1 * b1) + (b2 * b2 + b3 * b3); }
          s = wave_sum(s); s2 = wave_sum(s2); if (F.lane == 0) { ss0[m] = s; ss0[m2] = s2; } } }
    { float* pb = (float*)(ws + WS_PHIB);
      for (int task = gw; task < 2 * 32 * 4; task += NGW) { const int side = task >> 7, kc = (task >> 2) & 31, cc = task & 3; const float* pe = F.in[side ? 12 : 11]; const float* w1 = F.in[side ? 15 : 13]; float a = 0.f;
          for (int kk = kc * 64; kk < kc * 64 + 64; ++kk) a += pe[kk] * w1[(size_t)kk * 256 + cc * 64 + F.lane];
          atomicAdd(pb + side * 256 + cc * 64 + F.lane, a); } }
}
__device__ __forceinline__ void conv_gate_phase(Frame& F) {
    bf16* BG = (bf16*)(F.ws + WS_BG); const bf16* V = (const bf16*)(F.ws + WS_V); const float* cw = F.in[7];
    const bool grp = (F.G == 256); const int rbase = grp ? (F.vcu >> 5) * 4096 * 128 : 0, nit = grp ? 4096 * 128 : T * 128;
    const int gt = (grp ? (F.vcu & 31) : F.vcu) * (NWAVES * 64) + F.tid, NGT = (grp ? 32 : F.G) * NWAVES * 64;
    const int c0 = (gt & 127) * 8;
    float w0[8], w1[8], w2[8];
#pragma unroll
    for (int j = 0; j < 8; ++j) { w0[j] = cw[c0 + j]; w1[j] = cw[1024 + c0 + j]; w2[j] = cw[2048 + c0 + j]; }
    const v4u z = {0u, 0u, 0u, 0u};
    for (int it = gt; it < nit; it += 2 * NGT) { const int rowa = (rbase + it) >> 7, rowb = (rbase + it + NGT) >> 7, ta = rowa & (SEQ - 1), tb = rowb & (SEQ - 1);
        const v4u a2 = *(const v4u*)(V + (size_t)rowa * 1024 + c0), a1 = ta >= 1 ? *(const v4u*)(V + (size_t)(rowa - 1) * 1024 + c0) : z, a0 = ta >= 2 ? *(const v4u*)(V + (size_t)(rowa - 2) * 1024 + c0) : z, ba = *(const v4u*)(BG + (size_t)rowa * 1024 + c0);
        const v4u b2 = *(const v4u*)(V + (size_t)rowb * 1024 + c0), b1 = tb >= 1 ? *(const v4u*)(V + (size_t)(rowb - 1) * 1024 + c0) : z, b0 = tb >= 2 ? *(const v4u*)(V + (size_t)(rowb - 2) * 1024 + c0) : z, bb = *(const v4u*)(BG + (size_t)rowb * 1024 + c0);
        v4u oa, ob;
#pragma unroll
        for (int j = 0; j < 4; ++j) {
            oa[j] = pk2(bflo(ba[j]) * (w0[2 * j] * bflo(a0[j]) + w1[2 * j] * bflo(a1[j]) + w2[2 * j] * bflo(a2[j])), bfhi(ba[j]) * (w0[2 * j + 1] * bfhi(a0[j]) + w1[2 * j + 1] * bfhi(a1[j]) + w2[2 * j + 1] * bfhi(a2[j])));
            ob[j] = pk2(bflo(bb[j]) * (w0[2 * j] * bflo(b0[j]) + w1[2 * j] * bflo(b1[j]) + w2[2 * j] * bflo(b2[j])), bfhi(bb[j]) * (w0[2 * j + 1] * bfhi(b0[j]) + w1[2 * j + 1] * bfhi(b1[j]) + w2[2 * j + 1] * bfhi(b2[j]))); }
        *(v4u*)(BG + (size_t)rowa * 1024 + c0) = oa; *(v4u*)(BG + (size_t)rowb * 1024 + c0) = ob; }
}
__device__ __forceinline__ void phi2_phase(Frame& F, int task0, int tstep, int tend) {
    LAS float* hs = (LAS float*)(F.lds + RING_OFF + F.wave * 8192);
    for (int task = task0; task < tend; task += tstep) { const int side = task / (PHI_ROWS / 8), r0 = (task % (PHI_ROWS / 8)) * 8;
        const bf16* H = (const bf16*)(F.ws + WS_PHIH) + (size_t)side * PHI_ROWS * 256 + (size_t)r0 * 256; const float* w2 = F.in[side ? 16 : 14];
#pragma unroll
        for (int j = 0; j < 4; ++j) { const v4u w = *(const v4u*)(H + F.lane * 32 + j * 8);
#pragma unroll
            for (int q = 0; q < 4; ++q) { hs[F.lane * 32 + j * 8 + 2 * q] = bflo(w[q]); hs[F.lane * 32 + j * 8 + 2 * q + 1] = bfhi(w[q]); } }
        LDS_WAIT(); asm volatile("" ::: "memory");
        float acc[8] = {0.f, 0.f, 0.f, 0.f, 0.f, 0.f, 0.f, 0.f};
        for (int c = 0; c < 256; c += 4) { const float wa = w2[(c + 0) * 64 + F.lane], wb = w2[(c + 1) * 64 + F.lane], wc = w2[(c + 2) * 64 + F.lane], wd = w2[(c + 3) * 64 + F.lane];
#pragma unroll
            for (int i = 0; i < 8; ++i) { const f32x4 h = *(const LAS f32x4*)(hs + i * 256 + c); acc[i] += h.x * wa + h.y * wb + h.z * wc + h.w * wd; } }
        bf16* O = (bf16*)(F.ws + (side ? WS_VCMP : WS_KCMP));
#pragma unroll
        for (int i = 0; i < 8; ++i) O[(size_t)(r0 + i) * 64 + F.lane] = (bf16)f2bf(acc[i]);
        LDS_WAIT(); asm volatile("" ::: "memory"); }
}
__device__ __forceinline__ void vsel_transpose_phase(Frame& F, int task0, int tstep) {
    LAS unsigned short* ts = (LAS unsigned short*)(F.lds + RING_OFF + F.wave * 16384);
    const int lane = F.lane;
    const bf16* VSEL = (const bf16*)(F.ws + WS_KVQ) + 3 * KVQ_TSTRIDE; bf16* VT = (bf16*)(F.ws + WS_VT);
    const int key = lane, s = key >> 5, k5 = key & 31, e = ((k5 >> 4) << 2) | (k5 & 3), q4 = (k5 >> 2) & 3, slot = 32 * s + 8 * q4 + e;
    for (int task = task0; task < BATCH * NG * 128; task += tstep) { const int blk = task & 127, g = (task >> 7) & 3, b = task >> 9;
        const v4u* src = (const v4u*)(VSEL + ((size_t)b * SEQ + 64 * blk + key) * 256 + g * 64);
#pragma unroll
        for (int c = 0; c < 8; ++c) { const v4u w = src[c];
#pragma unroll
            for (int q = 0; q < 4; ++q) { ts[(8 * c + 2 * q) * 72 + slot] = (unsigned short)(w[q] & 0xffffu); ts[(8 * c + 2 * q + 1) * 72 + slot] = (unsigned short)(w[q] >> 16); } }
        LDS_WAIT(); asm volatile("" ::: "memory");
        v4u* dst = (v4u*)(VT + (size_t)task * 4096 + lane * 64);
#pragma unroll
        for (int c = 0; c < 8; ++c) dst[c] = *(const LAS v4u*)(ts + lane * 72 + 8 * c);
        LDS_WAIT(); asm volatile("" ::: "memory"); }
}
__device__ __forceinline__ void final_norm_phase(Frame& F) {
    const bool grp = (F.G == 256); const int mbase = grp ? (F.vcu >> 5) * 4096 : 0, mend = grp ? mbase + 4096 : T;
    const int gw = mbase + (grp ? (F.vcu & 31) : F.vcu) * NWAVES + F.wave, NGW = (grp ? 32 : F.G) * NWAVES; const float* ss = (const float*)(F.ws + WS_SS) + 4 * T; const float* gn = F.in[19]; const bf16* XB = (const bf16*)(F.ws + WS_XB);
    f32x4 g4[4];
#pragma unroll
    for (int j = 0; j < 4; ++j) g4[j] = *((const f32x4*)gn + F.lane + 64 * j);
    for (int m = gw; m < mend; m += 2 * NGW) { const int m2 = m + NGW;
        GAS f32x4* xr = (GAS f32x4*)(F.out + (size_t)m * DM) + F.lane; GAS f32x4* xr2 = (GAS f32x4*)(F.out + (size_t)m2 * DM) + F.lane;
        const GAS unsigned long long* xs = (const GAS unsigned long long*)(XB + (size_t)m * DM) + F.lane; const GAS unsigned long long* xs2 = (const GAS unsigned long long*)(XB + (size_t)m2 * DM) + F.lane;
        unsigned long long wa[4], wb[4];
#pragma unroll
        for (int j = 0; j < 4; ++j) { wa[j] = xs[64 * j]; wb[j] = xs2[64 * j]; }
        const float rs = __builtin_amdgcn_rsqf(ss[m] * (1.0f / 1024.0f) + 1e-6f), rs2 = __builtin_amdgcn_rsqf(ss[m2] * (1.0f / 1024.0f) + 1e-6f);
#pragma unroll
        for (int j = 0; j < 4; ++j) { f32x4 v = (f32x4){bflo((unsigned)wa[j]), bfhi((unsigned)wa[j]), bflo((unsigned)(wa[j] >> 32)), bfhi((unsigned)(wa[j] >> 32))}; xr[64 * j] = v * rs * g4[j];
            f32x4 w = (f32x4){bflo((unsigned)wb[j]), bfhi((unsigned)wb[j]), bflo((unsigned)(wb[j] >> 32)), bfhi((unsigned)(wb[j] >> 32))}; xr2[64 * j] = w * rs2 * g4[j]; } }
}

__device__ __forceinline__ int t5_bucket_dev(int d) {
    if (d < 16) return d;
    int b = 16;
    b += (d >= 19); b += (d >= 21); b += (d >= 24); b += (d >= 27); b += (d >= 31); b += (d >= 35); b += (d >= 40); b += (d >= 46);
    b += (d >= 52); b += (d >= 59); b += (d >= 67); b += (d >= 77); b += (d >= 87); b += (d >= 99); b += (d >= 113);
    return b;
}
__device__ __forceinline__ void build_bias_table(Frame& F, LAS float* BT) {
    for (int i = F.tid; i < 128 * 16; i += NWAVES * 64) BT[i] = F.in[1][t5_bucket_dev(i >> 4) * 16 + (i & 15)];
}
__device__ __forceinline__ void attn_naive_phase(Frame& F, bf16* O) {
    LAS float* BT = (LAS float*)(F.lds + RING_OFF);
    LAS float* qs = (LAS float*)(F.lds + RING_OFF + 8192 + F.wave * 4096);
    LAS float* imp = qs + 256;
    LAS int* selb = (LAS int*)(imp + 512);
    LAS float* MC = (LAS float*)(selb + 16);
    LAS float* LG = (LAS float*)(F.lds + RING_OFF + 8192 + 8 * 4096 + F.wave * 8192);
    build_bias_table(F, BT);
    __syncthreads();
    const bf16* KVQ = (const bf16*)(F.ws + WS_KVQ);
    const bf16* GATES = KVQ + 10 * KVQ_TSTRIDE; const bf16* KCMP = (const bf16*)(F.ws + WS_KCMP); const bf16* VCMP = (const bf16*)(F.ws + WS_VCMP);
    const int gw = F.vcu * NWAVES + F.wave, NGW = F.G * NWAVES, lane0 = F.lane;
#pragma unroll 1
    for (int task = gw; task < T * NG; task += NGW) {
        int lane = lane0; asm volatile("" : "+v"(lane));
        const int row = task >> 2, g = task & 3, b = row >> 13, pos = row & (SEQ - 1);
        { const bf16* qp = KVQ + (size_t)(6 + g) * KVQ_TSTRIDE + (size_t)row * 256 + lane * 4; const unsigned long long w = *(const unsigned long long*)qp;
          qs[lane * 4 + 0] = bflo((unsigned)w); qs[lane * 4 + 1] = bfhi((unsigned)w); qs[lane * 4 + 2] = bflo((unsigned)(w >> 32)); qs[lane * 4 + 3] = bfhi((unsigned)(w >> 32)); }
        LDS_WAIT(); asm volatile("" ::: "memory");
        const int nv = pos >= 31 ? ((pos - 31) >> 4) + 1 : 0;
        float oacc[4] = {0.f, 0.f, 0.f, 0.f};
#pragma unroll 1
        for (int br = 0; br < 3; ++br) {
            const bf16* Kt = br == 0 ? KCMP : KVQ + (size_t)(br == 1 ? 2 : 4) * KVQ_TSTRIDE; const bf16* Vt = br == 0 ? VCMP : KVQ + (size_t)(br == 1 ? 3 : 5) * KVQ_TSTRIDE;
            const int nc = br == 0 ? (nv + 63) >> 6 : (br == 1 ? 16 : 8);
            float m[4] = {-1e30f, -1e30f, -1e30f, -1e30f}, Z[4] = {0.f, 0.f, 0.f, 0.f}, o[4] = {0.f, 0.f, 0.f, 0.f};
#pragma unroll 1
            for (int c = 0; c < nc; ++c) { asm volatile("" ::: "memory");
                int ridx, dist; bool valid;
                if (br == 0) { const int n = c * 64 + lane; ridx = b * 512 + n; dist = pos - 16 * n - 31; valid = n < nv; }
                else if (br == 1) { const int bk = selb[c]; const int tok = bk * 64 + lane; ridx = b * SEQ + tok; dist = pos - tok; valid = (bk >= 0) && dist >= 0; }
                else { const int kp = pos - 511 + c * 64 + lane; ridx = b * SEQ + kp; dist = pos - kp; valid = kp >= 0; }
                const unsigned long long vmask = __ballot(valid);
                if (vmask == 0ull) continue;
                float l[4] = {0.f, 0.f, 0.f, 0.f};
                if (valid) { const v4u* kr = (const v4u*)(Kt + (size_t)ridx * 256 + g * 64);
#pragma unroll 2
                    for (int j = 0; j < 8; ++j) { asm volatile("" ::: "memory"); const v4u w = kr[j]; float f[8];
#pragma unroll
                        for (int q = 0; q < 4; ++q) { f[2 * q] = bflo(w[q]); f[2 * q + 1] = bfhi(w[q]); }
#pragma unroll
                        for (int h = 0; h < 4; ++h) { const f32x4 qa = *(const LAS f32x4*)(qs + h * 64 + 8 * j), qb = *(const LAS f32x4*)(qs + h * 64 + 8 * j + 4);
                            l[h] += (f[0] * qa.x + f[1] * qa.y) + (f[2] * qa.z + f[3] * qa.w) + (f[4] * qb.x + f[5] * qb.y) + (f[6] * qb.z + f[7] * qb.w); } }
                    const int dd = dist < 127 ? dist : 127;
#pragma unroll
                    for (int h = 0; h < 4; ++h) l[h] += BT[dd * 16 + g * 4 + h]; }
                float p[4];
#pragma unroll
                for (int h = 0; h < 4; ++h) { const float lv = valid ? l[h] : -1e30f; const float mn = fmaxf(m[h], wave_max(lv)); const float sc = __expf(m[h] - mn);
                    p[h] = valid ? __expf(lv - mn) : 0.f; Z[h] = Z[h] * sc + wave_sum(p[h]); o[h] *= sc; m[h] = mn; }
                if (br == 0) {
#pragma unroll
                    for (int h = 0; h < 4; ++h) { LG[h * 512 + c * 64 + lane] = p[h]; if (lane == 0) MC[c * 4 + h] = m[h]; } }
                unsigned long long vm = vmask;
                while (vm) { const int ll = __builtin_ctzll(vm); vm &= vm - 1ull;
                    const int r = __builtin_amdgcn_readlane(ridx, ll); const float v = bf2f(Vt[(size_t)r * 256 + g * 64 + lane]);
#pragma unroll
                    for (int h = 0; h < 4; ++h) o[h] += __uint_as_float(__builtin_amdgcn_readlane(__float_as_uint(p[h]), ll)) * v; } }
            { const bf16* gp = GATES + (size_t)row * 256 + g * 12 + br;
#pragma unroll
              for (int h = 0; h < 4; ++h) { const float zi = Z[h] > 0.f ? 1.0f / Z[h] : 0.f; Z[h] = zi; oacc[h] += bf2f(gp[h * 3]) * o[h] * zi; } }
            if (br == 0) {
                LDS_WAIT(); asm volatile("" ::: "memory");
#pragma unroll 1
                for (int c = 0; c < 8; ++c) { const int n = c * 64 + lane; float s = 0.f;
                    if (c < nc) {
#pragma unroll
                        for (int h = 0; h < 4; ++h) s += LG[h * 512 + n] * __expf(MC[c * 4 + h] - m[h]) * Z[h]; }
                    imp[n] = s; }
                LDS_WAIT(); asm volatile("" ::: "memory");
                unsigned khi[2], klo[2]; const int cb = pos >> 6;
#pragma unroll
                for (int k = 0; k < 2; ++k) { const int j = lane + 64 * k; float s = 2.0f * (imp[4 * j] + imp[4 * j + 1] + imp[4 * j + 2]) + imp[4 * j + 3]; if (j > 0) s += imp[4 * j - 1];
                    const bool forced = (j == 0) || (j == cb) || (j == cb - 1), future = j > cb; const float sc = forced ? 1e9f : s;
                    khi[k] = future ? 0u : (__float_as_uint(sc) + 1u); klo[k] = 128u - (unsigned)j; }
                LDS_WAIT(); asm volatile("" ::: "memory");
#pragma unroll 1
                for (int i = 0; i < 16; ++i) { unsigned h, l; const bool first = (khi[0] > khi[1]) || (khi[0] == khi[1] && klo[0] > klo[1]); h = first ? khi[0] : khi[1]; l = first ? klo[0] : klo[1];
#pragma unroll
                    for (int off = 1; off < 64; off <<= 1) { const unsigned oh = __shfl_xor(h, off), ol = __shfl_xor(l, off); if (oh > h || (oh == h && ol > l)) { h = oh; l = ol; } }
                    h = __builtin_amdgcn_readfirstlane(h); l = __builtin_amdgcn_readfirstlane(l);
                    if (lane == 0) selb[i] = (h != 0u) ? 128 - (int)l : -1;
#pragma unroll
                    for (int k = 0; k < 2; ++k) if (klo[k] == l) { khi[k] = 0u; klo[k] = 0u; } }
                LDS_WAIT(); asm volatile("" ::: "memory");
            }
        }
#pragma unroll
        for (int h = 0; h < 4; ++h) O[(size_t)row * 1024 + (g * 4 + h) * 64 + lane] = (bf16)f2bf(oacc[h]);
    }
}

namespace nsa {
typedef float f32x16 __attribute__((ext_vector_type(16)));
typedef short s16x4 __attribute__((ext_vector_type(4)));
typedef short v4i16_t __attribute__((ext_vector_type(4)));
constexpr float LOG2E = 1.4426950408889634f, MASKV = -3.0e30f, MINIT = -1.0e30f;
constexpr int KSTR = 144, VSTR = 136, KVBUF = 64 * KSTR + 64 * VSTR;
constexpr int L_KV = 0, L_SC = 35840, L_TB = 72704, L_WSF = L_TB + 8320, L_SELM = L_WSF + 2048, L_NMREF = L_SELM + 1024, L_GS = L_NMREF + 1024, L_FLAG = L_GS + 1024, L_QS = L_FLAG + 128, QS_STR = 144, L_PO = L_QS + 256 * QS_STR, L_G2 = L_PO + 256 * 128, L_LSD = L_G2 + 2048, L_END = L_LSD + 1024;
constexpr int SG = 2, ST_RSTR = 136, ST_LVAL = 256 * ST_RSTR, ST_TAGS = ST_LVAL + 1024, L_ST = 0, STBUF = ST_TAGS + 64;
constexpr int L_ZERO = 2 * STBUF;
static_assert(L_SC + 64 * 128 * 4 <= L_TB && L_ZERO + 4 * ST_RSTR + 16 <= L_TB && L_ZERO % 16 == 0 && (4 * ST_RSTR) % 16 == 0 && L_END <= 163328, "attention LDS map");
constexpr int LSTR = 400;
constexpr int TBN = 130;
__device__ __forceinline__ int crow(int r, int hi) { return (r & 3) + 8 * (r >> 2) + 4 * hi; }
__device__ __forceinline__ float swap_other(float x, int hi) { auto rr = __builtin_amdgcn_permlane32_swap(__float_as_uint(x), __float_as_uint(x), false, false); return hi ? __uint_as_float(rr[0]) : __uint_as_float(rr[1]); }
#define NSA_DPP(x, ctrl) __uint_as_float((unsigned)__builtin_amdgcn_update_dpp(0, (int)__float_as_uint(x), ctrl, 0xF, 0xF, true))
#define NSA_DPPU(x, ctrl) ((unsigned)__builtin_amdgcn_update_dpp(0, (int)(x), ctrl, 0xF, 0xF, true))
__device__ __forceinline__ unsigned cvtpk(float lo, float hi) { typedef float f2 __attribute__((ext_vector_type(2))); typedef __bf16 b2 __attribute__((ext_vector_type(2))); f2 v = {lo, hi}; b2 b = __builtin_convertvector(v, b2); return __builtin_bit_cast(unsigned, b); }

struct TileRegs { v4u k, v; };
__device__ __forceinline__ void tile_load(TileRegs& R, const bf16* Kt, const bf16* Vt, long row0, long rowmax, int tid) {
    long r = row0 + (tid >> 3); r = r < 0 ? 0 : (r > rowmax ? rowmax : r);
    R.k = *(const v4u*)(Kt + r * 256 + (tid & 7) * 8); R.v = *(const v4u*)(Vt + r * 256 + (tid & 7) * 8);
}
__device__ __forceinline__ void tile_store(const TileRegs& R, LAS unsigned char* buf, int tid) {
    *(LAS v4u*)(buf + (tid >> 3) * KSTR + (tid & 7) * 16) = R.k;
    typedef unsigned u2 __attribute__((ext_vector_type(2)));
    LAS unsigned char* vp = buf + 64 * KSTR + (tid >> 3) * VSTR + (tid & 7) * 16;
    *(LAS u2*)vp = (u2){R.v.x, R.v.y}; *(LAS u2*)(vp + 8) = (u2){R.v.z, R.v.w};
}
__device__ __forceinline__ void qkt(f32x16& p0, f32x16& p1, const LAS unsigned char* buf, const LAS unsigned char* qrow  , int r32, int hi) {
    const LAS unsigned char* kb = buf + r32 * KSTR + hi * 16;
    p0 = f32x16{}; p1 = f32x16{};
#pragma unroll
    for (int d0 = 0; d0 < 4; ++d0) { const bf16x8 a0 = *(const LAS bf16x8*)(kb + d0 * 32), a1 = *(const LAS bf16x8*)(kb + 32 * KSTR + d0 * 32), qf = *(const LAS bf16x8*)(qrow + d0 * 32);
        p0 = __builtin_amdgcn_mfma_f32_32x32x16_bf16(a0, qf, p0, 0, 0, 0); p1 = __builtin_amdgcn_mfma_f32_32x32x16_bf16(a1, qf, p1, 0, 0, 0); }
}
__device__ __forceinline__ s16x4 vtr(const LAS unsigned char* p) { return __builtin_bit_cast(s16x4, __builtin_amdgcn_ds_read_tr16_b64_v4i16((LAS v4i16_t*)p)); }
__device__ __forceinline__ void pv(f32x16 (&o)[2], const LAS unsigned char* buf, const unsigned (&pw)[16], int lane) {
    const int hi = lane >> 5; const LAS unsigned char* vb = buf + 64 * KSTR + (((lane & 15) >> 2) + 4 * hi) * VSTR + (lane & 3) * 8 + ((lane >> 4) & 1) * 32;
#pragma unroll
    for (int s = 0; s < 4; ++s) { const bf16x8 pa = __builtin_bit_cast(bf16x8, (v4u){pw[4 * s], pw[4 * s + 1], pw[4 * s + 2], pw[4 * s + 3]});
#pragma unroll
        for (int d0 = 0; d0 < 2; ++d0) { const s16x4 lo = vtr(vb + (16 * s) * VSTR + d0 * 64), hh = vtr(vb + (16 * s + 8) * VSTR + d0 * 64);
            const bf16x8 vf = (bf16x8){lo[0], lo[1], lo[2], lo[3], hh[0], hh[1], hh[2], hh[3]};
            o[d0] = __builtin_amdgcn_mfma_f32_32x32x16_bf16(pa, vf, o[d0], 0, 0, 0); } }
}
__device__ __forceinline__ float rowmax32(const f32x16& p0, const f32x16& p1, int hi) {
    float a = fmaxf(p0[0], p1[0]);
#pragma unroll
    for (int r = 1; r < 16; ++r) a = fmaxf(a, fmaxf(p0[r], p1[r]));
    return fmaxf(a, swap_other(a, hi));
}
template <int MULT, bool FAR>
__device__ __forceinline__ void bias_mask(f32x16& p0, f32x16& p1, int dl, const LAS float* tbl  ) {
#pragma unroll
    for (int r = 0; r < 16; ++r) { const int c = (r & 3) + 8 * (r >> 2);
        const int d0 = dl - MULT * c, d1 = dl - MULT * (c + 32);
        const int i0 = min(max(d0, -1), 128) + 1, i1 = min(max(d1, -1), 128) + 1;
        float b0 = tbl[i0 * 16], b1 = tbl[i1 * 16];
        if (FAR) { if (d0 >= 512) b0 = MASKV; if (d1 >= 512) b1 = MASKV; }
        p0[r] += b0; p1[r] += b1;
        if ((r & 3) == 3) asm volatile("" ::: "memory"); }
}
__device__ __forceinline__ void row_to_regs(float (&fr)[16], float f, LAS float* wsf, int r32, int hi) {
    if (hi == 0) wsf[r32] = f;
    asm volatile("s_waitcnt lgkmcnt(0)" ::: "memory");
#pragma unroll
    for (int r = 0; r < 16; ++r) fr[r] = wsf[crow(r, hi)];
    asm volatile("s_waitcnt lgkmcnt(0)" ::: "memory");
}
}

#ifndef TSEC
#define TSEC 0
#endif
#define TSB(id) do { if (TSEC == (id)) ts0_ = __builtin_amdgcn_s_memrealtime(); } while (0)
#define TSE(id) do { if (TSEC == (id)) tacc_ += __builtin_amdgcn_s_memrealtime() - ts0_; } while (0)
__device__ __forceinline__ void attn_dense_phase(Frame& F) {
    using namespace nsa;
    unsigned long long ts0_ = 0, tacc_ = 0; (void)ts0_;
    LAS unsigned char* L = F.lds + RING_OFF;
    LAS float* TB = (LAS float*)(L + L_TB); LAS float* wsf = (LAS float*)(L + L_WSF) + F.wave * 64; LAS float* SC = (LAS float*)(L + L_SC); LAS unsigned* SELM = (LAS unsigned*)(L + L_SELM);
    const int wave = F.wave;
    for (int i = F.tid; i < TBN * 16; i += NWAVES * 64) { const int idx = i >> 4, hh = i & 15; float v;
        if (idx == 0) v = MASKV; else if (idx == 129) v = 0.f; else v = F.in[1][t5_bucket_dev(idx - 1) * 16 + hh] - F.in[1][31 * 16 + hh];
        TB[i] = v; }
    for (int i = F.tid; i < (4 * ST_RSTR + 16) / 4; i += NWAVES * 64) ((LAS unsigned*)(L + L_ZERO))[i] = 0u;
    __syncthreads();
    const bf16* KVQ = (const bf16*)(F.ws + WS_KVQ); const bf16* GATES = KVQ + 10 * KVQ_TSTRIDE;
    const bf16* KCMP = (const bf16*)(F.ws + WS_KCMP); const bf16* VCMP = (const bf16*)(F.ws + WS_VCMP);
    bf16* O = (bf16*)(F.ws + WS_O);
    unsigned* UCTR0 = (unsigned*)(F.ws + WS_CTL) + 1024; LAS unsigned* UCUR = (LAS unsigned*)(L + L_FLAG) + 17; unsigned ugrp = (unsigned)(F.vcu >> 5) & 7u;
#define NSA_DEAL(dst) do { dst = 2048u; for (int tr_ = 0; tr_ < 8; ++tr_) { const unsigned u_ = atomicAdd(UCTR0 + 64 * ugrp, 1u); if (u_ < 256u) { dst = 256u * ugrp + u_; break; } ugrp = (ugrp + 1u) & 7u; } } while (0)
    if (F.tid == 0) { unsigned d0_; NSA_DEAL(d0_); UCUR[0] = d0_; }
    __syncthreads();
#pragma unroll 1
    for (unsigned ucur = UCUR[0]; ucur < 2048u; ucur = UCUR[0]) {
        const int lane = fresh_lane(), tid = wave * 64 + lane, r32 = lane & 31, hi = lane >> 5, ql = r32 >> 2, h = r32 & 3;
        unsigned unext = 2048u; if (tid == 0) NSA_DEAL(unext);
        const int bg = 2 * (int)(ucur >> 8) + (int)((ucur >> 7) & 1u), b = bg >> 2, g = bg & 3, qt = 127 - (int)(ucur & 127u), t0 = qt * 64, cb = qt;
        const int i = 8 * wave + ql, pos = t0 + i; const long row = (long)b * SEQ + pos;
        const LAS float* tbl = TB + g * 4 + h;
        const LAS unsigned char* qr = L + L_QS + (32 * wave + r32) * QS_STR + hi * 16;
        { const bf16* qp = KVQ + (size_t)(6 + g) * KVQ_TSTRIDE + row * 256 + h * 64 + hi * 8;
#pragma unroll
          for (int d0 = 0; d0 < 4; ++d0) *(LAS bf16x8*)(L + L_QS + (32 * wave + r32) * QS_STR + hi * 16 + d0 * 32) = *(const bf16x8*)(qp + d0 * 16); }
        if (hi == 0) { const bf16* gp = GATES + row * 256 + g * 12 + h * 3; LAS float* G2 = (LAS float*)(L + L_G2) + (32 * wave + r32) * 2; G2[0] = bf2f(gp[0]); G2[1] = bf2f(gp[2]); ((LAS float*)(L + L_GS))[32 * wave + r32] = bf2f(gp[1]); }
        float mwin;
        f32x16 oacc[2];
        TileRegs TR;
        TSB(1);
        { const bf16* Kt = KVQ + 4 * KVQ_TSTRIDE + g * 64; const bf16* Vt = KVQ + 5 * KVQ_TSTRIDE + g * 64; const long base = (long)b * SEQ, rmax = (long)T - 1;
          const int kt0 = t0 >= 512 ? 0 : 8 - cb;
          LAS float* LINE = (LAS float*)(L + L_SC);
          if (tid < LSTR) {
#pragma unroll
              for (int hh = 0; hh < 4; ++hh) { float v; if (tid < 260) { const int d = tid - 68; v = d < 0 ? MASKV : TB[(min(d, 128) + 1) * 16 + g * 4 + hh]; } else v = tid + 184 >= 512 ? MASKV : 0.f;
                  LINE[hh * LSTR + tid] = v; } }
          f32x16 (&o)[2] = oacc; o[0] = f32x16{}; o[1] = f32x16{}; float m = MINIT, l = 0.f;
          tile_load(TR, Kt, Vt, base + t0 - 512 + 64 * kt0, rmax, tid); tile_store(TR, L + L_KV, tid); __syncthreads();
#pragma unroll 1
          for (int kt = kt0; kt < 9; ++kt) { LAS unsigned char* buf = L + L_KV + ((kt - kt0) & 1) * KVBUF;
              if (kt < 8) tile_load(TR, Kt, Vt, base + t0 - 512 + 64 * (kt + 1), rmax, tid);
              f32x16 p0, p1; qkt(p0, p1, buf, qr, r32, hi);
              if (kt == 0 || kt >= 6) { const int dl = 512 - 64 * kt + i - 4 * hi;
                  const LAS float* lp = LINE + h * LSTR + (kt == 0 ? dl - 247 : dl + 5);
#pragma unroll
                  for (int r = 0; r < 16; ++r) { const int c = (r & 3) + 8 * (r >> 2); p0[r] += lp[63 - c]; p1[r] += lp[31 - c]; } }
              p0 *= LOG2E; p1 *= LOG2E;
              const float rm = rowmax32(p0, p1, hi), mn = fmaxf(m, rm), f = __builtin_amdgcn_exp2f(m - mn), nmn = -mn; m = mn; l *= f;
              if (__any(f != 1.0f)) { float fr[16]; row_to_regs(fr, f, wsf, r32, hi);
#pragma unroll
                  for (int r = 0; r < 16; ++r) { o[0][r] *= fr[r]; o[1][r] *= fr[r]; } }
              unsigned pw[16]; p0 += nmn; p1 += nmn;
#pragma unroll
              for (int r = 0; r < 16; ++r) { p0[r] = __builtin_amdgcn_exp2f(p0[r]); p1[r] = __builtin_amdgcn_exp2f(p1[r]); }
              { const f32x16 s = p0 + p1; typedef float f32x2 __attribute__((ext_vector_type(2))); f32x2 s2 = {s[0], s[1]};
#pragma unroll
                for (int r = 1; r < 8; ++r) s2 += (f32x2){s[2 * r], s[2 * r + 1]};
                l += s2.x + s2.y; }
#pragma unroll
              for (int r = 0; r < 8; ++r) { pw[r] = cvtpk(p0[2 * r], p0[2 * r + 1]); pw[8 + r] = cvtpk(p1[2 * r], p1[2 * r + 1]); }
              pv(o, buf, pw, lane);
              if (kt < 8) tile_store(TR, L + L_KV + ((kt - kt0 + 1) & 1) * KVBUF, tid);
              __syncthreads(); }
          const float g_w = ((const LAS float*)(L + L_G2))[(32 * wave + r32) * 2 + 1]; const float lt = l + swap_other(l, hi); float fr[16]; row_to_regs(fr, lt > 0.f ? g_w / lt : 0.f, wsf, r32, hi); mwin = m * (1.0f / LOG2E);
#pragma unroll
          for (int r = 0; r < 16; ++r) { oacc[0][r] *= fr[r]; oacc[1][r] *= fr[r]; } }
        TSE(1); TSB(2);
        { const bf16* Kt = KCMP + g * 64; const bf16* Vt = VCMP + g * 64; const long base = (long)b * 512, rmax = (long)BATCH * 512 - 1;
          const int nvmax = t0 + 63 >= 31 ? ((t0 + 32) >> 4) + 1 : 0, ntc = (nvmax + 63) >> 6;
          float m = MINIT, l = 0.f;
          if (ntc > 0) { tile_load(TR, Kt, Vt, base, rmax, tid); tile_store(TR, L + L_KV, tid); }
          __syncthreads();
#pragma unroll 1
          for (int tc = 0; tc < ntc; ++tc) { LAS unsigned char* buf = L + L_KV + (tc & 1) * KVBUF;
              tile_load(TR, Kt, Vt, base + 64 * (tc + 1 < ntc ? tc + 1 : 0), rmax, tid);
              f32x16 p0, p1; qkt(p0, p1, buf, qr, r32, hi);
              if (t0 - 1024 * tc - 1039 < 128) bias_mask<16, false>(p0, p1, pos - 31 - 1024 * tc - 64 * hi, tbl);
              p0 *= LOG2E; p1 *= LOG2E;
              const float rm = rowmax32(p0, p1, hi), mn = fmaxf(m, rm), nmn = -mn; l *= __builtin_amdgcn_exp2f(m - mn); m = mn;
              p0 += nmn; p1 += nmn;
#pragma unroll
              for (int r = 0; r < 16; ++r) { p0[r] = __builtin_amdgcn_exp2f(p0[r]); p1[r] = __builtin_amdgcn_exp2f(p1[r]); }
              { const f32x16 s = p0 + p1; typedef float f32x2 __attribute__((ext_vector_type(2))); f32x2 s2 = {s[0], s[1]};
#pragma unroll
                for (int r = 1; r < 8; ++r) s2 += (f32x2){s[2 * r], s[2 * r + 1]};
                l += s2.x + s2.y; }
              tile_store(TR, L + L_KV + ((tc + 1) & 1) * KVBUF, tid);
              __syncthreads(); }
          const float g_c = ((const LAS float*)(L + L_G2))[(32 * wave + r32) * 2]; const float lt = l + swap_other(l, hi), linv = lt > 0.f ? 1.0f / lt : 0.f, nm = -m;
          float carry = 0.f;
#pragma unroll 1
          for (int tc = 0; tc < ntc; ++tc) { LAS unsigned char* buf = L + L_KV + ((ntc + tc) & 1) * KVBUF;
              if (tc + 1 < ntc) tile_load(TR, Kt, Vt, base + 64 * (tc + 1), rmax, tid);
              f32x16 p0, p1; qkt(p0, p1, buf, qr, r32, hi);
              if (t0 - 1024 * tc - 1039 < 128) bias_mask<16, false>(p0, p1, pos - 31 - 1024 * tc - 64 * hi, tbl);
              unsigned pw[16];
#pragma unroll
              for (int r = 0; r < 16; ++r) { p0[r] = __builtin_amdgcn_exp2f(fmaf(p0[r], LOG2E, nm)); p1[r] = __builtin_amdgcn_exp2f(fmaf(p1[r], LOG2E, nm)); }
              p0 *= linv; p1 *= linv;
#pragma unroll
              for (int r = 0; r < 8; ++r) { pw[r] = cvtpk(p0[2 * r] * g_c, p0[2 * r + 1] * g_c); pw[8 + r] = cvtpk(p1[2 * r] * g_c, p1[2 * r + 1] * g_c); }
              pv(oacc, buf, pw, lane);
              float w8[8], c8[8];
#pragma unroll
              for (int kq = 0; kq < 8; ++kq) { float a[4];
#pragma unroll
                  for (int e = 0; e < 4; ++e) { float x = kq < 4 ? p0[4 * kq + e] : p1[4 * (kq - 4) + e]; x += NSA_DPP(x, 0xB1); x += NSA_DPP(x, 0x4E); a[e] = x; }
                  w8[kq] = 2.0f * (a[0] + a[1] + a[2]) + a[3]; c8[kq] = a[3]; }
#pragma unroll
              for (int kq = 0; kq < 8; ++kq) { const float ok = swap_other(c8[kq], hi); w8[kq] += hi ? ok : carry; carry = ok; }
              LAS float* scq = SC + i * 128 + 16 * tc;
#pragma unroll
              for (int kq = 0; kq < 8; ++kq) if ((kq & 3) == h) scq[2 * kq + hi] = w8[kq];
              if (tc + 1 < ntc) tile_store(TR, L + L_KV + ((ntc + tc + 1) & 1) * KVBUF, tid);
              __syncthreads(); }
        }
        TSE(2); TSB(3);
        { const int lq = lane >> 3, sub = lane & 7; unsigned msk[4] = {0u, 0u, 0u, 0u};
          if (cb <= 15) { msk[0] = (cb == 31) ? 0xffffffffu : ((1u << (cb + 1)) - 1u); }
          else { unsigned key[16]; const LAS float* scq = SC + (8 * wave + lq) * 128;
              asm volatile("s_waitcnt lgkmcnt(0)" ::: "memory");
#pragma unroll
              for (int kk = 0; kk < 16; ++kk) { const int j = sub + 8 * kk; const float s = scq[j]; key[kk] = (j >= 1 && j <= cb - 2) ? ((__float_as_uint(s) & 0xFFFFFF80u) | (unsigned)(127 - j)) : 0u; }
#pragma unroll 1
              for (int rd = 0; rd < 13; ++rd) { unsigned mx = key[0];
#pragma unroll
                  for (int kk = 1; kk < 16; ++kk) mx = mx > key[kk] ? mx : key[kk];
                  { unsigned o1 = NSA_DPPU(mx, 0xB1); mx = mx > o1 ? mx : o1; o1 = NSA_DPPU(mx, 0x4E); mx = mx > o1 ? mx : o1; o1 = NSA_DPPU(mx, 0x141); mx = mx > o1 ? mx : o1; }
                  const int j = 127 - (int)(mx & 127u);
#pragma unroll
                  for (int w4 = 0; w4 < 4; ++w4) if (mx != 0u && (j >> 5) == w4) msk[w4] |= 1u << (j & 31);
#pragma unroll
                  for (int kk = 0; kk < 16; ++kk) if (key[kk] == mx) key[kk] = 0u; }
              msk[0] |= 1u;
#pragma unroll
              for (int w4 = 0; w4 < 4; ++w4) { if (((cb - 1) >> 5) == w4) msk[w4] |= 1u << ((cb - 1) & 31); if ((cb >> 5) == w4) msk[w4] |= 1u << (cb & 31); } }
          if (sub < 4) { const unsigned mv = sub == 0 ? msk[0] : sub == 1 ? msk[1] : sub == 2 ? msk[2] : msk[3];
              SELM[(8 * wave + lq) * 4 + sub] = mv; } }
        TSE(3); TSB(4);
        { LAS unsigned short* PO = (LAS unsigned short*)(L + L_PO);
#pragma unroll
          for (int r = 0; r < 16; ++r) { const int rw = 32 * wave + crow(r, hi); PO[rw * 64 + r32] = (unsigned short)f2bf(oacc[0][r]); PO[rw * 64 + 32 + r32] = (unsigned short)f2bf(oacc[1][r]); } }
        { LAS float* NMREF = (LAS float*)(L + L_NMREF); LAS float* GS = (LAS float*)(L + L_GS); LAS unsigned char* QS = L + L_QS; LAS unsigned* FLAG = (LAS unsigned*)(L + L_FLAG);
          { const int l2 = fresh_lane(); if (l2 < 32) NMREF[32 * wave + l2] = -mwin * LOG2E; if (wave == 0 && l2 == 0) FLAG[16] = 1u << (cb <= 19 ? 3 : cb <= 36 ? 2 : cb <= 71 ? 1 : 0); }
          __syncthreads();
          if (tid < 260) {
#pragma unroll
              for (int hh = 0; hh < 4; ++hh) { const int d = tid - 68; ((LAS float*)(L + L_SC))[hh * LSTR + tid] = d < 0 ? MASKV : TB[(min(d, 128) + 1) * 16 + g * 4 + hh]; } }
          f32x16 osel[2]; osel[0] = f32x16{}; osel[1] = f32x16{};
          { const bf16* Kt = KVQ + 2 * KVQ_TSTRIDE + g * 64; const bf16* Vt = KVQ + 3 * KVQ_TSTRIDE + g * 64; const long base = (long)b * SEQ, rmax = (long)T - 1;
            const int nd = cb <= 15 ? cb + 1 : 3; const float nmw = -mwin * LOG2E; float lsd = 0.f;
#define NSA_DBLK(ii) (cb <= 15 ? (ii) : ((ii) == 0 ? 0 : cb - 2 + (ii)))
            tile_load(TR, Kt, Vt, base + 64 * NSA_DBLK(0), rmax, tid); tile_store(TR, L + L_KV, tid); __syncthreads();
#pragma unroll 1
            for (int ii = 0; ii < nd; ++ii) { LAS unsigned char* buf = L + L_KV + (ii & 1) * KVBUF; const int blk = NSA_DBLK(ii);
                if (ii + 1 < nd) tile_load(TR, Kt, Vt, base + 64 * NSA_DBLK(ii + 1), rmax, tid);
                f32x16 p0, p1; qkt(p0, p1, buf, qr, r32, hi);
                if (blk >= cb - 2) { const LAS float* lp = (const LAS float*)(L + L_SC) + h * LSTR + (t0 + i - 64 * blk - 4 * hi) + 5;
#pragma unroll
                    for (int r = 0; r < 16; ++r) { const int c = (r & 3) + 8 * (r >> 2); p0[r] += lp[63 - c]; p1[r] += lp[31 - c]; } }
                unsigned pw[16]; float ls = 0.f;
#pragma unroll
                for (int r = 0; r < 16; ++r) { p0[r] = __builtin_amdgcn_exp2f(fminf(fmaf(p0[r], LOG2E, nmw), 100.f)); p1[r] = __builtin_amdgcn_exp2f(fminf(fmaf(p1[r], LOG2E, nmw), 100.f)); ls += p0[r] + p1[r]; }
                lsd += ls;
#pragma unroll
                for (int r = 0; r < 8; ++r) { pw[r] = cvtpk(p0[2 * r], p0[2 * r + 1]); pw[8 + r] = cvtpk(p1[2 * r], p1[2 * r + 1]); }
                pv(osel, buf, pw, lane);
                if (ii + 1 < nd) tile_store(TR, L + L_KV + ((ii + 1) & 1) * KVBUF, tid);
                __syncthreads(); }
#undef NSA_DBLK
            lsd += swap_other(lsd, hi); if (hi == 0) ((LAS float*)(L + L_LSD))[32 * wave + r32] = lsd; }
          float osp[4][8]; float lsp[4] = {0.f, 0.f, 0.f, 0.f};
          { LAS float* cv = (LAS float*)(L + L_ST) + wave * 2048;
#pragma unroll
            for (int r = 0; r < 16; ++r) { cv[crow(r, hi) * 64 + r32] = osel[0][r]; cv[crow(r, hi) * 64 + 32 + r32] = osel[1][r]; }
            asm volatile("s_waitcnt lgkmcnt(0)" ::: "memory");
            const LAS float* cr = cv + (4 * (lane >> 3)) * 64 + 8 * (lane & 7);
#pragma unroll
            for (int hh = 0; hh < 4; ++hh) { const f32x4 a = *(const LAS f32x4*)(cr + hh * 64), bq = *(const LAS f32x4*)(cr + hh * 64 + 4);
#pragma unroll
                for (int e = 0; e < 4; ++e) { osp[hh][e] = a[e]; osp[hh][4 + e] = bq[e]; } } }
          __syncthreads();
          const int fr16 = lane & 15, q4 = lane >> 4, qi = fr16 >> 2, hc = fr16 & 3;
          const bf16* Ks = KVQ + 2 * KVQ_TSTRIDE + ((long)b * SEQ) * 256 + g * 64; const bf16* VT = (const bf16*)(F.ws + WS_VT) + (size_t)((b * 4 + g) * 128) * 4096;
          bf16x8 Kf[4][2] = {}, Vf[4][2] = {}; unsigned long long qm = 0ull, qmn = 0ull; int jn = 0, jc = 0, jcn = 0;
          const int chs = cb <= 19 ? 3 : cb <= 36 ? 2 : cb <= 71 ? 1 : 0;
#define NSA_SCAN_NEXT() do { qmn = 0ull; for (;;) { unsigned jx = 0u; if (lane == 0) jx = __hip_atomic_fetch_add(FLAG + 16, 1u, __ATOMIC_RELAXED, __HIP_MEMORY_SCOPE_WORKGROUP); \
              const int tk = __builtin_amdgcn_readfirstlane((int)jx), j = tk >> chs; if (j > cb - 2) break; \
              { const unsigned wv = SELM[lane * 4 + (j >> 5)]; const int wsh = 6 - chs, c0 = (tk & ((1 << chs) - 1)) << wsh; \
                qmn = __ballot((wv >> (j & 31)) & 1u) & ((chs == 0 ? ~0ull : ((1ull << (1 << wsh)) - 1ull)) << c0); } \
              jcn = j; if (qmn) break; } } while (0)
#define NSA_LOAD_K(j) do { const bf16* kp = Ks + (size_t)(64 * (j) + fr16) * 256 + 8 * q4; \
              _Pragma("unroll") for (int a = 0; a < 4; ++a) _Pragma("unroll") for (int s2 = 0; s2 < 2; ++s2) Kf[a][s2] = *(const bf16x8*)(kp + a * 16 * 256 + s2 * 32); } while (0)
#define NSA_LOAD_V(j) do { const bf16* vp = VT + (size_t)(j) * 4096 + fr16 * 64 + 8 * q4; \
              _Pragma("unroll") for (int a = 0; a < 4; ++a) _Pragma("unroll") for (int s2 = 0; s2 < 2; ++s2) Vf[a][s2] = *(const bf16x8*)(vp + a * 16 * 64 + s2 * 32); } while (0)
#define NSA_LOAD_K_D(j, dep) do { const bf16* kp = Ks + (size_t)(64 * (j) + fr16) * 256 + 8 * q4 + (dep); \
              _Pragma("unroll") for (int a = 0; a < 4; ++a) _Pragma("unroll") for (int s2 = 0; s2 < 2; ++s2) Kf[a][s2] = *(const bf16x8*)(kp + a * 16 * 256 + s2 * 32); } while (0)
#define NSA_LOAD_V_D(j, dep) do { const bf16* vp = VT + (size_t)(j) * 4096 + fr16 * 64 + 8 * q4 + (dep); \
              _Pragma("unroll") for (int a = 0; a < 4; ++a) _Pragma("unroll") for (int s2 = 0; s2 < 2; ++s2) Vf[a][s2] = *(const bf16x8*)(vp + a * 16 * 64 + s2 * 32); } while (0)
          if (cb > 15) {
              int gi = 0, rd = 0; bool fin = false;
              auto consume = [&]() __attribute__((always_inline)) { const LAS unsigned char* sb = L + L_ST + (rd & 1) * STBUF;
                const unsigned tg = *(sb + ST_TAGS + lane);
                const int ql8 = lane >> 3; unsigned long long mym = 0ull;
#pragma unroll
                for (int q = 0; q < 8; ++q) { const unsigned long long bm = __ballot(tg == (unsigned)(8 * wave + q)); if (ql8 == q) mym = bm; }
                typedef unsigned u2 __attribute__((ext_vector_type(2)));
                auto pull2 = [&]() __attribute__((always_inline)) {
                    const bool a0 = mym != 0ull; const int j0 = a0 ? __builtin_ctzll(mym) : 0; mym &= mym - 1ull;
                    const bool a1 = mym != 0ull; const int j1 = a1 ? __builtin_ctzll(mym) : 0; mym &= mym - 1ull;
                    const LAS unsigned char* dp0 = (a0 ? sb + (4 * j0) * ST_RSTR : L + L_ZERO) + 16 * (lane & 7); const LAS unsigned char* dp1 = (a1 ? sb + (4 * j1) * ST_RSTR : L + L_ZERO) + 16 * (lane & 7);
                    const f32x4 lv0 = *(const LAS f32x4*)(a0 ? sb + ST_LVAL + 16 * j0 : L + L_ZERO + 4 * ST_RSTR), lv1 = *(const LAS f32x4*)(a1 ? sb + ST_LVAL + 16 * j1 : L + L_ZERO + 4 * ST_RSTR);
                    u2 d0[4][2], d1[4][2];
#pragma unroll
                    for (int hh = 0; hh < 4; ++hh) { d0[hh][0] = *(const LAS u2*)(dp0 + hh * ST_RSTR); d0[hh][1] = *(const LAS u2*)(dp0 + hh * ST_RSTR + 8); d1[hh][0] = *(const LAS u2*)(dp1 + hh * ST_RSTR); d1[hh][1] = *(const LAS u2*)(dp1 + hh * ST_RSTR + 8); }
#pragma unroll
                    for (int hh = 0; hh < 4; ++hh) {
#pragma unroll
                        for (int w = 0; w < 2; ++w) { const unsigned x0 = d0[hh][w].x, y0 = d0[hh][w].y, x1 = d1[hh][w].x, y1 = d1[hh][w].y;
                            osp[hh][4 * w + 0] += __uint_as_float(x0 << 16) + __uint_as_float(x1 << 16); osp[hh][4 * w + 1] += __uint_as_float(x0 & 0xFFFF0000u) + __uint_as_float(x1 & 0xFFFF0000u);
                            osp[hh][4 * w + 2] += __uint_as_float(y0 << 16) + __uint_as_float(y1 << 16); osp[hh][4 * w + 3] += __uint_as_float(y0 & 0xFFFF0000u) + __uint_as_float(y1 & 0xFFFF0000u); }
                        lsp[hh] += lv0[hh] + lv1[hh]; } };
                if (__ballot(mym != 0ull) != 0ull) { pull2();
                    if (__ballot(mym != 0ull) != 0ull) { pull2();
                        while (__ballot(mym != 0ull) != 0ull) pull2(); } } };
              auto round_end = [&](const bool more) __attribute__((always_inline)) -> bool {
                if (lane == 0) FLAG[(rd & 1) * 8 + wave] = more ? 1u : 0u;
                asm volatile("s_waitcnt lgkmcnt(0)" ::: "memory"); __builtin_amdgcn_s_barrier(); asm volatile("" ::: "memory");
                const unsigned any = FLAG[(rd & 1) * 8 + (lane & 7)];
                consume(); ++rd; gi = 0;
                return __ballot(any != 0u) == 0ull; };
              auto group = [&](const bool last) __attribute__((always_inline)) {
                  LAS unsigned char* stb = L + L_ST + (rd & 1) * STBUF; const int sidx = wave * SG + gi;
                  LAS unsigned char* sdat = stb + (16 * sidx + fr16) * ST_RSTR; LAS float* slv = (LAS float*)(stb + ST_LVAL) + 16 * sidx + fr16; LAS unsigned char* stg = stb + ST_TAGS + 4 * sidx;
                  int iq[4];
#pragma unroll
                  for (int e = 0; e < 4; ++e) { if (qm) { iq[e] = __builtin_ctzll(qm); qm &= qm - 1ull; } else iq[e] = -1; }
                  const int myq = qi == 0 ? iq[0] : qi == 1 ? iq[1] : qi == 2 ? iq[2] : iq[3]; const bool cval = myq >= 0; const int rowq = 4 * (cval ? myq : iq[0]) + hc;
                  const bf16x8 q0 = *(const LAS bf16x8*)(QS + rowq * QS_STR + q4 * 16), q1 = *(const LAS bf16x8*)(QS + rowq * QS_STR + 64 + q4 * 16);
                  const float nmr = NMREF[rowq];
                  f32x4 st[4];
#pragma unroll
                  for (int kt = 0; kt < 4; ++kt) { st[kt] = (f32x4){0.f, 0.f, 0.f, 0.f};
                      st[kt] = __builtin_amdgcn_mfma_f32_16x16x32_bf16(Kf[kt][0], q0, st[kt], 0, 0, 0); st[kt] = __builtin_amdgcn_mfma_f32_16x16x32_bf16(Kf[kt][1], q1, st[kt], 0, 0, 0); }
                  const int jnx = qmn ? jcn : jc;
                  if (last) { int dep = 0; asm volatile("" : "+v"(dep) : "v"(st[0]), "v"(st[1]), "v"(st[2]), "v"(st[3])); NSA_LOAD_K_D(jnx, dep); }
                  if (jc >= cb - 2) { const int dl = t0 + (cval ? myq : iq[0]) - 64 * jc - 4 * q4; const LAS float* tb2 = TB + g * 4 + hc;
#pragma unroll
                      for (int kt = 0; kt < 4; ++kt)
#pragma unroll
                          for (int r = 0; r < 4; ++r) { const int d = dl - 16 * kt - r; st[kt][r] += tb2[(min(max(d, -1), 128) + 1) * 16]; } }
                  float ls = 0.f;
#pragma unroll
                  for (int kt = 0; kt < 4; ++kt)
#pragma unroll
                      for (int r = 0; r < 4; ++r) { const float p = __builtin_amdgcn_exp2f(fminf(fmaf(st[kt][r], LOG2E, nmr), 100.f)); st[kt][r] = p; ls += p; }
                  { const auto s16 = __builtin_amdgcn_permlane16_swap(__float_as_uint(ls), __float_as_uint(ls), false, false); ls = __uint_as_float(s16[0]) + __uint_as_float(s16[1]);
                    const auto s32 = __builtin_amdgcn_permlane32_swap(__float_as_uint(ls), __float_as_uint(ls), false, false); ls = __uint_as_float(s32[0]) + __uint_as_float(s32[1]); }
                  if (q4 == 0) slv[0] = ls;
                  if (lane < 4) stg[lane] = (unsigned char)(lane == 0 ? iq[0] : lane == 1 ? iq[1] : lane == 2 ? iq[2] : iq[3]);
                  bf16x8 pf[2];
#pragma unroll
                  for (int s2 = 0; s2 < 2; ++s2) pf[s2] = __builtin_bit_cast(bf16x8, (v4u){cvtpk(st[2 * s2][0], st[2 * s2][1]), cvtpk(st[2 * s2][2], st[2 * s2][3]), cvtpk(st[2 * s2 + 1][0], st[2 * s2 + 1][1]), cvtpk(st[2 * s2 + 1][2], st[2 * s2 + 1][3])});
                  f32x4 ot[4];
#pragma unroll
                  for (int dt = 0; dt < 4; ++dt) { ot[dt] = (f32x4){0.f, 0.f, 0.f, 0.f};
                      ot[dt] = __builtin_amdgcn_mfma_f32_16x16x32_bf16(Vf[dt][0], pf[0], ot[dt], 0, 0, 0); ot[dt] = __builtin_amdgcn_mfma_f32_16x16x32_bf16(Vf[dt][1], pf[1], ot[dt], 0, 0, 0); }
                  if (last) { int dep = 0; asm volatile("" : "+v"(dep) : "v"(ot[0]), "v"(ot[1]), "v"(ot[2]), "v"(ot[3])); NSA_LOAD_V_D(jnx, dep); }
#pragma unroll
                  for (int dt = 0; dt < 4; ++dt) { typedef unsigned u2 __attribute__((ext_vector_type(2)));
                      *(LAS u2*)(sdat + (16 * dt + 4 * q4) * 2) = (u2){cvtpk(ot[dt][0], ot[dt][1]), cvtpk(ot[dt][2], ot[dt][3])}; } };
              NSA_SCAN_NEXT(); if (qmn) { NSA_LOAD_K(jcn); NSA_LOAD_V(jcn); }
#pragma unroll 1
              while (qmn != 0ull) { qm = qmn; jc = jcn;
#pragma unroll 1
                  while (__builtin_popcountll(qm) > 4) { group(false); if (++gi == SG) round_end(true); }
                  NSA_SCAN_NEXT();
                  group(true);
                  if (++gi == SG) fin = round_end(qmn != 0ull); }
#pragma unroll 1
              while (!fin) { LAS unsigned char* stb = L + L_ST + (rd & 1) * STBUF;
                  for (; gi < SG; ++gi) if (lane < 4) stb[ST_TAGS + 4 * (wave * SG + gi) + lane] = (unsigned char)255;
                  fin = round_end(false); }
          }
          { const int ln = fresh_lane(), q8 = ln >> 3, dg = ln & 7;
#pragma unroll
            for (int hh = 0; hh < 4; ++hh) { const int rw = 32 * wave + 4 * q8 + hh;
                const float lsum = lsp[hh] + ((const LAS float*)(L + L_LSD))[rw]; const float f = lsum > 0.f ? GS[rw] / lsum : 0.f;
                const v4u po = *(const LAS v4u*)(L + L_PO + rw * 128 + 16 * dg); v4u ov;
                ov.x = cvtpk(__uint_as_float(po.x << 16) + osp[hh][0] * f, __uint_as_float(po.x & 0xFFFF0000u) + osp[hh][1] * f); ov.y = cvtpk(__uint_as_float(po.y << 16) + osp[hh][2] * f, __uint_as_float(po.y & 0xFFFF0000u) + osp[hh][3] * f);
                ov.z = cvtpk(__uint_as_float(po.z << 16) + osp[hh][4] * f, __uint_as_float(po.z & 0xFFFF0000u) + osp[hh][5] * f); ov.w = cvtpk(__uint_as_float(po.w << 16) + osp[hh][6] * f, __uint_as_float(po.w & 0xFFFF0000u) + osp[hh][7] * f);
                *(v4u*)(O + ((long)b * SEQ + t0 + 8 * wave + q8) * 1024 + (g * 4 + hh) * 64 + 8 * dg) = ov; } } }
        TSE(4);
        if (tid == 0) UCUR[0] = unext;
        __syncthreads();
    }
    if (TSEC) { const unsigned long long tb_ = __builtin_amdgcn_s_memrealtime(); while (__builtin_amdgcn_s_memrealtime() - tb_ < tacc_) __builtin_amdgcn_s_sleep(4); }
}


#ifndef MK_PER_PHASE
#define MK_PER_PHASE 0
#endif
constexpr int N_PHASES = 14;
struct Args { const float* in[20]; float* out; unsigned char* ws; int ph_lo, ph_hi, li, pad; };
__global__ void __launch_bounds__(NWAVES * 64, 2) nsa_fwd(Args args) {
    extern __shared__ __attribute__((aligned(16))) unsigned char lds[];
    Frame F;
    F.lds = (LAS unsigned char*)lds;
    F.MISC = (volatile LAS unsigned*)(F.lds + MISC_OFF);
    F.tid = threadIdx.x; F.lane = F.tid & 63; F.wave = __builtin_amdgcn_readfirstlane(F.tid >> 6);
    F.G = gridDim.x; { const int bx = blockIdx.x; F.vcu = (F.G % 8 == 0) ? (bx % 8) * (F.G / 8) + bx / 8 : bx; }
    unsigned char* ws = args.ws; F.ws = ws; F.out = args.out;
    F.ctl = (gu32*)(ws + WS_CTL);
    F.in = args.in;
    for (int u = F.tid; u < (LDS_BYTES - LDSCTL_OFF) / 4; u += NWAVES * 64) ((LAS unsigned*)(F.lds + LDSCTL_OFF))[u] = 0u;
    __syncthreads();
    XcdBarrier bar; bar.bar = (unsigned*)(F.ctl + CW_BAR); bar.x = 0; bar.st = nullptr; bar.G = 0;
    if (!MK_PER_PHASE) bar = xcd_barrier_post((unsigned*)(F.ctl + CW_BAR), F.MISC + 8, F.tid == 0, gridDim.x);
    const bool use_gbar = !MK_PER_PHASE && F.G == 256;
    XcdBarrier gbar = bar;
    if (use_gbar) gbar = xcd_barrier_post((unsigned*)(F.ctl + CW_BAR) + XCD_BAR_WORDS * (1 + ((int)blockIdx.x & 7)), F.MISC + 10, F.tid == 0, gridDim.x / 8);
#define GROUP_BAR() do { if (use_gbar) xcd_barrier(gbar, F.wave == 0 && fresh_lane() == 0); else GRID_BAR(); } while (0)
#ifdef TBAR
    unsigned long long tbar_acc = 0;
#define GRID_BAR() do { const unsigned long long tq_ = __builtin_amdgcn_s_memrealtime(); xcd_barrier(bar, F.wave == 0 && fresh_lane() == 0); tbar_acc += __builtin_amdgcn_s_memrealtime() - tq_; } while (0)
#else
#define GRID_BAR() do { if (!MK_PER_PHASE) xcd_barrier(bar, F.wave == 0 && fresh_lane() == 0); } while (0)
#endif
    const int lo = args.ph_lo, hi = args.ph_hi;
#ifndef TPH_MASK
#define TPH_MASK 0
#endif
    unsigned long long tph_acc = 0, tph_t0 = 0; int tph_cur = -1; (void)tph_t0; (void)tph_cur;
#define TPH_MARK(k) (TPH_MASK ? (void)((tph_cur >= 0 && ((TPH_MASK >> tph_cur) & 1)) ? (tph_acc += __builtin_amdgcn_s_memrealtime() - tph_t0) : 0ull, tph_cur = (k), tph_t0 = __builtin_amdgcn_s_memrealtime()) : (void)0)
#ifndef TIMB
#define TIMB -1
#endif
    unsigned long long timb_t0 = 0; (void)timb_t0;
#define TIMB_MARK(k) ((TIMB >= 0 && (k) == TIMB) ? (void)(timb_t0 = __builtin_amdgcn_s_memrealtime()) : (void)0)
#define IN(k) (lo <= (k) && (k) < hi && (TPH_MARK(k), TIMB_MARK(k), F.lane = fresh_lane(), F.tid = F.wave * 64 + F.lane, true))
#define BOTH(k) ((TIMB >= 0 && (k) == TIMB) ? (void)((__syncthreads(), F.wave == 0 && fresh_lane() == 0) ? (atomicMax((unsigned*)(ws + WS_CTL) + 24, ~(unsigned)(__builtin_amdgcn_s_memrealtime() - timb_t0)), atomicMax((unsigned*)(ws + WS_CTL) + 25, (unsigned)(__builtin_amdgcn_s_memrealtime() - timb_t0)), 0) : 0) : (void)0, IN(k) && IN((k) + 1))
    bf16* XB = (bf16*)(ws + WS_XB); float* SS = (float*)(ws + WS_SS);
    const int bx = (int)blockIdx.x;

    if (IN(0)) { p0_prologue(F); if (BOTH(0)) GRID_BAR(); }
    if (IN(1)) {
        pg8::Gemm g{XB, (const bf16*)(ws + WS_WIN), T, 3072, DM, 0}; pg8::StaticOrder S; S.init(T, 3072, F.G, bx);
        pg8::EpiWin E{(bf16*)(ws + WS_BG), (bf16*)(ws + WS_V), SS};
        pg8::gemm_phase<pg8::EpiWin, pg8::StaticOrder, true, true>(F.lds + RING_OFF, g, S, E, F.wave);
#ifdef DUP1
        GRID_BAR(); pg8::gemm_phase<pg8::EpiWin, pg8::StaticOrder, true, true>(F.lds + RING_OFF, g, S, E, F.wave);
#endif
        if (BOTH(1)) GRID_BAR(); }
    if (IN(2)) { conv_gate_phase(F); if (BOTH(2)) GROUP_BAR(); }
    if (IN(3)) {
        pg8::Gemm g{(const bf16*)(ws + WS_BG), (const bf16*)(ws + WS_WOUT), T, DM, DM, 0}; pg8::StaticOrder S; S.init(T, DM, F.G, bx);
        pg8::EpiRes E{XB, SS + T};
        pg8::gemm_phase<pg8::EpiRes, pg8::StaticOrder, true, true>(F.lds + RING_OFF, g, S, E, F.wave);
        if (BOTH(3)) GRID_BAR(); }
    if (IN(4)) {
        pg8::Gemm g{XB, (const bf16*)(ws + WS_W1), T, FF, DM, 0}; pg8::StaticOrder S; S.init(T, FF, F.G, bx);
        pg8::EpiRelu2 E{(bf16*)(ws + WS_H), FF, SS + T};
        pg8::gemm_phase<pg8::EpiRelu2, pg8::StaticOrder, true, true>(F.lds + RING_OFF, g, S, E, F.wave);
#ifdef DUP4
        GRID_BAR(); pg8::gemm_phase<pg8::EpiRelu2, pg8::StaticOrder, true, true>(F.lds + RING_OFF, g, S, E, F.wave);
#endif
        if (BOTH(4)) GROUP_BAR(); }
    if (IN(5)) {
        pg8::Gemm g{(const bf16*)(ws + WS_H), (const bf16*)(ws + WS_W2), T, DM, FF, 0}; pg8::StaticOrder S; S.init(T, DM, F.G, bx);
        pg8::EpiRes E{XB, SS + 2 * T};
        pg8::gemm_phase<pg8::EpiRes, pg8::StaticOrder, true, true>(F.lds + RING_OFF, g, S, E, F.wave);
        if (BOTH(5)) GRID_BAR(); }
    if (IN(6)) {
        pg8::Gemm g{XB, (const bf16*)(ws + WS_WKVQ), T, NKVQ, DM, 0}; pg8::StaticOrder S; S.init(T, NKVQ, F.G, bx);
        pg8::EpiKvq E{(bf16*)(ws + WS_KVQ), KVQ_TSTRIDE, SS + 2 * T};
        pg8::gemm_phase<pg8::EpiKvq, pg8::StaticOrder, true, true>(F.lds + RING_OFF, g, S, E, F.wave);
        if (BOTH(6)) GRID_BAR(); }
    if (IN(7)) {
        const int c = F.vcu, side = (c >> 5) & 1;
        pg8::Gemm g{(const bf16*)(ws + WS_KVQ) + (size_t)side * KVQ_TSTRIDE, (const bf16*)(ws + WS_PW1 + (size_t)side * MiB), PHI_ROWS, 256, 2048, 1}; pg8::PhiOrder S{c};
        pg8::EpiPhi E{(bf16*)(ws + WS_PHIH) + (size_t)side * PHI_ROWS * 256, (const float*)(ws + WS_PHIB) + side * 256};
        pg8::gemm_phase<pg8::EpiPhi, pg8::PhiOrder, false, true>(F.lds + RING_OFF, g, S, E, F.wave);
        if (BOTH(7)) GRID_BAR(); }
    if (IN(8)) { phi2_phase(F, F.vcu * NWAVES + F.wave, F.G * NWAVES, 2 * (PHI_ROWS / 8)); __syncthreads(); vsel_transpose_phase(F, F.vcu * NWAVES + F.wave, F.G * NWAVES); if (BOTH(8)) GRID_BAR(); }
#ifdef TMIN9
    unsigned long long t9_ = 0;
    if (IN(9)) { t9_ = __builtin_amdgcn_s_memrealtime(); }
#endif
    if (IN(9)) { if (F.G == 256) attn_dense_phase(F); else attn_naive_phase(F, (bf16*)(ws + WS_O));
#ifdef TMIN9
        __syncthreads(); if (F.tid == 0) { const unsigned dt = (unsigned)(__builtin_amdgcn_s_memrealtime() - t9_); atomicMax((unsigned*)(ws + WS_CTL) + 20, ~dt); atomicMax((unsigned*)(ws + WS_CTL) + 21, dt); }
#endif
        if (BOTH(9)) GRID_BAR(); }
    if (IN(10)) {
        pg8::Gemm g{(const bf16*)(ws + WS_O), (const bf16*)(ws + WS_WO), T, DM, DM, 0}; pg8::StaticOrder S; S.init(T, DM, F.G, bx);
        pg8::EpiRes E{XB, SS + 3 * T};
        pg8::gemm_phase<pg8::EpiRes, pg8::StaticOrder, true, true>(F.lds + RING_OFF, g, S, E, F.wave);
        if (BOTH(10)) GROUP_BAR(); }
    if (IN(11)) {
        pg8::Gemm g{XB, (const bf16*)(ws + WS_W1 + 8 * MiB), T, FF, DM, 0}; pg8::StaticOrder S; S.init(T, FF, F.G, bx);
        pg8::EpiRelu2 E{(bf16*)(ws + WS_H), FF, SS + 3 * T};
        pg8::gemm_phase<pg8::EpiRelu2, pg8::StaticOrder, true, true>(F.lds + RING_OFF, g, S, E, F.wave);
        if (BOTH(11)) GROUP_BAR(); }
    if (IN(12)) {
        pg8::Gemm g{(const bf16*)(ws + WS_H), (const bf16*)(ws + WS_W2 + 8 * MiB), T, DM, FF, 0}; pg8::StaticOrder S; S.init(T, DM, F.G, bx);
        pg8::EpiRes E{XB, SS + 4 * T};
        pg8::gemm_phase<pg8::EpiRes, pg8::StaticOrder, true, true>(F.lds + RING_OFF, g, S, E, F.wave);
        if (BOTH(12)) GROUP_BAR(); }
    if (IN(13)) { final_norm_phase(F);
    }
    if (TIMB >= 0) { const unsigned mn = ~((const unsigned*)(ws + WS_CTL))[24], mx = ((const unsigned*)(ws + WS_CTL))[25]; const unsigned long long tb_ = __builtin_amdgcn_s_memrealtime(); while (__builtin_amdgcn_s_memrealtime() - tb_ < (unsigned long long)(mx - mn)) __builtin_amdgcn_s_sleep(4); }
#ifdef TMIN9
    { const unsigned mn = ~((const unsigned*)(ws + WS_CTL))[20]; const unsigned long long tb_ = __builtin_amdgcn_s_memrealtime(); while (__builtin_amdgcn_s_memrealtime() - tb_ < (unsigned long long)mn) __builtin_amdgcn_s_sleep(4); }
#endif
#ifdef TBAR
    { const unsigned long long tb_ = __builtin_amdgcn_s_memrealtime(); while (__builtin_amdgcn_s_memrealtime() - tb_ < tbar_acc) __builtin_amdgcn_s_sleep(4); }
#endif
    if (TPH_MASK) { TPH_MARK(14); const unsigned long long tb_ = __builtin_amdgcn_s_memrealtime(); while (__builtin_amdgcn_s_memrealtime() - tb_ < tph_acc) __builtin_amdgcn_s_sleep(4); }
#undef IN
#undef BOTH
}

extern "C" void kernel_launch(void* const* d_in, const int* in_sizes, int n_in, void* d_out, int out_size, void* d_ws, size_t ws_size, hipStream_t stream) {
    static int grid = 0;
    if (grid == 0) {
        if (n_in != 20 || in_sizes[0] != T * DM || out_size != T * DM || ws_size < WS_END) { fprintf(stderr, "kernel_launch: unexpected shapes (n_in %d, in0 %d, out %d, ws %zu)\n", n_in, n_in > 0 ? in_sizes[0] : -1, out_size, ws_size); grid = -1; return; }
        int dev = 0, cus = 0, per_cu = 0;
        if (hipGetDevice(&dev) != hipSuccess || hipDeviceGetAttribute(&cus, hipDeviceAttributeMultiprocessorCount, dev) != hipSuccess) { grid = -1; return; }
        if (hipFuncSetAttribute((const void*)nsa_fwd, hipFuncAttributeMaxDynamicSharedMemorySize, LDS_BYTES) != hipSuccess) { fprintf(stderr, "kernel_launch: hipFuncSetAttribute failed\n"); grid = -1; return; }
        if (hipOccupancyMaxActiveBlocksPerMultiprocessor(&per_cu, (const void*)nsa_fwd, NWAVES * 64, LDS_BYTES) != hipSuccess || per_cu < 1) fprintf(stderr, "kernel_launch: occupancy query reports %d\n", per_cu);
        (void)hipGetLastError();
        grid = cus;
        if (grid != 256) fprintf(stderr, "kernel_launch: %d CUs (built for 256)\n", grid);
    }
    if (grid < 0) return;
    if (hipMemsetAsync((char*)d_ws + WS_CTL, 0, CTL_ZERO_BYTES, stream) != hipSuccess) return;
    Args a{};
    for (int i = 0; i < 20; ++i) a.in[i] = (const float*)d_in[i];
    a.out = (float*)d_out; a.ws = (unsigned char*)d_ws;
#if MK_PER_PHASE
    for (int p = 0; p < N_PHASES; ++p) { a.ph_lo = p; a.ph_hi = p + 1; a.li = p; hipLaunchKernelGGL(nsa_fwd, dim3(grid), dim3(NWAVES * 64), LDS_BYTES, stream, a); }
#else
    a.ph_lo = 0; a.ph_hi = N_PHASES; a.li = 0;
    hipLaunchKernelGGL(nsa_fwd, dim3(grid), dim3(NWAVES * 64), LDS_BYTES, stream, a);
#endif
}
```

```cpp
#include <hip/hip_runtime.h>
#include <cstdio>
#include <cstdint>
__device__ __forceinline__ int fresh_lane() { int l; asm volatile("v_mbcnt_lo_u32_b32 %0, -1, 0\n\tv_mbcnt_hi_u32_b32 %0, -1, %0" : "=v"(l)); return l; }
namespace pg8 {
#define PG8_LAS __attribute__((address_space(3)))
typedef unsigned short bf16_t;
typedef short bf16x8 __attribute__((ext_vector_type(8)));
typedef float f32x4 __attribute__((ext_vector_type(4)));
typedef unsigned u32x4 __attribute__((ext_vector_type(4)));
constexpr int BM = 256, BK = 64, HALF = 128, HTB = HALF * BK * 2  , STAGE_BYTES = 8 * HTB, NXCD = 8, WGM = 8;

__host__ __device__ __forceinline__ int lds_byte(int r, int c) { const int st = (r >> 4) * 2 + (c >> 5), rr = r & 15, cc = c & 31, ob = rr * 64 + cc * 2; return st * 1024 + (ob ^ (((ob >> 9) & 1) << 5)); }
__host__ __device__ __forceinline__ void stage_rc(int b, int& R, int& C) { const int st = b / 1024, sb = b % 1024, swz = sb ^ (((sb >> 9) & 1) << 5); R = (st >> 1) * 16 + swz / 64; C = (st & 1) * 32 + (swz % 64) / 2; }
__host__ __device__ __forceinline__ int perm32(int rho) { const int n = rho >> 4, i = rho & 15; return 8 * (i >> 2) + 4 * n + (i & 3); }

struct Unit { int pm, pn; };
struct Gemm { const bf16_t* A; const bf16_t* Bt; int M, N, K; int a_gather; };

struct StaticOrder {
    int nM, nN, nwg, G, c;
    __host__ __device__ void init(int M, int N, int G_, int c_) { nM = M / BM; nN = N / BM; nwg = nM * nN; G = G_; c = c_; }
    __host__ __device__ bool next(int i, Unit& u) const {
        const long L = (long)i * G + c; if (L >= nwg) return false;
        int wgid = (int)L; { const int q = nwg / NXCD, r = nwg % NXCD, xcd = wgid % NXCD, off = wgid / NXCD; wgid = (xcd < r ? xcd * (q + 1) : r * (q + 1) + (xcd - r) * q) + off; }
        const int nig = WGM * nN, gid = wgid / nig, fm = gid * WGM, gsz = (nM - fm) < WGM ? (nM - fm) : WGM;
        u.pm = fm + ((wgid % nig) % gsz); u.pn = (wgid % nig) / gsz; return true;
    }
    __device__ __forceinline__ void a_ready(const Unit&) const {}
    __device__ __forceinline__ void done(const Unit&) const {}
};

__device__ __forceinline__ unsigned cvt_pk_bf16(float lo, float hi) { unsigned r; asm volatile("v_cvt_pk_bf16_f32 %0, %1, %2" : "=v"(r) : "v"(lo), "v"(hi)); return r; }
typedef float f32x2 __attribute__((ext_vector_type(2)));
typedef unsigned u32x2 __attribute__((ext_vector_type(2)));
constexpr float RMS_EPS = 1e-6f;
__device__ __forceinline__ float row_rstd(const float* ss, int r) { return __builtin_amdgcn_rsqf(ss[r] * (1.0f / 1024.0f) + RMS_EPS); }

struct EpiRes {
    static constexpr bool PERM = true, AFTER_DRAIN = false;
    bf16_t* xb; float* ss;
    __device__ __forceinline__ void operator()(const f32x4 (&acc)[2][2][4][2], const Unit& u, int wr, int wc, int fr, int fq) const {
        const int col0 = u.pn * BM + wc * 32 + 8 * fq;
#pragma unroll
        for (int ai = 0; ai < 2; ++ai)
#pragma unroll
            for (int m = 0; m < 4; ++m) { const int r = u.pm * BM + ai * HALF + wr * 64 + m * 16 + fr; bf16_t* rowp = xb + (size_t)r * 1024 + col0; float s = 0.f;
#pragma unroll
                for (int bj = 0; bj < 2; ++bj) { const u32x4 b = *(const u32x4*)(rowp + bj * HALF); const f32x4 a0 = acc[ai][bj][m][0], a1 = acc[ai][bj][m][1];
                    const unsigned w0 = cvt_pk_bf16(__uint_as_float(b.x << 16) + a0[0], __uint_as_float(b.x & 0xffff0000u) + a0[1]), w1 = cvt_pk_bf16(__uint_as_float(b.y << 16) + a0[2], __uint_as_float(b.y & 0xffff0000u) + a0[3]);
                    const unsigned w2 = cvt_pk_bf16(__uint_as_float(b.z << 16) + a1[0], __uint_as_float(b.z & 0xffff0000u) + a1[1]), w3 = cvt_pk_bf16(__uint_as_float(b.w << 16) + a1[2], __uint_as_float(b.w & 0xffff0000u) + a1[3]);
                    u32x4 w; w.x = w0; w.y = w1; w.z = w2; w.w = w3; *(u32x4*)(rowp + bj * HALF) = w;
                    const float e0 = __uint_as_float(w0 << 16), e1 = __uint_as_float(w0 & 0xffff0000u), e2 = __uint_as_float(w1 << 16), e3 = __uint_as_float(w1 & 0xffff0000u);
                    const float e4 = __uint_as_float(w2 << 16), e5 = __uint_as_float(w2 & 0xffff0000u), e6 = __uint_as_float(w3 << 16), e7 = __uint_as_float(w3 & 0xffff0000u);
                    s += ((e0 * e0 + e1 * e1) + (e2 * e2 + e3 * e3)) + ((e4 * e4 + e5 * e5) + (e6 * e6 + e7 * e7)); }
                s += __shfl_xor(s, 16); s += __shfl_xor(s, 32);
                if (fq == 0) atomicAdd(ss + r, s); }
    }
};
struct EpiRelu2 {
    static constexpr bool PERM = true, AFTER_DRAIN = false;
    bf16_t* O; int ldc; const float* ss;
    __device__ __forceinline__ void operator()(const f32x4 (&acc)[2][2][4][2], const Unit& u, int wr, int wc, int fr, int fq) const {
        const int col0 = u.pn * BM + wc * 32 + 8 * fq;
#pragma unroll
        for (int ai = 0; ai < 2; ++ai)
#pragma unroll
            for (int m = 0; m < 4; ++m) { const int r = u.pm * BM + ai * HALF + wr * 64 + m * 16 + fr; const float rs = row_rstd(ss, r), s2 = rs * rs; bf16_t* rowp = O + (size_t)r * ldc + col0;
#pragma unroll
                for (int bj = 0; bj < 2; ++bj) { f32x4 v0 = acc[ai][bj][m][0], v1 = acc[ai][bj][m][1];
#pragma unroll
                    for (int j = 0; j < 4; ++j) { const float a = fmaxf(v0[j], 0.f), b = fmaxf(v1[j], 0.f); v0[j] = a * a * s2; v1[j] = b * b * s2; }
                    u32x4 w; w.x = cvt_pk_bf16(v0[0], v0[1]); w.y = cvt_pk_bf16(v0[2], v0[3]); w.z = cvt_pk_bf16(v1[0], v1[1]); w.w = cvt_pk_bf16(v1[2], v1[3]);
                    *(u32x4*)(rowp + bj * HALF) = w; } }
    }
};
struct EpiWin {
    static constexpr bool PERM = true, AFTER_DRAIN = false;
    bf16_t* BG; bf16_t* V; const float* ss;
    __device__ __forceinline__ void operator()(const f32x4 (&acc)[2][2][4][2], const Unit& u, int wr, int wc, int fr, int fq) const {
#pragma unroll
        for (int ai = 0; ai < 2; ++ai)
#pragma unroll
            for (int m = 0; m < 4; ++m) { const int r = u.pm * BM + ai * HALF + wr * 64 + m * 16 + fr; const float rs = row_rstd(ss, r);
                if (u.pn < 4) { bf16_t* rowp = BG + (size_t)r * 1024 + u.pn * BM + wc * 32 + 8 * fq;
#pragma unroll
                    for (int bj = 0; bj < 2; ++bj) { const f32x4 v0 = acc[ai][bj][m][0] * rs, v1 = acc[ai][bj][m][1] * rs;
                        u32x4 w; w.x = cvt_pk_bf16(v0[0], v0[1]); w.y = cvt_pk_bf16(v0[2], v0[3]); w.z = cvt_pk_bf16(v1[0], v1[1]); w.w = cvt_pk_bf16(v1[2], v1[3]);
                        *(u32x4*)(rowp + bj * HALF) = w; }
                } else { bf16_t* rowp = V + (size_t)r * 1024 + (u.pn - 4) * HALF + wc * 32 + 8 * fq; const float s2 = rs * rs;
                    const f32x4 v0 = acc[ai][0][m][0] * acc[ai][1][m][0] * s2, v1 = acc[ai][0][m][1] * acc[ai][1][m][1] * s2;
                    u32x4 w; w.x = cvt_pk_bf16(v0[0], v0[1]); w.y = cvt_pk_bf16(v0[2], v0[3]); w.z = cvt_pk_bf16(v1[0], v1[1]); w.w = cvt_pk_bf16(v1[2], v1[3]);
                    *(u32x4*)rowp = w; } }
    }
};
struct EpiKvq {
    static constexpr bool PERM = true, AFTER_DRAIN = false;
    bf16_t* O; size_t tstride; const float* ss;
    __device__ __forceinline__ void operator()(const f32x4 (&acc)[2][2][4][2], const Unit& u, int wr, int wc, int fr, int fq) const {
        bf16_t* base = O + (size_t)u.pn * tstride + wc * 32 + 8 * fq; const bool sig = (u.pn == 10);
#pragma unroll
        for (int ai = 0; ai < 2; ++ai)
#pragma unroll
            for (int m = 0; m < 4; ++m) { const int r = u.pm * BM + ai * HALF + wr * 64 + m * 16 + fr; const float rs = row_rstd(ss, r); bf16_t* rowp = base + (size_t)r * 256;
#pragma unroll
                for (int bj = 0; bj < 2; ++bj) { f32x4 v0 = acc[ai][bj][m][0] * rs, v1 = acc[ai][bj][m][1] * rs;
                    if (sig) {
#pragma unroll
                        for (int j = 0; j < 4; ++j) { v0[j] = 1.0f / (1.0f + __expf(-v0[j])); v1[j] = 1.0f / (1.0f + __expf(-v1[j])); } }
                    u32x4 w; w.x = cvt_pk_bf16(v0[0], v0[1]); w.y = cvt_pk_bf16(v0[2], v0[3]); w.z = cvt_pk_bf16(v1[0], v1[1]); w.w = cvt_pk_bf16(v1[2], v1[3]);
                    *(u32x4*)(rowp + bj * HALF) = w; } }
    }
};
struct EpiPhi {
    static constexpr bool PERM = true, AFTER_DRAIN = false;
    bf16_t* O; const float* bias;
    __device__ __forceinline__ void operator()(const f32x4 (&acc)[2][2][4][2], const Unit& u, int wr, int wc, int fr, int fq) const {
        const int col0 = wc * 32 + 8 * fq;
        f32x4 bv[2][2];
#pragma unroll
        for (int bj = 0; bj < 2; ++bj)
#pragma unroll
            for (int n = 0; n < 2; ++n) bv[bj][n] = *(const f32x4*)(bias + col0 + bj * HALF + 4 * n);
#pragma unroll
        for (int ai = 0; ai < 2; ++ai)
#pragma unroll
            for (int m = 0; m < 4; ++m) { const int r = u.pm * BM + ai * HALF + wr * 64 + m * 16 + fr; bf16_t* rowp = O + (size_t)r * 256 + col0;
#pragma unroll
                for (int bj = 0; bj < 2; ++bj) { f32x4 v0 = acc[ai][bj][m][0] + bv[bj][0], v1 = acc[ai][bj][m][1] + bv[bj][1];
#pragma unroll
                    for (int j = 0; j < 4; ++j) { v0[j] = v0[j] / (1.0f + __expf(-v0[j])); v1[j] = v1[j] / (1.0f + __expf(-v1[j])); }
                    u32x4 w; w.x = cvt_pk_bf16(v0[0], v0[1]); w.y = cvt_pk_bf16(v0[2], v0[3]); w.z = cvt_pk_bf16(v1[0], v1[1]); w.w = cvt_pk_bf16(v1[2], v1[3]);
                    *(u32x4*)(rowp + bj * HALF) = w; } }
    }
};
struct PhiOrder {
    int c;
    __device__ __forceinline__ bool next(int i, Unit& u) const { if (i > 0 || c >= 64) return false; u.pm = c & 31; u.pn = 0; return true; }
    __device__ __forceinline__ void a_ready(const Unit&) const {}
    __device__ __forceinline__ void done(const Unit&) const {}
};
template <class Epi, class Sched, bool ALIGN_EPI = false, bool SP2 = false>
__device__ __forceinline__ void gemm_phase(PG8_LAS unsigned char* lds, const Gemm g, const Sched& S, const Epi& E, const int wid  ) {
    const int lane = fresh_lane(), tid = wid * 64 + lane, wr = wid >> 2, wc = wid & 3, fr = lane & 15, fq = lane >> 4;
    const int K = g.K, nt = K / BK;
    unsigned voffA[2], voffB[2];
#pragma unroll
    for (int i = 0; i < 2; ++i) { int R, C; stage_rc(tid * 16 + i * 8192, R, C); const int Rb = Epi::PERM ? ((R & ~31) + perm32(R & 31)) : R;
        voffA[i] = g.a_gather ? (unsigned)((R >> 2) * 8192 + (R & 3) * 128 + C * 2) : (unsigned)(R * K + C) * 2u; voffB[i] = (unsigned)(Rb * K + C) * 2u; }
    const size_t kstep = (size_t)(BK * 2);
    const size_t hstep = (size_t)HALF * K * 2;
    const size_t tstep = 2 * hstep;
    const size_t kstepA = g.a_gather ? (size_t)512 : kstep, hstepA = g.a_gather ? (size_t)262144 : hstep, tstepA = g.a_gather ? (size_t)524288 : tstep;
    const unsigned ldsw = (unsigned)wid * 1024u;
    const int aoff = lds_byte(wr * 64 + fr, fq * 8), boff = lds_byte(wc * 32 + fr, fq * 8);
#define PG8_SA(b, h) (((b) * 2 + (h)) * HTB)
#define PG8_SB(b, h) ((4 + (b) * 2 + (h)) * HTB)
#define PG8_STAGE(bufoff, gbase, voff) do { _Pragma("unroll") for (int _i = 0; _i < 2; ++_i) \
        __builtin_amdgcn_global_load_lds((const unsigned*)((const char*)(gbase) + (voff)[_i]), (PG8_LAS unsigned*)(lds + (bufoff) + ldsw + _i * 8192), 16, 0, 0); } while (0)
#define PG8_LDA(dst, b, h) do { _Pragma("unroll") for (int m = 0; m < 4; ++m) _Pragma("unroll") for (int k = 0; k < 2; ++k) dst[m][k] = *(const PG8_LAS bf16x8*)(lds + PG8_SA(b, h) + aoff + m * 2048 + k * 1024); } while (0)
#define PG8_LDB(dst, b, h) do { _Pragma("unroll") for (int n = 0; n < 2; ++n) _Pragma("unroll") for (int k = 0; k < 2; ++k) dst[n][k] = *(const PG8_LAS bf16x8*)(lds + PG8_SB(b, h) + boff + n * 2048 + k * 1024); } while (0)
#define PG8_MMA(ai, bj, At, Bt) do { __builtin_amdgcn_s_setprio(1); _Pragma("unroll") for (int m = 0; m < 4; ++m) _Pragma("unroll") for (int n = 0; n < 2; ++n) _Pragma("unroll") for (int k = 0; k < 2; ++k) \
        acc[ai][bj][m][n] = __builtin_amdgcn_mfma_f32_16x16x32_bf16(Bt[n][k], At[m][k], acc[ai][bj][m][n], 0, 0, 0); __builtin_amdgcn_s_setprio(0); } while (0)
#define PG8_WAIT_V(n) asm volatile("s_waitcnt vmcnt(" #n ")" ::: "memory")
#define PG8_WAIT_L(n) asm volatile("s_waitcnt lgkmcnt(" #n ")" ::: "memory")
#define PG8_BAR __builtin_amdgcn_s_barrier()
#define PG8_SCHED __builtin_amdgcn_sched_barrier(0)
    Unit cur, nxt; int ui = 0;
    if (!S.next(0, cur)) return;
    f32x4 acc[2][2][4][2];
#pragma unroll
    for (int a = 0; a < 2; ++a)
#pragma unroll
        for (int b = 0; b < 2; ++b)
#pragma unroll
            for (int m = 0; m < 4; ++m)
#pragma unroll
                for (int n = 0; n < 2; ++n) acc[a][b][m][n] = (f32x4){0.f, 0.f, 0.f, 0.f};
    bf16x8 At[4][2], B0[2][2], B1[2][2];
    const char* cA = (const char*)g.A + (size_t)cur.pm * tstepA; const char* cB = (const char*)g.Bt + (size_t)cur.pn * tstep;
    S.a_ready(cur);
    if constexpr (SP2) {
        PG8_STAGE(PG8_SB(0, 0), cB, voffB); PG8_STAGE(PG8_SB(0, 1), cB + hstep, voffB); PG8_STAGE(PG8_SA(0, 0), cA, voffA); PG8_STAGE(PG8_SA(0, 1), cA + hstepA, voffA);
        if (wr == 1) PG8_BAR;
        PG8_WAIT_V(2); PG8_BAR;
        PG8_STAGE(PG8_SB(1, 0), cB + kstep, voffB); PG8_STAGE(PG8_SA(1, 0), cA + kstepA, voffA); PG8_STAGE(PG8_SB(1, 1), cB + hstep + kstep, voffB);
        PG8_WAIT_V(6); PG8_BAR;
    } else {
        PG8_STAGE(PG8_SB(0, 0), cB, voffB); PG8_STAGE(PG8_SA(0, 0), cA, voffA); PG8_STAGE(PG8_SB(0, 1), cB + hstep, voffB); PG8_STAGE(PG8_SA(0, 1), cA + hstepA, voffA);
        if (wr == 1) PG8_BAR;
        PG8_WAIT_V(4); PG8_BAR;
        PG8_STAGE(PG8_SB(1, 0), cB + kstep, voffB); PG8_STAGE(PG8_SA(1, 0), cA + kstepA, voffA); PG8_STAGE(PG8_SB(1, 1), cB + hstep + kstep, voffB);
        PG8_WAIT_V(6); PG8_BAR;
    }
    for (;;) {
        const bool has_next = S.next(ui + 1, nxt);
        const char* nA = has_next ? (const char*)g.A + (size_t)nxt.pm * tstepA : cA; const char* nB = has_next ? (const char*)g.Bt + (size_t)nxt.pn * tstep : cB;
        for (int t = 0; t < nt; t += 2) {
            const bool last = (t == nt - 2);
            const char* a1 = cA + (size_t)(t + 1) * kstepA;
            const char* a2 = last ? nA : cA + (size_t)(t + 2) * kstepA; const char* b2 = last ? nB : cB + (size_t)(t + 2) * kstep;
            const char* a3 = a2 + kstepA; const char* b3 = b2 + kstep;
            if (last && has_next) S.a_ready(nxt);
            if constexpr (SP2) {
            PG8_LDB(B0, 0, 0); PG8_LDB(B1, 0, 1); PG8_SCHED; PG8_LDA(At, 0, 0); PG8_STAGE(PG8_SA(1, 1), a1 + hstepA, voffA);
            PG8_WAIT_V(8); PG8_WAIT_L(0); PG8_BAR; PG8_MMA(0, 0, At, B0); PG8_MMA(0, 1, At, B1); PG8_BAR; PG8_SCHED;
            PG8_LDA(At, 0, 1); PG8_STAGE(PG8_SB(0, 0), b2, voffB); PG8_STAGE(PG8_SB(0, 1), b2 + hstep, voffB); PG8_STAGE(PG8_SA(0, 0), a2, voffA);
            PG8_WAIT_V(8); PG8_WAIT_L(0); PG8_BAR; PG8_MMA(1, 0, At, B0); PG8_MMA(1, 1, At, B1); PG8_BAR; PG8_SCHED;
            PG8_LDB(B0, 1, 0); PG8_LDB(B1, 1, 1); PG8_SCHED; PG8_LDA(At, 1, 0); PG8_STAGE(PG8_SA(0, 1), a2 + hstepA, voffA);
            PG8_WAIT_V(8); PG8_WAIT_L(0); PG8_BAR; PG8_MMA(0, 0, At, B0); PG8_MMA(0, 1, At, B1); PG8_BAR; PG8_SCHED;
            PG8_LDA(At, 1, 1); PG8_STAGE(PG8_SB(1, 0), b3, voffB); PG8_STAGE(PG8_SB(1, 1), b3 + hstep, voffB); PG8_STAGE(PG8_SA(1, 0), a3, voffA);
            PG8_WAIT_V(8); PG8_WAIT_L(0); PG8_BAR; PG8_MMA(1, 0, At, B0); PG8_MMA(1, 1, At, B1); PG8_BAR; PG8_SCHED;
            } else {
            PG8_LDB(B0, 0, 0); PG8_SCHED; PG8_LDA(At, 0, 0); PG8_STAGE(PG8_SA(1, 1), a1 + hstepA, voffA);
            PG8_WAIT_L(8); PG8_BAR; PG8_WAIT_L(0); PG8_MMA(0, 0, At, B0); PG8_BAR; PG8_SCHED;
            PG8_LDB(B1, 0, 1); PG8_STAGE(PG8_SB(0, 0), b2, voffB);
            PG8_BAR; PG8_WAIT_L(0); PG8_MMA(0, 1, At, B1); PG8_BAR;
            PG8_LDA(At, 0, 1); PG8_STAGE(PG8_SA(0, 0), a2, voffA);
            PG8_BAR; PG8_WAIT_L(0); PG8_MMA(1, 0, At, B0); PG8_BAR; PG8_SCHED;
            PG8_STAGE(PG8_SB(0, 1), b2 + hstep, voffB);
            PG8_WAIT_V(6); PG8_BAR; PG8_MMA(1, 1, At, B1); PG8_BAR;
            PG8_LDB(B0, 1, 0); PG8_SCHED; PG8_LDA(At, 1, 0); PG8_STAGE(PG8_SA(0, 1), a2 + hstepA, voffA);
            PG8_WAIT_L(8); PG8_BAR; PG8_WAIT_L(0); PG8_MMA(0, 0, At, B0); PG8_BAR; PG8_SCHED;
            PG8_LDB(B1, 1, 1); PG8_STAGE(PG8_SB(1, 0), b3, voffB);
            PG8_BAR; PG8_WAIT_L(0); PG8_MMA(0, 1, At, B1); PG8_BAR;
            PG8_LDA(At, 1, 1); PG8_STAGE(PG8_SA(1, 0), a3, voffA);
            PG8_BAR; PG8_WAIT_L(0); PG8_MMA(1, 0, At, B0); PG8_BAR; PG8_SCHED;
            PG8_STAGE(PG8_SB(1, 1), b3 + hstep, voffB);
            PG8_WAIT_V(6); PG8_BAR; PG8_MMA(1, 1, At, B1); PG8_BAR;
            }
        }
        if constexpr (ALIGN_EPI) { if (wr == 0) PG8_BAR; }
        if constexpr (!Epi::AFTER_DRAIN) { E(acc, cur, wr, wc, fr, fq); S.done(cur); }
        if (!has_next) break;
#pragma unroll
        for (int a = 0; a < 2; ++a)
#pragma unroll
            for (int b = 0; b < 2; ++b)
#pragma unroll
                for (int m = 0; m < 4; ++m)
#pragma unroll
                    for (int n = 0; n < 2; ++n) acc[a][b][m][n] = (f32x4){0.f, 0.f, 0.f, 0.f};
        cur = nxt; cA = nA; cB = nB; ++ui;
        if constexpr (ALIGN_EPI) { if (wr == 1) PG8_BAR; }
    }
    PG8_WAIT_V(0);
    if constexpr (!ALIGN_EPI) { if (wr == 0) PG8_BAR; }
    PG8_BAR;
    if constexpr (Epi::AFTER_DRAIN) { E.fused(acc, cur, wr, wc, fr, fq, lds, wid, lane); S.done(cur); }
#undef PG8_SA
#undef PG8_SB
#undef PG8_STAGE
#undef PG8_LDA
#undef PG8_LDB
#undef PG8_MMA
#undef PG8_WAIT_V
#undef PG8_WAIT_L
#undef PG8_BAR
#undef PG8_SCHED
}
}

constexpr int NWAVES = 8;
constexpr int BATCH = 4, SEQ = 8192, DM = 1024, T = BATCH * SEQ, FF = 4096, NH = 16, HD = 64, NG = 4;
constexpr int NKVQ = 2816;
constexpr int PHI_ROWS = 8192;
constexpr size_t MiB = 1u << 20;
constexpr size_t WS_CTL = 0, CTL_ZERO_BYTES = 2 * MiB;
constexpr size_t WS_SS = 1 * MiB;
constexpr size_t WS_PHIB = WS_SS + 5 * 128 * 1024;
constexpr size_t WS_WIN = 2 * MiB, WS_WOUT = 8 * MiB, WS_W1 = 10 * MiB  , WS_W2 = 26 * MiB  , WS_WKVQ = 42 * MiB  , WS_WO = 48 * MiB, WS_PW1 = 50 * MiB  ;
constexpr size_t WS_KCMP = 53 * MiB, WS_VCMP = 54 * MiB;
constexpr size_t WS_PHIH = 56 * MiB;
constexpr size_t WS_XB = 64 * MiB;
constexpr size_t WS_H = 128 * MiB;
constexpr size_t WS_BG = 128 * MiB, WS_V = 192 * MiB;
constexpr size_t WS_KVQ = 128 * MiB, KVQ_TSTRIDE = (size_t)T * 256;
constexpr size_t WS_O = 448 * MiB;
constexpr size_t WS_SELM = 384 * MiB;
constexpr size_t WS_VT = 400 * MiB;
constexpr size_t WS_END = 512 * MiB;
static_assert(WS_KVQ + 11 * KVQ_TSTRIDE * 2 <= WS_H + (size_t)T * FF * 2 && WS_H + (size_t)T * FF * 2 <= 384 * MiB && WS_O + (size_t)T * 1024 * 2 <= WS_END, "ws map");
constexpr int CW_BAR = 4096;
constexpr int RING_OFF = 0, RING_BYTES = 131072;
constexpr int LDS_BYTES = 163840;
constexpr int LDSCTL_OFF = LDS_BYTES - 512, MISC_OFF = LDSCTL_OFF + 320;
#define GAS __attribute__((address_space(1)))
#define LAS __attribute__((address_space(3)))
typedef unsigned short bf16;
typedef unsigned v4u __attribute__((ext_vector_type(4)));
typedef float f32x4 __attribute__((ext_vector_type(4)));
typedef short bf16x8 __attribute__((ext_vector_type(8)));
typedef GAS unsigned gu32;
typedef GAS unsigned long long gu64;
#define RLX_AGENT __ATOMIC_RELAXED, __HIP_MEMORY_SCOPE_AGENT
#define LDS_WAIT() asm volatile("s_waitcnt lgkmcnt(0)" ::: "memory")
#define VM_WAIT() asm volatile("s_waitcnt vmcnt(0)" ::: "memory")
__device__ __forceinline__ unsigned long long rt() { return __builtin_amdgcn_s_memrealtime(); }
__device__ __forceinline__ unsigned f2bf(float f) { unsigned u = __builtin_bit_cast(unsigned, f); return (u + 0x7fffu + ((u >> 16) & 1u)) >> 16; }
__device__ __forceinline__ unsigned pk2(float lo, float hi) { return f2bf(lo) | (f2bf(hi) << 16); }

#define XB_TMO      128
#define XB_XCNT(j)  (256  + 64 * (j))
#define XB_XSUB(j)  (1280 + 64 * (j))
#define XB_XGEN(j)  (2304 + 64 * (j))
#define XB_TOP      3328
#define XB_TOPGEN   3392
#define XCD_BAR_WORDS 3456
#define XB_SPIN_CAP (1u << 18)

__device__ __forceinline__ unsigned xb_ld(unsigned* p)              { return __hip_atomic_load(p, __ATOMIC_RELAXED, __HIP_MEMORY_SCOPE_AGENT); }
__device__ __forceinline__ unsigned xb_add(unsigned* p, unsigned v) { return __hip_atomic_fetch_add(p, v, __ATOMIC_RELAXED, __HIP_MEMORY_SCOPE_AGENT); }
__device__ __forceinline__ unsigned xb_xcc_id() { return (unsigned)__builtin_amdgcn_s_getreg((3 << 11) | 20) & 0xFu; }
#define XB_SPIN(cond, bar) do { unsigned _sp = 0; while (cond) { __builtin_amdgcn_s_sleep(1); \
    if ((++_sp & 255u) == 0u) { if (xb_ld(&(bar)[XB_TMO])) break; if (_sp > XB_SPIN_CAP) { atomicAdd(&(bar)[XB_TMO], 1u); break; } } } } while (0)

struct XcdBarrier {
    unsigned* bar; unsigned x; unsigned G;
    volatile LAS unsigned* st;
};

__device__ __forceinline__ XcdBarrier xcd_barrier_post(unsigned* bar, volatile LAS unsigned* st, bool leader  , unsigned G  ) {
    XcdBarrier b; b.bar = bar; b.x = xb_xcc_id(); b.st = st; b.G = G;
    if (leader) (void)xb_add(&bar[XB_XCNT(b.x)], 1u);
    return b;
}
__device__ __forceinline__ void xcd_barrier_complete(unsigned* bar, unsigned x, unsigned& nloc, unsigned& nx, const unsigned G) {
    unsigned sum, cnt, mine, sp = 0u;
    for (;;) {
        sum = 0u; cnt = 0u; mine = 0u;
#pragma unroll
        for (unsigned j = 0; j < 16; ++j) { const unsigned c = xb_ld(&bar[XB_XCNT(j)]); sum += c; cnt += (c > 0u) ? 1u : 0u; mine = (j == x) ? c : mine; }
        if (sum == G) break;
        __builtin_amdgcn_s_sleep(1);
        if ((++sp & 255u) == 0u) { if (xb_ld(&bar[XB_TMO])) break; if (sp > XB_SPIN_CAP) { atomicAdd(&bar[XB_TMO], 1u); break; } }
    }
    nloc = mine > 0u ? mine : 1u; nx = cnt > 0u ? cnt : 1u;
}

__device__ __forceinline__ void xcd_barrier(const XcdBarrier& b, bool leader  ) {
    asm volatile("s_waitcnt vmcnt(0)" ::: "memory");
    __syncthreads();
    if (leader) {
        unsigned* bar = b.bar;
        __builtin_amdgcn_s_waitcnt(0);
        unsigned nloc = b.st[0], nx = b.st[1];
        if (nloc == 0u) { xcd_barrier_complete(bar, b.x, nloc, nx, b.G); b.st[0] = nloc; b.st[1] = nx; }
        const unsigned old = xb_add(&bar[XB_XSUB(b.x)], 1u);
        const unsigned gen = old / nloc;
        if (old + 1u == (gen + 1u) * nloc) {
            __builtin_amdgcn_fence(__ATOMIC_RELEASE, "agent");
            asm volatile("s_waitcnt vmcnt(0)" ::: "memory");
            const unsigned og = xb_add(&bar[XB_TOP], 1u);
            const unsigned tg = og / nx;
            if (og + 1u == (tg + 1u) * nx) xb_add(&bar[XB_TOPGEN], 1u);
            else XB_SPIN(xb_ld(&bar[XB_TOPGEN]) == tg, bar);
            __builtin_amdgcn_fence(__ATOMIC_ACQUIRE, "agent");
            xb_add(&bar[XB_XGEN(b.x)], 1u);
            asm volatile("s_waitcnt vmcnt(0)" ::: "memory");
        } else {
            XB_SPIN(xb_ld(&bar[XB_XGEN(b.x)]) == gen, bar);
            __builtin_amdgcn_fence(__ATOMIC_ACQUIRE, "agent");
            asm volatile("s_waitcnt vmcnt(0)" ::: "memory");
        }
    }
    __syncthreads();
}

struct Frame {
    LAS unsigned char* lds;
    volatile LAS unsigned* MISC;
    gu32* ctl;
    int tid, lane, wave;
    int vcu, G;
    const float* const* in;
    float* out; unsigned char* ws;
};
__device__ __forceinline__ float wave_sum(float v) {
#pragma unroll
    for (int o = 1; o < 64; o <<= 1) v += __shfl_xor(v, o);
    return v;
}
__device__ __forceinline__ float wave_max(float v) {
#pragma unroll
    for (int o = 1; o < 64; o <<= 1) v = fmaxf(v, __shfl_xor(v, o));
    return v;
}
__device__ __forceinline__ float bf2f(unsigned short b) { return __uint_as_float(((unsigned)b) << 16); }
__device__ __forceinline__ float bflo(unsigned w) { return __uint_as_float(w << 16); }
__device__ __forceinline__ float bfhi(unsigned w) { return __uint_as_float(w & 0xffff0000u); }

__device__ __forceinline__ void p0_transpose_item(const float* W, int ldw, int nvalid, const float* gain, float scale, bf16* WT, int K, int drow, int k0, int n0, LAS float* scr, int lane) {
    float wv[32];
#pragma unroll
    for (int i = 0; i < 32; ++i) { const int kk = 2 * i + (lane >> 5), n = n0 + (lane & 31); wv[i] = (n < nvalid) ? W[(size_t)(k0 + kk) * ldw + n] : 0.f; }
#pragma unroll
    for (int i = 0; i < 32; ++i) { const int kk = 2 * i + (lane >> 5); float v = wv[i]; if (gain) v *= gain[k0 + kk]; scr[kk * 33 + (lane & 31)] = v * scale; }
    LDS_WAIT(); asm volatile("" ::: "memory");
    const int c = lane & 7;
#pragma unroll
    for (int j = 0; j < 4; ++j) { const int n = (lane >> 3) + 8 * j; const LAS float* s = scr + (8 * c) * 33 + n;
        v4u o; o.x = pk2(s[0 * 33], s[1 * 33]); o.y = pk2(s[2 * 33], s[3 * 33]); o.z = pk2(s[4 * 33], s[5 * 33]); o.w = pk2(s[6 * 33], s[7 * 33]);
        *(GAS v4u*)(WT + (size_t)(drow + n) * K + k0 + 8 * c) = o; }
    LDS_WAIT(); asm volatile("" ::: "memory");
}
struct MatSpec { const float* W; int K, ldw, nvalid, niter; const float* gain; bf16* WT; int kind; };
__device__ __forceinline__ void p0_matrix_item(const MatSpec& m, int item, LAS float* scr, int lane) {
    const int nblk = m.niter / 32, kb = item / nblk, nb = item % nblk, k0 = 64 * kb, n0 = 32 * nb;
    int drow = n0; float scale = 1.f;
    if (m.kind == 1) { if (n0 >= 1024) { const int isu = n0 >= 2048, j = n0 - (isu ? 2048 : 1024); drow = 1024 + (j >> 7) * 256 + isu * 128 + (j & 127); } }
    else if (m.kind == 2) { if (n0 < 1024) { drow = 1536 + n0; scale = 0.125f; } else drow = 2560 + (n0 - 1024); }
    p0_transpose_item(m.W, m.ldw, m.nvalid, m.gain, scale, m.WT, m.K, drow, k0, n0, scr, lane);
}
__device__ __forceinline__ void p0_prologue(Frame& F) {
    LAS float* scr = (LAS float*)(F.lds + RING_OFF + F.wave * 16384);
    const int gw = F.vcu * NWAVES + F.wave, NGW = F.G * NWAVES;
    unsigned char* ws = F.ws;
    int it = gw;
#define DO_MAT(...) do { const MatSpec m_ = MatSpec{__VA_ARGS__}; const int n_ = (m_.K / 64) * (m_.niter / 32); _Pragma("unroll 1") for (; it < n_; it += NGW) p0_matrix_item(m_, it, scr, F.lane); it -= n_; } while (0)
    DO_MAT(F.in[6],  1024, 3072, 3072, 3072, F.in[2],           (bf16*)(ws + WS_WIN), 1);
    DO_MAT(F.in[8],  1024, 1024, 1024, 1024, nullptr,           (bf16*)(ws + WS_WOUT), 0);
    DO_MAT(F.in[4],  1024, 4096, 4096, 4096, F.in[3],           (bf16*)(ws + WS_W1), 0);
    DO_MAT(F.in[4] + (size_t)1024 * 4096, 1024, 4096, 4096, 4096, F.in[3] + 1024, (bf16*)(ws + WS_W1 + 8 * MiB), 0);
    DO_MAT(F.in[5],  4096, 1024, 1024, 1024, nullptr,           (bf16*)(ws + WS_W2), 0);
    DO_MAT(F.in[5] + (size_t)4096 * 1024, 4096, 1024, 1024, 1024, nullptr, (bf16*)(ws + WS_W2 + 8 * MiB), 0);
    DO_MAT(F.in[10], 1024, 1536, 1536, 1536, F.in[9],           (bf16*)(ws + WS_WKVQ), 0);
    DO_MAT(F.in[17], 1024, 1072, 1072, 1280, F.in[2] + 1024,    (bf16*)(ws + WS_WKVQ), 2);
    DO_MAT(F.in[18], 1024, 1024, 1024, 1024, nullptr,           (bf16*)(ws + WS_WO), 0);
    DO_MAT(F.in[13], 2048, 256, 256, 256, nullptr,              (bf16*)(ws + WS_PW1), 0);
    DO_MAT(F.in[15], 2048, 256, 256, 256, nullptr,              (bf16*)(ws + WS_PW1 + 1 * MiB), 0);
#undef DO_MAT
    { bf16* XB = (bf16*)(ws + WS_XB); float* ss0 = (float*)(ws + WS_SS);
      for (int m = gw; m < T; m += 2 * NGW) { const int m2 = m + NGW;
          const GAS f32x4* xr = (const GAS f32x4*)(F.in[0] + (size_t)m * DM) + F.lane; const GAS f32x4* xr2 = (const GAS f32x4*)(F.in[0] + (size_t)m2 * DM) + F.lane;
          GAS unsigned long long* o8 = (GAS unsigned long long*)(XB + (size_t)m * DM) + F.lane; GAS unsigned long long* o82 = (GAS unsigned long long*)(XB + (size_t)m2 * DM) + F.lane;
          f32x4 va[4], vb[4];
#pragma unroll
          for (int j = 0; j < 4; ++j) { va[j] = xr[64 * j]; vb[j] = xr2[64 * j]; }
          float s = 0.f, s2 = 0.f;
#pragma unroll
          for (int j = 0; j < 4; ++j) { const f32x4 v = va[j], w = vb[j];
              const unsigned long long pa = (unsigned long long)pk2(v.x, v.y) | ((unsigned long long)pk2(v.z, v.w) << 32), pb = (unsigned long long)pk2(w.x, w.y) | ((unsigned long long)pk2(w.z, w.w) << 32);
              o8[64 * j] = pa; o82[64 * j] = pb;
              const float a0 = bflo((unsigned)pa), a1 = bfhi((unsigned)pa), a2 = bflo((unsigned)(pa >> 32)), a3 = bfhi((unsigned)(pa >> 32)); s += (a0 * a0 + a1 * a1) + (a2 * a2 + a3 * a3);
              const float b0 = bflo((unsigned)pb), b1 = bfhi((unsigned)pb), b2 = bflo((unsigned)(pb >> 32)), b3 = bfhi((unsigned)(pb >> 32)); s2 += (b0 * b0 + b1 * b1) + (b2 * b2 + b3 * b3); }
          s = wave_sum(s); s2 = wave_sum(s2); if (F.lane == 0) { ss0[m] = s; ss0[m2] = s2; } } }
    { float* pb = (float*)(ws + WS_PHIB);
      for (int task = gw; task < 2 * 32 * 4; task += NGW) { const int side = task >> 7, kc = (task >> 2) & 31, cc = task & 3; const float* pe = F.in[side ? 12 : 11]; const float* w1 = F.in[side ? 15 : 13]; float a = 0.f;
          for (int kk = kc * 64; kk < kc * 64 + 64; ++kk) a += pe[kk] * w1[(size_t)kk * 256 + cc * 64 + F.lane];
          atomicAdd(pb + side * 256 + cc * 64 + F.lane, a); } }
}
__device__ __forceinline__ void conv_gate_phase(Frame& F) {
    bf16* BG = (bf16*)(F.ws + WS_BG); const bf16* V = (const bf16*)(F.ws + WS_V); const float* cw = F.in[7];
    const bool grp = (F.G == 256); const int rbase = grp ? (F.vcu >> 5) * 4096 * 128 : 0, nit = grp ? 4096 * 128 : T * 128;
    const int gt = (grp ? (F.vcu & 31) : F.vcu) * (NWAVES * 64) + F.tid, NGT = (grp ? 32 : F.G) * NWAVES * 64;
    const int c0 = (gt & 127) * 8;
    float w0[8], w1[8], w2[8];
#pragma unroll
    for (int j = 0; j < 8; ++j) { w0[j] = cw[c0 + j]; w1[j] = cw[1024 + c0 + j]; w2[j] = cw[2048 + c0 + j]; }
    const v4u z = {0u, 0u, 0u, 0u};
    for (int it = gt; it < nit; it += 2 * NGT) { const int rowa = (rbase + it) >> 7, rowb = (rbase + it + NGT) >> 7, ta = rowa & (SEQ - 1), tb = rowb & (SEQ - 1);
        const v4u a2 = *(const v4u*)(V + (size_t)rowa * 1024 + c0), a1 = ta >= 1 ? *(const v4u*)(V + (size_t)(rowa - 1) * 1024 + c0) : z, a0 = ta >= 2 ? *(const v4u*)(V + (size_t)(rowa - 2) * 1024 + c0) : z, ba = *(const v4u*)(BG + (size_t)rowa * 1024 + c0);
        const v4u b2 = *(const v4u*)(V + (size_t)rowb * 1024 + c0), b1 = tb >= 1 ? *(const v4u*)(V + (size_t)(rowb - 1) * 1024 + c0) : z, b0 = tb >= 2 ? *(const v4u*)(V + (size_t)(rowb - 2) * 1024 + c0) : z, bb = *(const v4u*)(BG + (size_t)rowb * 1024 + c0);
        v4u oa, ob;
#pragma unroll
        for (int j = 0; j < 4; ++j) {
            oa[j] = pk2(bflo(ba[j]) * (w0[2 * j] * bflo(a0[j]) + w1[2 * j] * bflo(a1[j]) + w2[2 * j] * bflo(a2[j])), bfhi(ba[j]) * (w0[2 * j + 1] * bfhi(a0[j]) + w1[2 * j + 1] * bfhi(a1[j]) + w2[2 * j + 1] * bfhi(a2[j])));
            ob[j] = pk2(bflo(bb[j]) * (w0[2 * j] * bflo(b0[j]) + w1[2 * j] * bflo(b1[j]) + w2[2 * j] * bflo(b2[j])), bfhi(bb[j]) * (w0[2 * j + 1] * bfhi(b0[j]) + w1[2 * j + 1] * bfhi(b1[j]) + w2[2 * j + 1] * bfhi(b2[j]))); }
        *(v4u*)(BG + (size_t)rowa * 1024 + c0) = oa; *(v4u*)(BG + (size_t)rowb * 1024 + c0) = ob; }
}
__device__ __forceinline__ void phi2_phase(Frame& F, int task0, int tstep, int tend) {
    LAS float* hs = (LAS float*)(F.lds + RING_OFF + F.wave * 8192);
    for (int task = task0; task < tend; task += tstep) { const int side = task / (PHI_ROWS / 8), r0 = (task % (PHI_ROWS / 8)) * 8;
        const bf16* H = (const bf16*)(F.ws + WS_PHIH) + (size_t)side * PHI_ROWS * 256 + (size_t)r0 * 256; const float* w2 = F.in[side ? 16 : 14];
#pragma unroll
        for (int j = 0; j < 4; ++j) { const v4u w = *(const v4u*)(H + F.lane * 32 + j * 8);
#pragma unroll
            for (int q = 0; q < 4; ++q) { hs[F.lane * 32 + j * 8 + 2 * q] = bflo(w[q]); hs[F.lane * 32 + j * 8 + 2 * q + 1] = bfhi(w[q]); } }
        LDS_WAIT(); asm volatile("" ::: "memory");
        float acc[8] = {0.f, 0.f, 0.f, 0.f, 0.f, 0.f, 0.f, 0.f};
        for (int c = 0; c < 256; c += 4) { const float wa = w2[(c + 0) * 64 + F.lane], wb = w2[(c + 1) * 64 + F.lane], wc = w2[(c + 2) * 64 + F.lane], wd = w2[(c + 3) * 64 + F.lane];
#pragma unroll
            for (int i = 0; i < 8; ++i) { const f32x4 h = *(const LAS f32x4*)(hs + i * 256 + c); acc[i] += h.x * wa + h.y * wb + h.z * wc + h.w * wd; } }
        bf16* O = (bf16*)(F.ws + (side ? WS_VCMP : WS_KCMP));
#pragma unroll
        for (int i = 0; i < 8; ++i) O[(size_t)(r0 + i) * 64 + F.lane] = (bf16)f2bf(acc[i]);
        LDS_WAIT(); asm volatile("" ::: "memory"); }
}
__device__ __forceinline__ void vsel_transpose_phase(Frame& F, int task0, int tstep) {
    LAS unsigned short* ts = (LAS unsigned short*)(F.lds + RING_OFF + F.wave * 16384);
    const int lane = F.lane;
    const bf16* VSEL = (const bf16*)(F.ws + WS_KVQ) + 3 * KVQ_TSTRIDE; bf16* VT = (bf16*)(F.ws + WS_VT);
    const int key = lane, s = key >> 5, k5 = key & 31, e = ((k5 >> 4) << 2) | (k5 & 3), q4 = (k5 >> 2) & 3, slot = 32 * s + 8 * q4 + e;
    for (int task = task0; task < BATCH * NG * 128; task += tstep) { const int blk = task & 127, g = (task >> 7) & 3, b = task >> 9;
        const v4u* src = (const v4u*)(VSEL + ((size_t)b * SEQ + 64 * blk + key) * 256 + g * 64);
#pragma unroll
        for (int c = 0; c < 8; ++c) { const v4u w = src[c];
#pragma unroll
            for (int q = 0; q < 4; ++q) { ts[(8 * c + 2 * q) * 72 + slot] = (unsigned short)(w[q] & 0xffffu); ts[(8 * c + 2 * q + 1) * 72 + slot] = (unsigned short)(w[q] >> 16); } }
        LDS_WAIT(); asm volatile("" ::: "memory");
        v4u* dst = (v4u*)(VT + (size_t)task * 4096 + lane * 64);
#pragma unroll
        for (int c = 0; c < 8; ++c) dst[c] = *(const LAS v4u*)(ts + lane * 72 + 8 * c);
        LDS_WAIT(); asm volatile("" ::: "memory"); }
}
__device__ __forceinline__ void final_norm_phase(Frame& F) {
    const bool grp = (F.G == 256); const int mbase = grp ? (F.vcu >> 5) * 4096 : 0, mend = grp ? mbase + 4096 : T;
    const int gw = mbase + (grp ? (F.vcu & 31) : F.vcu) * NWAVES + F.wave, NGW = (grp ? 32 : F.G) * NWAVES; const float* ss = (const float*)(F.ws + WS_SS) + 4 * T; const float* gn = F.in[19]; const bf16* XB = (const bf16*)(F.ws + WS_XB);
    f32x4 g4[4];
#pragma unroll
    for (int j = 0; j < 4; ++j) g4[j] = *((const f32x4*)gn + F.lane + 64 * j);
    for (int m = gw; m < mend; m += 2 * NGW) { const int m2 = m + NGW;
        GAS f32x4* xr = (GAS f32x4*)(F.out + (size_t)m * DM) + F.lane; GAS f32x4* xr2 = (GAS f32x4*)(F.out + (size_t)m2 * DM) + F.lane;
        const GAS unsigned long long* xs = (const GAS unsigned long long*)(XB + (size_t)m * DM) + F.lane; const GAS unsigned long long* xs2 = (const GAS unsigned long long*)(XB + (size_t)m2 * DM) + F.lane;
        unsigned long long wa[4], wb[4];
#pragma unroll
        for (int j = 0; j < 4; ++j) { wa[j] = xs[64 * j]; wb[j] = xs2[64 * j]; }
        const float rs = __builtin_amdgcn_rsqf(ss[m] * (1.0f / 1024.0f) + 1e-6f), rs2 = __builtin_amdgcn_rsqf(ss[m2] * (1.0f / 1024.0f) + 1e-6f);
#pragma unroll
        for (int j = 0; j < 4; ++j) { f32x4 v = (f32x4){bflo((unsigned)wa[j]), bfhi((unsigned)wa[j]), bflo((unsigned)(wa[j] >> 32)), bfhi((unsigned)(wa[j] >> 32))}; xr[64 * j] = v * rs * g4[j];
            f32x4 w = (f32x4){bflo((unsigned)wb[j]), bfhi((unsigned)wb[j]), bflo((unsigned)(wb[j] >> 32)), bfhi((unsigned)(wb[j] >> 32))}; xr2[64 * j] = w * rs2 * g4[j]; } }
}

__device__ __forceinline__ int t5_bucket_dev(int d) {
    if (d < 16) return d;
    int b = 16;
    b += (d >= 19); b += (d >= 21); b += (d >= 24); b += (d >= 27); b += (d >= 31); b += (d >= 35); b += (d >= 40); b += (d >= 46);
    b += (d >= 52); b += (d >= 59); b += (d >= 67); b += (d >= 77); b += (d >= 87); b += (d >= 99); b += (d >= 113);
    return b;
}
__device__ __forceinline__ void build_bias_table(Frame& F, LAS float* BT) {
    for (int i = F.tid; i < 128 * 16; i += NWAVES * 64) BT[i] = F.in[1][t5_bucket_dev(i >> 4) * 16 + (i & 15)];
}
__device__ __forceinline__ void attn_naive_phase(Frame& F, bf16* O) {
    LAS float* BT = (LAS float*)(F.lds + RING_OFF);
    LAS float* qs = (LAS float*)(F.lds + RING_OFF + 8192 + F.wave * 4096);
    LAS float* imp = qs + 256;
    LAS int* selb = (LAS int*)(imp + 512);
    LAS float* MC = (LAS float*)(selb + 16);
    LAS float* LG = (LAS float*)(F.lds + RING_OFF + 8192 + 8 * 4096 + F.wave * 8192);
    build_bias_table(F, BT);
    __syncthreads();
    const bf16* KVQ = (const bf16*)(F.ws + WS_KVQ);
    const bf16* GATES = KVQ + 10 * KVQ_TSTRIDE; const bf16* KCMP = (const bf16*)(F.ws + WS_KCMP); const bf16* VCMP = (const bf16*)(F.ws + WS_VCMP);
    const int gw = F.vcu * NWAVES + F.wave, NGW = F.G * NWAVES, lane0 = F.lane;
#pragma unroll 1
    for (int task = gw; task < T * NG; task += NGW) {
        int lane = lane0; asm volatile("" : "+v"(lane));
        const int row = task >> 2, g = task & 3, b = row >> 13, pos = row & (SEQ - 1);
        { const bf16* qp = KVQ + (size_t)(6 + g) * KVQ_TSTRIDE + (size_t)row * 256 + lane * 4; const unsigned long long w = *(const unsigned long long*)qp;
          qs[lane * 4 + 0] = bflo((unsigned)w); qs[lane * 4 + 1] = bfhi((unsigned)w); qs[lane * 4 + 2] = bflo((unsigned)(w >> 32)); qs[lane * 4 + 3] = bfhi((unsigned)(w >> 32)); }
        LDS_WAIT(); asm volatile("" ::: "memory");
        const int nv = pos >= 31 ? ((pos - 31) >> 4) + 1 : 0;
        float oacc[4] = {0.f, 0.f, 0.f, 0.f};
#pragma unroll 1
        for (int br = 0; br < 3; ++br) {
            const bf16* Kt = br == 0 ? KCMP : KVQ + (size_t)(br == 1 ? 2 : 4) * KVQ_TSTRIDE; const bf16* Vt = br == 0 ? VCMP : KVQ + (size_t)(br == 1 ? 3 : 5) * KVQ_TSTRIDE;
            const int nc = br == 0 ? (nv + 63) >> 6 : (br == 1 ? 16 : 8);
            float m[4] = {-1e30f, -1e30f, -1e30f, -1e30f}, Z[4] = {0.f, 0.f, 0.f, 0.f}, o[4] = {0.f, 0.f, 0.f, 0.f};
#pragma unroll 1
            for (int c = 0; c < nc; ++c) { asm volatile("" ::: "memory");
                int ridx, dist; bool valid;
                if (br == 0) { const int n = c * 64 + lane; ridx = b * 512 + n; dist = pos - 16 * n - 31; valid = n < nv; }
                else if (br == 1) { const int bk = selb[c]; const int tok = bk * 64 + lane; ridx = b * SEQ + tok; dist = pos - tok; valid = (bk >= 0) && dist >= 0; }
                else { const int kp = pos - 511 + c * 64 + lane; ridx = b * SEQ + kp; dist = pos - kp; valid = kp >= 0; }
                const unsigned long long vmask = __ballot(valid);
                if (vmask == 0ull) continue;
                float l[4] = {0.f, 0.f, 0.f, 0.f};
                if (valid) { const v4u* kr = (const v4u*)(Kt + (size_t)ridx * 256 + g * 64);
#pragma unroll 2
                    for (int j = 0; j < 8; ++j) { asm volatile("" ::: "memory"); const v4u w = kr[j]; float f[8];
#pragma unroll
                        for (int q = 0; q < 4; ++q) { f[2 * q] = bflo(w[q]); f[2 * q + 1] = bfhi(w[q]); }
#pragma unroll
                        for (int h = 0; h < 4; ++h) { const f32x4 qa = *(const LAS f32x4*)(qs + h * 64 + 8 * j), qb = *(const LAS f32x4*)(qs + h * 64 + 8 * j + 4);
                            l[h] += (f[0] * qa.x + f[1] * qa.y) + (f[2] * qa.z + f[3] * qa.w) + (f[4] * qb.x + f[5] * qb.y) + (f[6] * qb.z + f[7] * qb.w); } }
                    const int dd = dist < 127 ? dist : 127;
#pragma unroll
                    for (int h = 0; h < 4; ++h) l[h] += BT[dd * 16 + g * 4 + h]; }
                float p[4];
#pragma unroll
                for (int h = 0; h < 4; ++h) { const float lv = valid ? l[h] : -1e30f; const float mn = fmaxf(m[h], wave_max(lv)); const float sc = __expf(m[h] - mn);
                    p[h] = valid ? __expf(lv - mn) : 0.f; Z[h] = Z[h] * sc + wave_sum(p[h]); o[h] *= sc; m[h] = mn; }
                if (br == 0) {
#pragma unroll
                    for (int h = 0; h < 4; ++h) { LG[h * 512 + c * 64 + lane] = p[h]; if (lane == 0) MC[c * 4 + h] = m[h]; } }
                unsigned long long vm = vmask;
                while (vm) { const int ll = __builtin_ctzll(vm); vm &= vm - 1ull;
                    const int r = __builtin_amdgcn_readlane(ridx, ll); const float v = bf2f(Vt[(size_t)r * 256 + g * 64 + lane]);
#pragma unroll
                    for (int h = 0; h < 4; ++h) o[h] += __uint_as_float(__builtin_amdgcn_readlane(__float_as_uint(p[h]), ll)) * v; } }
            { const bf16* gp = GATES + (size_t)row * 256 + g * 12 + br;
#pragma unroll
              for (int h = 0; h < 4; ++h) { const float zi = Z[h] > 0.f ? 1.0f / Z[h] : 0.f; Z[h] = zi; oacc[h] += bf2f(gp[h * 3]) * o[h] * zi; } }
            if (br == 0) {
                LDS_WAIT(); asm volatile("" ::: "memory");
#pragma unroll 1
                for (int c = 0; c < 8; ++c) { const int n = c * 64 + lane; float s = 0.f;
                    if (c < nc) {
#pragma unroll
                        for (int h = 0; h < 4; ++h) s += LG[h * 512 + n] * __expf(MC[c * 4 + h] - m[h]) * Z[h]; }
                    imp[n] = s; }
                LDS_WAIT(); asm volatile("" ::: "memory");
                unsigned khi[2], klo[2]; const int cb = pos >> 6;
#pragma unroll
                for (int k = 0; k < 2; ++k) { const int j = lane + 64 * k; float s = 2.0f * (imp[4 * j] + imp[4 * j + 1] + imp[4 * j + 2]) + imp[4 * j + 3]; if (j > 0) s += imp[4 * j - 1];
                    const bool forced = (j == 0) || (j == cb) || (j == cb - 1), future = j > cb; const float sc = forced ? 1e9f : s;
                    khi[k] = future ? 0u : (__float_as_uint(sc) + 1u); klo[k] = 128u - (unsigned)j; }
                LDS_WAIT(); asm volatile("" ::: "memory");
#pragma unroll 1
                for (int i = 0; i < 16; ++i) { unsigned h, l; const bool first = (khi[0] > khi[1]) || (khi[0] == khi[1] && klo[0] > klo[1]); h = first ? khi[0] : khi[1]; l = first ? klo[0] : klo[1];
#pragma unroll
                    for (int off = 1; off < 64; off <<= 1) { const unsigned oh = __shfl_xor(h, off), ol = __shfl_xor(l, off); if (oh > h || (oh == h && ol > l)) { h = oh; l = ol; } }
                    h = __builtin_amdgcn_readfirstlane(h); l = __builtin_amdgcn_readfirstlane(l);
                    if (lane == 0) selb[i] = (h != 0u) ? 128 - (int)l : -1;
#pragma unroll
                    for (int k = 0; k < 2; ++k) if (klo[k] == l) { khi[k] = 0u; klo[k] = 0u; } }
                LDS_WAIT(); asm volatile("" ::: "memory");
            }
        }
#pragma unroll
        for (int h = 0; h < 4; ++h) O[(size_t)row * 1024 + (g * 4 + h) * 64 + lane] = (bf16)f2bf(oacc[h]);
    }
}

namespace nsa {
typedef float f32x16 __attribute__((ext_vector_type(16)));
typedef short s16x4 __attribute__((ext_vector_type(4)));
typedef short v4i16_t __attribute__((ext_vector_type(4)));
constexpr float LOG2E = 1.4426950408889634f, MASKV = -3.0e30f, MINIT = -1.0e30f;
constexpr int KSTR = 144, VSTR = 136, KVBUF = 64 * KSTR + 64 * VSTR;
constexpr int L_KV = 0, L_SC = 35840, L_TB = 72704, L_WSF = L_TB + 8320, L_SELM = L_WSF + 2048, L_NMREF = L_SELM + 1024, L_GS = L_NMREF + 1024, L_FLAG = L_GS + 1024, L_QS = L_FLAG + 128, QS_STR = 144, L_PO = L_QS + 256 * QS_STR, L_G2 = L_PO + 256 * 128, L_LSD = L_G2 + 2048, L_END = L_LSD + 1024;
constexpr int SG = 2, ST_RSTR = 136, ST_LVAL = 256 * ST_RSTR, ST_TAGS = ST_LVAL + 1024, L_ST = 0, STBUF = ST_TAGS + 64;
constexpr int L_ZERO = 2 * STBUF;
static_assert(L_SC + 64 * 128 * 4 <= L_TB && L_ZERO + 4 * ST_RSTR + 16 <= L_TB && L_ZERO % 16 == 0 && (4 * ST_RSTR) % 16 == 0 && L_END <= 163328, "attention LDS map");
constexpr int LSTR = 400;
constexpr int TBN = 130;
__device__ __forceinline__ int crow(int r, int hi) { return (r & 3) + 8 * (r >> 2) + 4 * hi; }
__device__ __forceinline__ float swap_other(float x, int hi) { auto rr = __builtin_amdgcn_permlane32_swap(__float_as_uint(x), __float_as_uint(x), false, false); return hi ? __uint_as_float(rr[0]) : __uint_as_float(rr[1]); }
#define NSA_DPP(x, ctrl) __uint_as_float((unsigned)__builtin_amdgcn_update_dpp(0, (int)__float_as_uint(x), ctrl, 0xF, 0xF, true))
#define NSA_DPPU(x, ctrl) ((unsigned)__builtin_amdgcn_update_dpp(0, (int)(x), ctrl, 0xF, 0xF, true))
__device__ __forceinline__ unsigned cvtpk(float lo, float hi) { typedef float f2 __attribute__((ext_vector_type(2))); typedef __bf16 b2 __attribute__((ext_vector_type(2))); f2 v = {lo, hi}; b2 b = __builtin_convertvector(v, b2); return __builtin_bit_cast(unsigned, b); }

struct TileRegs { v4u k, v; };
__device__ __forceinline__ void tile_load(TileRegs& R, const bf16* Kt, const bf16* Vt, long row0, long rowmax, int tid) {
    long r = row0 + (tid >> 3); r = r < 0 ? 0 : (r > rowmax ? rowmax : r);
    R.k = *(const v4u*)(Kt + r * 256 + (tid & 7) * 8); R.v = *(const v4u*)(Vt + r * 256 + (tid & 7) * 8);
}
__device__ __forceinline__ void tile_store(const TileRegs& R, LAS unsigned char* buf, int tid) {
    *(LAS v4u*)(buf + (tid >> 3) * KSTR + (tid & 7) * 16) = R.k;
    typedef unsigned u2 __attribute__((ext_vector_type(2)));
    LAS unsigned char* vp = buf + 64 * KSTR + (tid >> 3) * VSTR + (tid & 7) * 16;
    *(LAS u2*)vp = (u2){R.v.x, R.v.y}; *(LAS u2*)(vp + 8) = (u2){R.v.z, R.v.w};
}
__device__ __forceinline__ void qkt(f32x16& p0, f32x16& p1, const LAS unsigned char* buf, const LAS unsigned char* qrow  , int r32, int hi) {
    const LAS unsigned char* kb = buf + r32 * KSTR + hi * 16;
    p0 = f32x16{}; p1 = f32x16{};
#pragma unroll
    for (int d0 = 0; d0 < 4; ++d0) { const bf16x8 a0 = *(const LAS bf16x8*)(kb + d0 * 32), a1 = *(const LAS bf16x8*)(kb + 32 * KSTR + d0 * 32), qf = *(const LAS bf16x8*)(qrow + d0 * 32);
        p0 = __builtin_amdgcn_mfma_f32_32x32x16_bf16(a0, qf, p0, 0, 0, 0); p1 = __builtin_amdgcn_mfma_f32_32x32x16_bf16(a1, qf, p1, 0, 0, 0); }
}
__device__ __forceinline__ s16x4 vtr(const LAS unsigned char* p) { return __builtin_bit_cast(s16x4, __builtin_amdgcn_ds_read_tr16_b64_v4i16((LAS v4i16_t*)p)); }
__device__ __forceinline__ void pv(f32x16 (&o)[2], const LAS unsigned char* buf, const unsigned (&pw)[16], int lane) {
    const int hi = lane >> 5; const LAS unsigned char* vb = buf + 64 * KSTR + (((lane & 15) >> 2) + 4 * hi) * VSTR + (lane & 3) * 8 + ((lane >> 4) & 1) * 32;
#pragma unroll
    for (int s = 0; s < 4; ++s) { const bf16x8 pa = __builtin_bit_cast(bf16x8, (v4u){pw[4 * s], pw[4 * s + 1], pw[4 * s + 2], pw[4 * s + 3]});
#pragma unroll
        for (int d0 = 0; d0 < 2; ++d0) { const s16x4 lo = vtr(vb + (16 * s) * VSTR + d0 * 64), hh = vtr(vb + (16 * s + 8) * VSTR + d0 * 64);
            const bf16x8 vf = (bf16x8){lo[0], lo[1], lo[2], lo[3], hh[0], hh[1], hh[2], hh[3]};
            o[d0] = __builtin_amdgcn_mfma_f32_32x32x16_bf16(pa, vf, o[d0], 0, 0, 0); } }
}
__device__ __forceinline__ float rowmax32(const f32x16& p0, const f32x16& p1, int hi) {
    float a = fmaxf(p0[0], p1[0]);
#pragma unroll
    for (int r = 1; r < 16; ++r) a = fmaxf(a, fmaxf(p0[r], p1[r]));
    return fmaxf(a, swap_other(a, hi));
}
template <int MULT, bool FAR>
__device__ __forceinline__ void bias_mask(f32x16& p0, f32x16& p1, int dl, const LAS float* tbl  ) {
#pragma unroll
    for (int r = 0; r < 16; ++r) { const int c = (r & 3) + 8 * (r >> 2);
        const int d0 = dl - MULT * c, d1 = dl - MULT * (c + 32);
        const int i0 = min(max(d0, -1), 128) + 1, i1 = min(max(d1, -1), 128) + 1;
        float b0 = tbl[i0 * 16], b1 = tbl[i1 * 16];
        if (FAR) { if (d0 >= 512) b0 = MASKV; if (d1 >= 512) b1 = MASKV; }
        p0[r] += b0; p1[r] += b1;
        if ((r & 3) == 3) asm volatile("" ::: "memory"); }
}
__device__ __forceinline__ void row_to_regs(float (&fr)[16], float f, LAS float* wsf, int r32, int hi) {
    if (hi == 0) wsf[r32] = f;
    asm volatile("s_waitcnt lgkmcnt(0)" ::: "memory");
#pragma unroll
    for (int r = 0; r < 16; ++r) fr[r] = wsf[crow(r, hi)];
    asm volatile("s_waitcnt lgkmcnt(0)" ::: "memory");
}
}

#ifndef TSEC
#define TSEC 0
#endif
#define TSB(id) do { if (TSEC == (id)) ts0_ = __builtin_amdgcn_s_memrealtime(); } while (0)
#define TSE(id) do { if (TSEC == (id)) tacc_ += __builtin_amdgcn_s_memrealtime() - ts0_; } while (0)
__device__ __forceinline__ void attn_dense_phase(Frame& F) {
    using namespace nsa;
    unsigned long long ts0_ = 0, tacc_ = 0; (void)ts0_;
    LAS unsigned char* L = F.lds + RING_OFF;
    LAS float* TB = (LAS float*)(L + L_TB); LAS float* wsf = (LAS float*)(L + L_WSF) + F.wave * 64; LAS float* SC = (LAS float*)(L + L_SC); LAS unsigned* SELM = (LAS unsigned*)(L + L_SELM);
    const int wave = F.wave;
    for (int i = F.tid; i < TBN * 16; i += NWAVES * 64) { const int idx = i >> 4, hh = i & 15; float v;
        if (idx == 0) v = MASKV; else if (idx == 129) v = 0.f; else v = F.in[1][t5_bucket_dev(idx - 1) * 16 + hh] - F.in[1][31 * 16 + hh];
        TB[i] = v; }
    for (int i = F.tid; i < (4 * ST_RSTR + 16) / 4; i += NWAVES * 64) ((LAS unsigned*)(L + L_ZERO))[i] = 0u;
    __syncthreads();
    const bf16* KVQ = (const bf16*)(F.ws + WS_KVQ); const bf16* GATES = KVQ + 10 * KVQ_TSTRIDE;
    const bf16* KCMP = (const bf16*)(F.ws + WS_KCMP); const bf16* VCMP = (const bf16*)(F.ws + WS_VCMP);
    bf16* O = (bf16*)(F.ws + WS_O);
    unsigned* UCTR0 = (unsigned*)(F.ws + WS_CTL) + 1024; LAS unsigned* UCUR = (LAS unsigned*)(L + L_FLAG) + 17; unsigned ugrp = (unsigned)(F.vcu >> 5) & 7u;
#define NSA_DEAL(dst) do { dst = 2048u; for (int tr_ = 0; tr_ < 8; ++tr_) { const unsigned u_ = atomicAdd(UCTR0 + 64 * ugrp, 1u); if (u_ < 256u) { dst = 256u * ugrp + u_; break; } ugrp = (ugrp + 1u) & 7u; } } while (0)
    if (F.tid == 0) { unsigned d0_; NSA_DEAL(d0_); UCUR[0] = d0_; }
    __syncthreads();
#pragma unroll 1
    for (unsigned ucur = UCUR[0]; ucur < 2048u; ucur = UCUR[0]) {
        const int lane = fresh_lane(), tid = wave * 64 + lane, r32 = lane & 31, hi = lane >> 5, ql = r32 >> 2, h = r32 & 3;
        unsigned unext = 2048u; if (tid == 0) NSA_DEAL(unext);
        const int bg = 2 * (int)(ucur >> 8) + (int)((ucur >> 7) & 1u), b = bg >> 2, g = bg & 3, qt = 127 - (int)(ucur & 127u), t0 = qt * 64, cb = qt;
        const int i = 8 * wave + ql, pos = t0 + i; const long row = (long)b * SEQ + pos;
        const LAS float* tbl = TB + g * 4 + h;
        const LAS unsigned char* qr = L + L_QS + (32 * wave + r32) * QS_STR + hi * 16;
        { const bf16* qp = KVQ + (size_t)(6 + g) * KVQ_TSTRIDE + row * 256 + h * 64 + hi * 8;
#pragma unroll
          for (int d0 = 0; d0 < 4; ++d0) *(LAS bf16x8*)(L + L_QS + (32 * wave + r32) * QS_STR + hi * 16 + d0 * 32) = *(const bf16x8*)(qp + d0 * 16); }
        if (hi == 0) { const bf16* gp = GATES + row * 256 + g * 12 + h * 3; LAS float* G2 = (LAS float*)(L + L_G2) + (32 * wave + r32) * 2; G2[0] = bf2f(gp[0]); G2[1] = bf2f(gp[2]); ((LAS float*)(L + L_GS))[32 * wave + r32] = bf2f(gp[1]); }
        float mwin;
        f32x16 oacc[2];
        TileRegs TR;
        TSB(1);
        { const bf16* Kt = KVQ + 4 * KVQ_TSTRIDE + g * 64; const bf16* Vt = KVQ + 5 * KVQ_TSTRIDE + g * 64; const long base = (long)b * SEQ, rmax = (long)T - 1;
          const int kt0 = t0 >= 512 ? 0 : 8 - cb;
          LAS float* LINE = (LAS float*)(L + L_SC);
          if (tid < LSTR) {
#pragma unroll
              for (int hh = 0; hh < 4; ++hh) { float v; if (tid < 260) { const int d = tid - 68; v = d < 0 ? MASKV : TB[(min(d, 128) + 1) * 16 + g * 4 + hh]; } else v = tid + 184 >= 512 ? MASKV : 0.f;
                  LINE[hh * LSTR + tid] = v; } }
          f32x16 (&o)[2] = oacc; o[0] = f32x16{}; o[1] = f32x16{}; float m = MINIT, l = 0.f;
          tile_load(TR, Kt, Vt, base + t0 - 512 + 64 * kt0, rmax, tid); tile_store(TR, L + L_KV, tid); __syncthreads();
#pragma unroll 1
          for (int kt = kt0; kt < 9; ++kt) { LAS unsigned char* buf = L + L_KV + ((kt - kt0) & 1) * KVBUF;
              if (kt < 8) tile_load(TR, Kt, Vt, base + t0 - 512 + 64 * (kt + 1), rmax, tid);
              f32x16 p0, p1; qkt(p0, p1, buf, qr, r32, hi);
              if (kt == 0 || kt >= 6) { const int dl = 512 - 64 * kt + i - 4 * hi;
                  const LAS float* lp = LINE + h * LSTR + (kt == 0 ? dl - 247 : dl + 5);
#pragma unroll
                  for (int r = 0; r < 16; ++r) { const int c = (r & 3) + 8 * (r >> 2); p0[r] += lp[63 - c]; p1[r] += lp[31 - c]; } }
              p0 *= LOG2E; p1 *= LOG2E;
              const float rm = rowmax32(p0, p1, hi), mn = fmaxf(m, rm), f = __builtin_amdgcn_exp2f(m - mn), nmn = -mn; m = mn; l *= f;
              if (__any(f != 1.0f)) { float fr[16]; row_to_regs(fr, f, wsf, r32, hi);
#pragma unroll
                  for (int r = 0; r < 16; ++r) { o[0][r] *= fr[r]; o[1][r] *= fr[r]; } }
              unsigned pw[16]; p0 += nmn; p1 += nmn;
#pragma unroll
              for (int r = 0; r < 16; ++r) { p0[r] = __builtin_amdgcn_exp2f(p0[r]); p1[r] = __builtin_amdgcn_exp2f(p1[r]); }
              { const f32x16 s = p0 + p1; typedef float f32x2 __attribute__((ext_vector_type(2))); f32x2 s2 = {s[0], s[1]};
#pragma unroll
                for (int r = 1; r < 8; ++r) s2 += (f32x2){s[2 * r], s[2 * r + 1]};
                l += s2.x + s2.y; }
#pragma unroll
              for (int r = 0; r < 8; ++r) { pw[r] = cvtpk(p0[2 * r], p0[2 * r + 1]); pw[8 + r] = cvtpk(p1[2 * r], p1[2 * r + 1]); }
              pv(o, buf, pw, lane);
              if (kt < 8) tile_store(TR, L + L_KV + ((kt - kt0 + 1) & 1) * KVBUF, tid);
              __syncthreads(); }
          const float g_w = ((const LAS float*)(L + L_G2))[(32 * wave + r32) * 2 + 1]; const float lt = l + swap_other(l, hi); float fr[16]; row_to_regs(fr, lt > 0.f ? g_w / lt : 0.f, wsf, r32, hi); mwin = m * (1.0f / LOG2E);
#pragma unroll
          for (int r = 0; r < 16; ++r) { oacc[0][r] *= fr[r]; oacc[1][r] *= fr[r]; } }
        TSE(1); TSB(2);
        { const bf16* Kt = KCMP + g * 64; const bf16* Vt = VCMP + g * 64; const long base = (long)b * 512, rmax = (long)BATCH * 512 - 1;
          const int nvmax = t0 + 63 >= 31 ? ((t0 + 32) >> 4) + 1 : 0, ntc = (nvmax + 63) >> 6;
          float m = MINIT, l = 0.f;
          if (ntc > 0) { tile_load(TR, Kt, Vt, base, rmax, tid); tile_store(TR, L + L_KV, tid); }
          __syncthreads();
#pragma unroll 1
          for (int tc = 0; tc < ntc; ++tc) { LAS unsigned char* buf = L + L_KV + (tc & 1) * KVBUF;
              tile_load(TR, Kt, Vt, base + 64 * (tc + 1 < ntc ? tc + 1 : 0), rmax, tid);
              f32x16 p0, p1; qkt(p0, p1, buf, qr, r32, hi);
              if (t0 - 1024 * tc - 1039 < 128) bias_mask<16, false>(p0, p1, pos - 31 - 1024 * tc - 64 * hi, tbl);
              p0 *= LOG2E; p1 *= LOG2E;
              const float rm = rowmax32(p0, p1, hi), mn = fmaxf(m, rm), nmn = -mn; l *= __builtin_amdgcn_exp2f(m - mn); m = mn;
              p0 += nmn; p1 += nmn;
#pragma unroll
              for (int r = 0; r < 16; ++r) { p0[r] = __builtin_amdgcn_exp2f(p0[r]); p1[r] = __builtin_amdgcn_exp2f(p1[r]); }
              { const f32x16 s = p0 + p1; typedef float f32x2 __attribute__((ext_vector_type(2))); f32x2 s2 = {s[0], s[1]};
#pragma unroll
                for (int r = 1; r < 8; ++r) s2 += (f32x2){s[2 * r], s[2 * r + 1]};
                l += s2.x + s2.y; }
              tile_store(TR, L + L_KV + ((tc + 1) & 1) * KVBUF, tid);
              __syncthreads(); }
          const float g_c = ((const LAS float*)(L + L_G2))[(32 * wave + r32) * 2]; const float lt = l + swap_other(l, hi), linv = lt > 0.f ? 1.0f / lt : 0.f, nm = -m;
          float carry = 0.f;
#pragma unroll 1
          for (int tc = 0; tc < ntc; ++tc) { LAS unsigned char* buf = L + L_KV + ((ntc + tc) & 1) * KVBUF;
              if (tc + 1 < ntc) tile_load(TR, Kt, Vt, base + 64 * (tc + 1), rmax, tid);
              f32x16 p0, p1; qkt(p0, p1, buf, qr, r32, hi);
              if (t0 - 1024 * tc - 1039 < 128) bias_mask<16, false>(p0, p1, pos - 31 - 1024 * tc - 64 * hi, tbl);
              unsigned pw[16];
#pragma unroll
              for (int r = 0; r < 16; ++r) { p0[r] = __builtin_amdgcn_exp2f(fmaf(p0[r], LOG2E, nm)); p1[r] = __builtin_amdgcn_exp2f(fmaf(p1[r], LOG2E, nm)); }
              p0 *= linv; p1 *= linv;
#pragma unroll
              for (int r = 0; r < 8; ++r) { pw[r] = cvtpk(p0[2 * r] * g_c, p0[2 * r + 1] * g_c); pw[8 + r] = cvtpk(p1[2 * r] * g_c, p1[2 * r + 1] * g_c); }
              pv(oacc, buf, pw, lane);
              float w8[8], c8[8];
#pragma unroll
              for (int kq = 0; kq < 8; ++kq) { float a[4];
#pragma unroll
                  for (int e = 0; e < 4; ++e) { float x = kq < 4 ? p0[4 * kq + e] : p1[4 * (kq - 4) + e]; x += NSA_DPP(x, 0xB1); x += NSA_DPP(x, 0x4E); a[e] = x; }
                  w8[kq] = 2.0f * (a[0] + a[1] + a[2]) + a[3]; c8[kq] = a[3]; }
#pragma unroll
              for (int kq = 0; kq < 8; ++kq) { const float ok = swap_other(c8[kq], hi); w8[kq] += hi ? ok : carry; carry = ok; }
              LAS float* scq = SC + i * 128 + 16 * tc;
#pragma unroll
              for (int kq = 0; kq < 8; ++kq) if ((kq & 3) == h) scq[2 * kq + hi] = w8[kq];
              if (tc + 1 < ntc) tile_store(TR, L + L_KV + ((ntc + tc + 1) & 1) * KVBUF, tid);
              __syncthreads(); }
        }
        TSE(2); TSB(3);
        { const int lq = lane >> 3, sub = lane & 7; unsigned msk[4] = {0u, 0u, 0u, 0u};
          if (cb <= 15) { msk[0] = (cb == 31) ? 0xffffffffu : ((1u << (cb + 1)) - 1u); }
          else { unsigned key[16]; const LAS float* scq = SC + (8 * wave + lq) * 128;
              asm volatile("s_waitcnt lgkmcnt(0)" ::: "memory");
#pragma unroll
              for (int kk = 0; kk < 16; ++kk) { const int j = sub + 8 * kk; const float s = scq[j]; key[kk] = (j >= 1 && j <= cb - 2) ? ((__float_as_uint(s) & 0xFFFFFF80u) | (unsigned)(127 - j)) : 0u; }
#pragma unroll 1
              for (int rd = 0; rd < 13; ++rd) { unsigned mx = key[0];
#pragma unroll
                  for (int kk = 1; kk < 16; ++kk) mx = mx > key[kk] ? mx : key[kk];
                  { unsigned o1 = NSA_DPPU(mx, 0xB1); mx = mx > o1 ? mx : o1; o1 = NSA_DPPU(mx, 0x4E); mx = mx > o1 ? mx : o1; o1 = NSA_DPPU(mx, 0x141); mx = mx > o1 ? mx : o1; }
                  const int j = 127 - (int)(mx & 127u);
#pragma unroll
                  for (int w4 = 0; w4 < 4; ++w4) if (mx != 0u && (j >> 5) == w4) msk[w4] |= 1u << (j & 31);
#pragma unroll
                  for (int kk = 0; kk < 16; ++kk) if (key[kk] == mx) key[kk] = 0u; }
              msk[0] |= 1u;
#pragma unroll
              for (int w4 = 0; w4 < 4; ++w4) { if (((cb - 1) >> 5) == w4) msk[w4] |= 1u << ((cb - 1) & 31); if ((cb >> 5) == w4) msk[w4] |= 1u << (cb & 31); } }
          if (sub < 4) { const unsigned mv = sub == 0 ? msk[0] : sub == 1 ? msk[1] : sub == 2 ? msk[2] : msk[3];
              SELM[(8 * wave + lq) * 4 + sub] = mv; } }
        TSE(3); TSB(4);
        { LAS unsigned short* PO = (LAS unsigned short*)(L + L_PO);
#pragma unroll
          for (int r = 0; r < 16; ++r) { const int rw = 32 * wave + crow(r, hi); PO[rw * 64 + r32] = (unsigned short)f2bf(oacc[0][r]); PO[rw * 64 + 32 + r32] = (unsigned short)f2bf(oacc[1][r]); } }
        { LAS float* NMREF = (LAS float*)(L + L_NMREF); LAS float* GS = (LAS float*)(L + L_GS); LAS unsigned char* QS = L + L_QS; LAS unsigned* FLAG = (LAS unsigned*)(L + L_FLAG);
          { const int l2 = fresh_lane(); if (l2 < 32) NMREF[32 * wave + l2] = -mwin * LOG2E; if (wave == 0 && l2 == 0) FLAG[16] = 1u; }
          __syncthreads();
          if (tid < 260) {
#pragma unroll
              for (int hh = 0; hh < 4; ++hh) { const int d = tid - 68; ((LAS float*)(L + L_SC))[hh * LSTR + tid] = d < 0 ? MASKV : TB[(min(d, 128) + 1) * 16 + g * 4 + hh]; } }
          f32x16 osel[2]; osel[0] = f32x16{}; osel[1] = f32x16{};
          { const bf16* Kt = KVQ + 2 * KVQ_TSTRIDE + g * 64; const bf16* Vt = KVQ + 3 * KVQ_TSTRIDE + g * 64; const long base = (long)b * SEQ, rmax = (long)T - 1;
            const int nd = cb <= 15 ? cb + 1 : 3; const float nmw = -mwin * LOG2E; float lsd = 0.f;
#define NSA_DBLK(ii) (cb <= 15 ? (ii) : ((ii) == 0 ? 0 : cb - 2 + (ii)))
            tile_load(TR, Kt, Vt, base + 64 * NSA_DBLK(0), rmax, tid); tile_store(TR, L + L_KV, tid); __syncthreads();
#pragma unroll 1
            for (int ii = 0; ii < nd; ++ii) { LAS unsigned char* buf = L + L_KV + (ii & 1) * KVBUF; const int blk = NSA_DBLK(ii);
                if (ii + 1 < nd) tile_load(TR, Kt, Vt, base + 64 * NSA_DBLK(ii + 1), rmax, tid);
                f32x16 p0, p1; qkt(p0, p1, buf, qr, r32, hi);
                if (blk >= cb - 2) { const LAS float* lp = (const LAS float*)(L + L_SC) + h * LSTR + (t0 + i - 64 * blk - 4 * hi) + 5;
#pragma unroll
                    for (int r = 0; r < 16; ++r) { const int c = (r & 3) + 8 * (r >> 2); p0[r] += lp[63 - c]; p1[r] += lp[31 - c]; } }
                unsigned pw[16]; float ls = 0.f;
#pragma unroll
                for (int r = 0; r < 16; ++r) { p0[r] = __builtin_amdgcn_exp2f(fminf(fmaf(p0[r], LOG2E, nmw), 100.f)); p1[r] = __builtin_amdgcn_exp2f(fminf(fmaf(p1[r], LOG2E, nmw), 100.f)); ls += p0[r] + p1[r]; }
                lsd += ls;
#pragma unroll
                for (int r = 0; r < 8; ++r) { pw[r] = cvtpk(p0[2 * r], p0[2 * r + 1]); pw[8 + r] = cvtpk(p1[2 * r], p1[2 * r + 1]); }
                pv(osel, buf, pw, lane);
                if (ii + 1 < nd) tile_store(TR, L + L_KV + ((ii + 1) & 1) * KVBUF, tid);
                __syncthreads(); }
#undef NSA_DBLK
            lsd += swap_other(lsd, hi); if (hi == 0) ((LAS float*)(L + L_LSD))[32 * wave + r32] = lsd; }
          float osp[4][8]; float lsp[4] = {0.f, 0.f, 0.f, 0.f};
          { LAS float* cv = (LAS float*)(L + L_ST) + wave * 2048;
#pragma unroll
            for (int r = 0; r < 16; ++r) { cv[crow(r, hi) * 64 + r32] = osel[0][r]; cv[crow(r, hi) * 64 + 32 + r32] = osel[1][r]; }
            asm volatile("s_waitcnt lgkmcnt(0)" ::: "memory");
            const LAS float* cr = cv + (4 * (lane >> 3)) * 64 + 8 * (lane & 7);
#pragma unroll
            for (int hh = 0; hh < 4; ++hh) { const f32x4 a = *(const LAS f32x4*)(cr + hh * 64), bq = *(const LAS f32x4*)(cr + hh * 64 + 4);
#pragma unroll
                for (int e = 0; e < 4; ++e) { osp[hh][e] = a[e]; osp[hh][4 + e] = bq[e]; } } }
          __syncthreads();
          const int fr16 = lane & 15, q4 = lane >> 4, qi = fr16 >> 2, hc = fr16 & 3;
          const bf16* Ks = KVQ + 2 * KVQ_TSTRIDE + ((long)b * SEQ) * 256 + g * 64; const bf16* VT = (const bf16*)(F.ws + WS_VT) + (size_t)((b * 4 + g) * 128) * 4096;
          bf16x8 Kf[4][2] = {}, Vf[4][2] = {}; unsigned long long qm = 0ull, qmn = 0ull; int jn = 0, jc = 0, jcn = 0;
#define NSA_SCAN_NEXT() do { qmn = 0ull; for (;;) { unsigned jx = 0u; if (lane == 0) jx = __hip_atomic_fetch_add(FLAG + 16, 1u, __ATOMIC_RELAXED, __HIP_MEMORY_SCOPE_WORKGROUP); \
              const int jt = __builtin_amdgcn_readfirstlane((int)jx); if (jt > cb - 2) break; const int j = cb - 1 - jt;     \
              { const unsigned wv = SELM[lane * 4 + (j >> 5)]; qmn = __ballot((wv >> (j & 31)) & 1u); } \
              jcn = j; if (qmn) break; } } while (0)
#define NSA_LOAD_K(j) do { const bf16* kp = Ks + (size_t)(64 * (j) + fr16) * 256 + 8 * q4; \
              _Pragma("unroll") for (int a = 0; a < 4; ++a) _Pragma("unroll") for (int s2 = 0; s2 < 2; ++s2) Kf[a][s2] = *(const bf16x8*)(kp + a * 16 * 256 + s2 * 32); } while (0)
#define NSA_LOAD_V(j) do { const bf16* vp = VT + (size_t)(j) * 4096 + fr16 * 64 + 8 * q4; \
              _Pragma("unroll") for (int a = 0; a < 4; ++a) _Pragma("unroll") for (int s2 = 0; s2 < 2; ++s2) Vf[a][s2] = *(const bf16x8*)(vp + a * 16 * 64 + s2 * 32); } while (0)
#define NSA_LOAD_K_D(j, dep) do { const bf16* kp = Ks + (size_t)(64 * (j) + fr16) * 256 + 8 * q4 + (dep); \
              _Pragma("unroll") for (int a = 0; a < 4; ++a) _Pragma("unroll") for (int s2 = 0; s2 < 2; ++s2) Kf[a][s2] = *(const bf16x8*)(kp + a * 16 * 256 + s2 * 32); } while (0)
#define NSA_LOAD_V_D(j, dep) do { const bf16* vp = VT + (size_t)(j) * 4096 + fr16 * 64 + 8 * q4 + (dep); \
              _Pragma("unroll") for (int a = 0; a < 4; ++a) _Pragma("unroll") for (int s2 = 0; s2 < 2; ++s2) Vf[a][s2] = *(const bf16x8*)(vp + a * 16 * 64 + s2 * 32); } while (0)
          if (cb > 15) {
              int gi = 0, rd = 0; bool fin = false;
              auto consume = [&]() __attribute__((always_inline)) { const LAS unsigned char* sb = L + L_ST + (rd & 1) * STBUF;
                const unsigned tg = *(sb + ST_TAGS + lane);
                const int ql8 = lane >> 3; unsigned long long mym = 0ull;
#pragma unroll
                for (int q = 0; q < 8; ++q) { const unsigned long long bm = __ballot(tg == (unsigned)(8 * wave + q)); if (ql8 == q) mym = bm; }
                typedef unsigned u2 __attribute__((ext_vector_type(2)));
                auto pull2 = [&]() __attribute__((always_inline)) {
                    const bool a0 = mym != 0ull; const int j0 = a0 ? __builtin_ctzll(mym) : 0; mym &= mym - 1ull;
                    const bool a1 = mym != 0ull; const int j1 = a1 ? __builtin_ctzll(mym) : 0; mym &= mym - 1ull;
                    const LAS unsigned char* dp0 = (a0 ? sb + (4 * j0) * ST_RSTR : L + L_ZERO) + 16 * (lane & 7); const LAS unsigned char* dp1 = (a1 ? sb + (4 * j1) * ST_RSTR : L + L_ZERO) + 16 * (lane & 7);
                    const f32x4 lv0 = *(const LAS f32x4*)(a0 ? sb + ST_LVAL + 16 * j0 : L + L_ZERO + 4 * ST_RSTR), lv1 = *(const LAS f32x4*)(a1 ? sb + ST_LVAL + 16 * j1 : L + L_ZERO + 4 * ST_RSTR);
                    u2 d0[4][2], d1[4][2];
#pragma unroll
                    for (int hh = 0; hh < 4; ++hh) { d0[hh][0] = *(const LAS u2*)(dp0 + hh * ST_RSTR); d0[hh][1] = *(const LAS u2*)(dp0 + hh * ST_RSTR + 8); d1[hh][0] = *(const LAS u2*)(dp1 + hh * ST_RSTR); d1[hh][1] = *(const LAS u2*)(dp1 + hh * ST_RSTR + 8); }
#pragma unroll
                    for (int hh = 0; hh < 4; ++hh) {
#pragma unroll
                        for (int w = 0; w < 2; ++w) { const unsigned x0 = d0[hh][w].x, y0 = d0[hh][w].y, x1 = d1[hh][w].x, y1 = d1[hh][w].y;
                            osp[hh][4 * w + 0] += __uint_as_float(x0 << 16) + __uint_as_float(x1 << 16); osp[hh][4 * w + 1] += __uint_as_float(x0 & 0xFFFF0000u) + __uint_as_float(x1 & 0xFFFF0000u);
                            osp[hh][4 * w + 2] += __uint_as_float(y0 << 16) + __uint_as_float(y1 << 16); osp[hh][4 * w + 3] += __uint_as_float(y0 & 0xFFFF0000u) + __uint_as_float(y1 & 0xFFFF0000u); }
                        lsp[hh] += lv0[hh] + lv1[hh]; } };
                if (__ballot(mym != 0ull) != 0ull) { pull2();
                    if (__ballot(mym != 0ull) != 0ull) { pull2();
                        while (__ballot(mym != 0ull) != 0ull) pull2(); } } };
              auto round_end = [&](const bool more) __attribute__((always_inline)) -> bool {
                if (lane == 0) FLAG[(rd & 1) * 8 + wave] = more ? 1u : 0u;
                asm volatile("s_waitcnt lgkmcnt(0)" ::: "memory"); __builtin_amdgcn_s_barrier(); asm volatile("" ::: "memory");
                const unsigned any = FLAG[(rd & 1) * 8 + (lane & 7)];
                consume(); ++rd; gi = 0;
                return __ballot(any != 0u) == 0ull; };
              auto group = [&](const bool last) __attribute__((always_inline)) {
                  LAS unsigned char* stb = L + L_ST + (rd & 1) * STBUF; const int sidx = wave * SG + gi;
                  LAS unsigned char* sdat = stb + (16 * sidx + fr16) * ST_RSTR; LAS float* slv = (LAS float*)(stb + ST_LVAL) + 16 * sidx + fr16; LAS unsigned char* stg = stb + ST_TAGS + 4 * sidx;
                  int iq[4];
#pragma unroll
                  for (int e = 0; e < 4; ++e) { if (qm) { iq[e] = __builtin_ctzll(qm); qm &= qm - 1ull; } else iq[e] = -1; }
                  const int myq = qi == 0 ? iq[0] : qi == 1 ? iq[1] : qi == 2 ? iq[2] : iq[3]; const bool cval = myq >= 0; const int rowq = 4 * (cval ? myq : iq[0]) + hc;
                  const bf16x8 q0 = *(const LAS bf16x8*)(QS + rowq * QS_STR + q4 * 16), q1 = *(const LAS bf16x8*)(QS + rowq * QS_STR + 64 + q4 * 16);
                  const float nmr = NMREF[rowq];
                  f32x4 st[4];
#pragma unroll
                  for (int kt = 0; kt < 4; ++kt) { st[kt] = (f32x4){0.f, 0.f, 0.f, 0.f};
                      st[kt] = __builtin_amdgcn_mfma_f32_16x16x32_bf16(Kf[kt][0], q0, st[kt], 0, 0, 0); st[kt] = __builtin_amdgcn_mfma_f32_16x16x32_bf16(Kf[kt][1], q1, st[kt], 0, 0, 0); }
                  const int jnx = qmn ? jcn : jc;
                  if (last) { int dep = 0; asm volatile("" : "+v"(dep) : "v"(st[0]), "v"(st[1]), "v"(st[2]), "v"(st[3])); NSA_LOAD_K_D(jnx, dep); }
                  if (jc >= cb - 2) { const int dl = t0 + (cval ? myq : iq[0]) - 64 * jc - 4 * q4; const LAS float* tb2 = TB + g * 4 + hc;
#pragma unroll
                      for (int kt = 0; kt < 4; ++kt)
#pragma unroll
                          for (int r = 0; r < 4; ++r) { const int d = dl - 16 * kt - r; st[kt][r] += tb2[(min(max(d, -1), 128) + 1) * 16]; } }
                  float ls = 0.f;
#pragma unroll
                  for (int kt = 0; kt < 4; ++kt)
#pragma unroll
                      for (int r = 0; r < 4; ++r) { const float p = __builtin_amdgcn_exp2f(fminf(fmaf(st[kt][r], LOG2E, nmr), 100.f)); st[kt][r] = p; ls += p; }
                  { const auto s16 = __builtin_amdgcn_permlane16_swap(__float_as_uint(ls), __float_as_uint(ls), false, false); ls = __uint_as_float(s16[0]) + __uint_as_float(s16[1]);
                    const auto s32 = __builtin_amdgcn_permlane32_swap(__float_as_uint(ls), __float_as_uint(ls), false, false); ls = __uint_as_float(s32[0]) + __uint_as_float(s32[1]); }
                  if (q4 == 0) slv[0] = ls;
                  if (lane < 4) stg[lane] = (unsigned char)(lane == 0 ? iq[0] : lane == 1 ? iq[1] : lane == 2 ? iq[2] : iq[3]);
                  bf16x8 pf[2];
#pragma unroll
                  for (int s2 = 0; s2 < 2; ++s2) pf[s2] = __builtin_bit_cast(bf16x8, (v4u){cvtpk(st[2 * s2][0], st[2 * s2][1]), cvtpk(st[2 * s2][2], st[2 * s2][3]), cvtpk(st[2 * s2 + 1][0], st[2 * s2 + 1][1]), cvtpk(st[2 * s2 + 1][2], st[2 * s2 + 1][3])});
                  f32x4 ot[4];
#pragma unroll
                  for (int dt = 0; dt < 4; ++dt) { ot[dt] = (f32x4){0.f, 0.f, 0.f, 0.f};
                      ot[dt] = __builtin_amdgcn_mfma_f32_16x16x32_bf16(Vf[dt][0], pf[0], ot[dt], 0, 0, 0); ot[dt] = __builtin_amdgcn_mfma_f32_16x16x32_bf16(Vf[dt][1], pf[1], ot[dt], 0, 0, 0); }
                  if (last) { int dep = 0; asm volatile("" : "+v"(dep) : "v"(ot[0]), "v"(ot[1]), "v"(ot[2]), "v"(ot[3])); NSA_LOAD_V_D(jnx, dep); }
#pragma unroll
                  for (int dt = 0; dt < 4; ++dt) { typedef unsigned u2 __attribute__((ext_vector_type(2)));
                      *(LAS u2*)(sdat + (16 * dt + 4 * q4) * 2) = (u2){cvtpk(ot[dt][0], ot[dt][1]), cvtpk(ot[dt][2], ot[dt][3])}; } };
              NSA_SCAN_NEXT(); if (qmn) { NSA_LOAD_K(jcn); NSA_LOAD_V(jcn); }
#pragma unroll 1
              while (qmn != 0ull) { qm = qmn; jc = jcn;
#pragma unroll 1
                  while (__builtin_popcountll(qm) > 4) { group(false); if (++gi == SG) round_end(true); }
                  NSA_SCAN_NEXT();
                  group(true);
                  if (++gi == SG) fin = round_end(qmn != 0ull); }
#pragma unroll 1
              while (!fin) { LAS unsigned char* stb = L + L_ST + (rd & 1) * STBUF;
                  for (; gi < SG; ++gi) if (lane < 4) stb[ST_TAGS + 4 * (wave * SG + gi) + lane] = (unsigned char)255;
                  fin = round_end(false); }
          }
          { const int ln = fresh_lane(), q8 = ln >> 3, dg = ln & 7;
#pragma unroll
            for (int hh = 0; hh < 4; ++hh) { const int rw = 32 * wave + 4 * q8 + hh;
                const float lsum = lsp[hh] + ((const LAS float*)(L + L_LSD))[rw]; const float f = lsum > 0.f ? GS[rw] / lsum : 0.f;
                const v4u po = *(const LAS v4u*)(L + L_PO + rw * 128 + 16 * dg); v4u ov;
                ov.x = cvtpk(__uint_as_float(po.x << 16) + osp[hh][0] * f, __uint_as_float(po.x & 0xFFFF0000u) + osp[hh][1] * f); ov.y = cvtpk(__uint_as_float(po.y << 16) + osp[hh][2] * f, __uint_as_float(po.y & 0xFFFF0000u) + osp[hh][3] * f);
                ov.z = cvtpk(__uint_as_float(po.z << 16) + osp[hh][4] * f, __uint_as_float(po.z & 0xFFFF0000u) + osp[hh][5] * f); ov.w = cvtpk(__uint_as_float(po.w << 16) + osp[hh][6] * f, __uint_as_float(po.w & 0xFFFF0000u) + osp[hh][7] * f);
                *(v4u*)(O + ((long)b * SEQ + t0 + 8 * wave + q8) * 1024 + (g * 4 + hh) * 64 + 8 * dg) = ov; } } }
        TSE(4);
        if (tid == 0) UCUR[0] = unext;
        __syncthreads();
    }
    if (TSEC) { const unsigned long long tb_ = __builtin_amdgcn_s_memrealtime(); while (__builtin_amdgcn_s_memrealtime() - tb_ < tacc_) __builtin_amdgcn_s_sleep(4); }
}


#ifndef MK_PER_PHASE
#define MK_PER_PHASE 0
#endif
constexpr int N_PHASES = 14;
struct Args { const float* in[20]; float* out; unsigned char* ws; int ph_lo, ph_hi, li, pad; };
__global__ void __launch_bounds__(NWAVES * 64, 2) nsa_fwd(Args args) {
    extern __shared__ __attribute__((aligned(16))) unsigned char lds[];
    Frame F;
    F.lds = (LAS unsigned char*)lds;
    F.MISC = (volatile LAS unsigned*)(F.lds + MISC_OFF);
    F.tid = threadIdx.x; F.lane = F.tid & 63; F.wave = __builtin_amdgcn_readfirstlane(F.tid >> 6);
    F.G = gridDim.x; { const int bx = blockIdx.x; F.vcu = (F.G % 8 == 0) ? (bx % 8) * (F.G / 8) + bx / 8 : bx; }
    unsigned char* ws = args.ws; F.ws = ws; F.out = args.out;
    F.ctl = (gu32*)(ws + WS_CTL);
    F.in = args.in;
    for (int u = F.tid; u < (LDS_BYTES - LDSCTL_OFF) / 4; u += NWAVES * 64) ((LAS unsigned*)(F.lds + LDSCTL_OFF))[u] = 0u;
    __syncthreads();
    XcdBarrier bar; bar.bar = (unsigned*)(F.ctl + CW_BAR); bar.x = 0; bar.st = nullptr; bar.G = 0;
    if (!MK_PER_PHASE) bar = xcd_barrier_post((unsigned*)(F.ctl + CW_BAR), F.MISC + 8, F.tid == 0, gridDim.x);
    const bool use_gbar = !MK_PER_PHASE && F.G == 256;
    XcdBarrier gbar = bar;
    if (use_gbar) gbar = xcd_barrier_post((unsigned*)(F.ctl + CW_BAR) + XCD_BAR_WORDS * (1 + ((int)blockIdx.x & 7)), F.MISC + 10, F.tid == 0, gridDim.x / 8);
#define GROUP_BAR() do { if (use_gbar) xcd_barrier(gbar, F.wave == 0 && fresh_lane() == 0); else GRID_BAR(); } while (0)
#ifdef TBAR
    unsigned long long tbar_acc = 0;
#define GRID_BAR() do { const unsigned long long tq_ = __builtin_amdgcn_s_memrealtime(); xcd_barrier(bar, F.wave == 0 && fresh_lane() == 0); tbar_acc += __builtin_amdgcn_s_memrealtime() - tq_; } while (0)
#else
#define GRID_BAR() do { if (!MK_PER_PHASE) xcd_barrier(bar, F.wave == 0 && fresh_lane() == 0); } while (0)
#endif
    const int lo = args.ph_lo, hi = args.ph_hi;
#ifndef TPH_MASK
#define TPH_MASK 0
#endif
    unsigned long long tph_acc = 0, tph_t0 = 0; int tph_cur = -1; (void)tph_t0; (void)tph_cur;
#define TPH_MARK(k) (TPH_MASK ? (void)((tph_cur >= 0 && ((TPH_MASK >> tph_cur) & 1)) ? (tph_acc += __builtin_amdgcn_s_memrealtime() - tph_t0) : 0ull, tph_cur = (k), tph_t0 = __builtin_amdgcn_s_memrealtime()) : (void)0)
#ifndef TIMB
#define TIMB -1
#endif
    unsigned long long timb_t0 = 0; (void)timb_t0;
#define TIMB_MARK(k) ((TIMB >= 0 && (k) == TIMB) ? (void)(timb_t0 = __builtin_amdgcn_s_memrealtime()) : (void)0)
#define IN(k) (lo <= (k) && (k) < hi && (TPH_MARK(k), TIMB_MARK(k), F.lane = fresh_lane(), F.tid = F.wave * 64 + F.lane, true))
#define BOTH(k) ((TIMB >= 0 && (k) == TIMB) ? (void)((__syncthreads(), F.wave == 0 && fresh_lane() == 0) ? (atomicMax((unsigned*)(ws + WS_CTL) + 24, ~(unsigned)(__builtin_amdgcn_s_memrealtime() - timb_t0)), atomicMax((unsigned*)(ws + WS_CTL) + 25, (unsigned)(__builtin_amdgcn_s_memrealtime() - timb_t0)), 0) : 0) : (void)0, IN(k) && IN((k) + 1))
    bf16* XB = (bf16*)(ws + WS_XB); float* SS = (float*)(ws + WS_SS);
    const int bx = (int)blockIdx.x;

    if (IN(0)) { p0_prologue(F); if (BOTH(0)) GRID_BAR(); }
    if (IN(1)) {
        pg8::Gemm g{XB, (const bf16*)(ws + WS_WIN), T, 3072, DM, 0}; pg8::StaticOrder S; S.init(T, 3072, F.G, bx);
        pg8::EpiWin E{(bf16*)(ws + WS_BG), (bf16*)(ws + WS_V), SS};
        pg8::gemm_phase<pg8::EpiWin, pg8::StaticOrder, true, true>(F.lds + RING_OFF, g, S, E, F.wave);
#ifdef DUP1
        GRID_BAR(); pg8::gemm_phase<pg8::EpiWin, pg8::StaticOrder, true, true>(F.lds + RING_OFF, g, S, E, F.wave);
#endif
        if (BOTH(1)) GRID_BAR(); }
    if (IN(2)) { conv_gate_phase(F); if (BOTH(2)) GROUP_BAR(); }
    if (IN(3)) {
        pg8::Gemm g{(const bf16*)(ws + WS_BG), (const bf16*)(ws + WS_WOUT), T, DM, DM, 0}; pg8::StaticOrder S; S.init(T, DM, F.G, bx);
        pg8::EpiRes E{XB, SS + T};
        pg8::gemm_phase<pg8::EpiRes, pg8::StaticOrder, true, true>(F.lds + RING_OFF, g, S, E, F.wave);
        if (BOTH(3)) GRID_BAR(); }
    if (IN(4)) {
        pg8::Gemm g{XB, (const bf16*)(ws + WS_W1), T, FF, DM, 0}; pg8::StaticOrder S; S.init(T, FF, F.G, bx);
        pg8::EpiRelu2 E{(bf16*)(ws + WS_H), FF, SS + T};
        pg8::gemm_phase<pg8::EpiRelu2, pg8::StaticOrder, true, true>(F.lds + RING_OFF, g, S, E, F.wave);
#ifdef DUP4
        GRID_BAR(); pg8::gemm_phase<pg8::EpiRelu2, pg8::StaticOrder, true, true>(F.lds + RING_OFF, g, S, E, F.wave);
#endif
        if (BOTH(4)) GROUP_BAR(); }
    if (IN(5)) {
        pg8::Gemm g{(const bf16*)(ws + WS_H), (const bf16*)(ws + WS_W2), T, DM, FF, 0}; pg8::StaticOrder S; S.init(T, DM, F.G, bx);
        pg8::EpiRes E{XB, SS + 2 * T};
        pg8::gemm_phase<pg8::EpiRes, pg8::StaticOrder, true, true>(F.lds + RING_OFF, g, S, E, F.wave);
        if (BOTH(5)) GRID_BAR(); }
    if (IN(6)) {
        pg8::Gemm g{XB, (const bf16*)(ws + WS_WKVQ), T, NKVQ, DM, 0}; pg8::StaticOrder S; S.init(T, NKVQ, F.G, bx);
        pg8::EpiKvq E{(bf16*)(ws + WS_KVQ), KVQ_TSTRIDE, SS + 2 * T};
        pg8::gemm_phase<pg8::EpiKvq, pg8::StaticOrder, true, true>(F.lds + RING_OFF, g, S, E, F.wave);
        if (BOTH(6)) GRID_BAR(); }
    if (IN(7)) {
        const int c = F.vcu, side = (c >> 5) & 1;
        pg8::Gemm g{(const bf16*)(ws + WS_KVQ) + (size_t)side * KVQ_TSTRIDE, (const bf16*)(ws + WS_PW1 + (size_t)side * MiB), PHI_ROWS, 256, 2048, 1}; pg8::PhiOrder S{c};
        pg8::EpiPhi E{(bf16*)(ws + WS_PHIH) + (size_t)side * PHI_ROWS * 256, (const float*)(ws + WS_PHIB) + side * 256};
        pg8::gemm_phase<pg8::EpiPhi, pg8::PhiOrder, false, true>(F.lds + RING_OFF, g, S, E, F.wave);
        if (BOTH(7)) GRID_BAR(); }
    if (IN(8)) { phi2_phase(F, F.vcu * NWAVES + F.wave, F.G * NWAVES, 2 * (PHI_ROWS / 8)); __syncthreads(); vsel_transpose_phase(F, F.vcu * NWAVES + F.wave, F.G * NWAVES); if (BOTH(8)) GRID_BAR(); }
#ifdef TMIN9
    unsigned long long t9_ = 0;
    if (IN(9)) { t9_ = __builtin_amdgcn_s_memrealtime(); }
#endif
    if (IN(9)) { if (F.G == 256) attn_dense_phase(F); else attn_naive_phase(F, (bf16*)(ws + WS_O));
#ifdef TMIN9
        __syncthreads(); if (F.tid == 0) { const unsigned dt = (unsigned)(__builtin_amdgcn_s_memrealtime() - t9_); atomicMax((unsigned*)(ws + WS_CTL) + 20, ~dt); atomicMax((unsigned*)(ws + WS_CTL) + 21, dt); }
#endif
        if (BOTH(9)) GRID_BAR(); }
    if (IN(10)) {
        pg8::Gemm g{(const bf16*)(ws + WS_O), (const bf16*)(ws + WS_WO), T, DM, DM, 0}; pg8::StaticOrder S; S.init(T, DM, F.G, bx);
        pg8::EpiRes E{XB, SS + 3 * T};
        pg8::gemm_phase<pg8::EpiRes, pg8::StaticOrder, true, true>(F.lds + RING_OFF, g, S, E, F.wave);
        if (BOTH(10)) GROUP_BAR(); }
    if (IN(11)) {
        pg8::Gemm g{XB, (const bf16*)(ws + WS_W1 + 8 * MiB), T, FF, DM, 0}; pg8::StaticOrder S; S.init(T, FF, F.G, bx);
        pg8::EpiRelu2 E{(bf16*)(ws + WS_H), FF, SS + 3 * T};
        pg8::gemm_phase<pg8::EpiRelu2, pg8::StaticOrder, true, true>(F.lds + RING_OFF, g, S, E, F.wave);
        if (BOTH(11)) GROUP_BAR(); }
    if (IN(12)) {
        pg8::Gemm g{(const bf16*)(ws + WS_H), (const bf16*)(ws + WS_W2 + 8 * MiB), T, DM, FF, 0}; pg8::StaticOrder S; S.init(T, DM, F.G, bx);
        pg8::EpiRes E{XB, SS + 4 * T};
        pg8::gemm_phase<pg8::EpiRes, pg8::StaticOrder, true, true>(F.lds + RING_OFF, g, S, E, F.wave);
        if (BOTH(12)) GROUP_BAR(); }
    if (IN(13)) { final_norm_phase(F);
    }
    if (TIMB >= 0) { const unsigned mn = ~((const unsigned*)(ws + WS_CTL))[24], mx = ((const unsigned*)(ws + WS_CTL))[25]; const unsigned long long tb_ = __builtin_amdgcn_s_memrealtime(); while (__builtin_amdgcn_s_memrealtime() - tb_ < (unsigned long long)(mx - mn)) __builtin_amdgcn_s_sleep(4); }
#ifdef TMIN9
    { const unsigned mn = ~((const unsigned*)(ws + WS_CTL))[20]; const unsigned long long tb_ = __builtin_amdgcn_s_memrealtime(); while (__builtin_amdgcn_s_memrealtime() - tb_ < (unsigned long long)mn) __builtin_amdgcn_s_sleep(4); }
#endif
#ifdef TBAR
    { const unsigned long long tb_ = __builtin_amdgcn_s_memrealtime(); while (__builtin_amdgcn_s_memrealtime() - tb_ < tbar_acc) __builtin_amdgcn_s_sleep(4); }
#endif
    if (TPH_MASK) { TPH_MARK(14); const unsigned long long tb_ = __builtin_amdgcn_s_memrealtime(); while (__builtin_amdgcn_s_memrealtime() - tb_ < tph_acc) __builtin_amdgcn_s_sleep(4); }
#undef IN
#undef BOTH
}

extern "C" void kernel_launch(void* const* d_in, const int* in_sizes, int n_in, void* d_out, int out_size, void* d_ws, size_t ws_size, hipStream_t stream) {
    static int grid = 0;
    if (grid == 0) {
        if (n_in != 20 || in_sizes[0] != T * DM || out_size != T * DM || ws_size < WS_END) { fprintf(stderr, "kernel_launch: unexpected shapes (n_in %d, in0 %d, out %d, ws %zu)\n", n_in, n_in > 0 ? in_sizes[0] : -1, out_size, ws_size); grid = -1; return; }
        int dev = 0, cus = 0, per_cu = 0;
        if (hipGetDevice(&dev) != hipSuccess || hipDeviceGetAttribute(&cus, hipDeviceAttributeMultiprocessorCount, dev) != hipSuccess) { grid = -1; return; }
        if (hipFuncSetAttribute((const void*)nsa_fwd, hipFuncAttributeMaxDynamicSharedMemorySize, LDS_BYTES) != hipSuccess) { fprintf(stderr, "kernel_launch: hipFuncSetAttribute failed\n"); grid = -1; return; }
        if (hipOccupancyMaxActiveBlocksPerMultiprocessor(&per_cu, (const void*)nsa_fwd, NWAVES * 64, LDS_BYTES) != hipSuccess || per_cu < 1) fprintf(stderr, "kernel_launch: occupancy query reports %d\n", per_cu);
        (void)hipGetLastError();
        grid = cus;
        if (grid != 256) fprintf(stderr, "kernel_launch: %d CUs (built for 256)\n", grid);
    }
    if (grid < 0) return;
    if (hipMemsetAsync((char*)d_ws + WS_CTL, 0, CTL_ZERO_BYTES, stream) != hipSuccess) return;
    Args a{};
    for (int i = 0; i < 20; ++i) a.in[i] = (const float*)d_in[i];
    a.out = (float*)d_out; a.ws = (unsigned char*)d_ws;
#if MK_PER_PHASE
    for (int p = 0; p < N_PHASES; ++p) { a.ph_lo = p; a.ph_hi = p + 1; a.li = p; hipLaunchKernelGGL(nsa_fwd, dim3(grid), dim3(NWAVES * 64), LDS_BYTES, stream, a); }
#else
    a.ph_lo = 0; a.ph_hi = N_PHASES; a.li = 0;
    hipLaunchKernelGGL(nsa_fwd, dim3(grid), dim3(NWAVES * 64), LDS_BYTES, stream, a);
#endif
}
```

```cpp
#include <hip/hip_runtime.h>
#include <cstdio>
#include <cstdint>
__device__ __forceinline__ int fresh_lane() { int l; asm volatile("v_mbcnt_lo_u32_b32 %0, -1, 0\n\tv_mbcnt_hi_u32_b32 %0, -1, %0" : "=v"(l)); return l; }
namespace pg8 {
#define PG8_LAS __attribute__((address_space(3)))
typedef unsigned short bf16_t;
typedef short bf16x8 __attribute__((ext_vector_type(8)));
typedef float f32x4 __attribute__((ext_vector_type(4)));
typedef unsigned u32x4 __attribute__((ext_vector_type(4)));
constexpr int BM = 256, BK = 64, HALF = 128, HTB = HALF * BK * 2  , STAGE_BYTES = 8 * HTB, NXCD = 8, WGM = 8;

__host__ __device__ __forceinline__ int lds_byte(int r, int c) { const int st = (r >> 4) * 2 + (c >> 5), rr = r & 15, cc = c & 31, ob = rr * 64 + cc * 2; return st * 1024 + (ob ^ (((ob >> 9) & 1) << 5)); }
__host__ __device__ __forceinline__ void stage_rc(int b, int& R, int& C) { const int st = b / 1024, sb = b % 1024, swz = sb ^ (((sb >> 9) & 1) << 5); R = (st >> 1) * 16 + swz / 64; C = (st & 1) * 32 + (swz % 64) / 2; }
__host__ __device__ __forceinline__ int perm32(int rho) { const int n = rho >> 4, i = rho & 15; return 8 * (i >> 2) + 4 * n + (i & 3); }

struct Unit { int pm, pn; };
struct Gemm { const bf16_t* A; const bf16_t* Bt; int M, N, K; int a_gather; };

struct StaticOrder {
    int nM, nN, nwg, G, c;
    __host__ __device__ void init(int M, int N, int G_, int c_) { nM = M / BM; nN = N / BM; nwg = nM * nN; G = G_; c = c_; }
    __host__ __device__ bool next(int i, Unit& u) const {
        const long L = (long)i * G + c; if (L >= nwg) return false;
        int wgid = (int)L; { const int q = nwg / NXCD, r = nwg % NXCD, xcd = wgid % NXCD, off = wgid / NXCD; wgid = (xcd < r ? xcd * (q + 1) : r * (q + 1) + (xcd - r) * q) + off; }
        const int nig = WGM * nN, gid = wgid / nig, fm = gid * WGM, gsz = (nM - fm) < WGM ? (nM - fm) : WGM;
        u.pm = fm + ((wgid % nig) % gsz); u.pn = (wgid % nig) / gsz; return true;
    }
    __device__ __forceinline__ void a_ready(const Unit&) const {}
    __device__ __forceinline__ void done(const Unit&) const {}
};

__device__ __forceinline__ unsigned cvt_pk_bf16(float lo, float hi) { unsigned r; asm volatile("v_cvt_pk_bf16_f32 %0, %1, %2" : "=v"(r) : "v"(lo), "v"(hi)); return r; }
typedef float f32x2 __attribute__((ext_vector_type(2)));
typedef unsigned u32x2 __attribute__((ext_vector_type(2)));
constexpr float RMS_EPS = 1e-6f;
__device__ __forceinline__ float row_rstd(const float* ss, int r) { return __builtin_amdgcn_rsqf(ss[r] * (1.0f / 1024.0f) + RMS_EPS); }

struct EpiRes {
    static constexpr bool PERM = true, AFTER_DRAIN = false;
    bf16_t* xb; float* ss;
    __device__ __forceinline__ void operator()(const f32x4 (&acc)[2][2][4][2], const Unit& u, int wr, int wc, int fr, int fq) const {
        const int col0 = u.pn * BM + wc * 32 + 8 * fq;
#pragma unroll
        for (int ai = 0; ai < 2; ++ai)
#pragma unroll
            for (int m = 0; m < 4; ++m) { const int r = u.pm * BM + ai * HALF + wr * 64 + m * 16 + fr; bf16_t* rowp = xb + (size_t)r * 1024 + col0; float s = 0.f;
#pragma unroll
                for (int bj = 0; bj < 2; ++bj) { const u32x4 b = *(const u32x4*)(rowp + bj * HALF); const f32x4 a0 = acc[ai][bj][m][0], a1 = acc[ai][bj][m][1];
                    const unsigned w0 = cvt_pk_bf16(__uint_as_float(b.x << 16) + a0[0], __uint_as_float(b.x & 0xffff0000u) + a0[1]), w1 = cvt_pk_bf16(__uint_as_float(b.y << 16) + a0[2], __uint_as_float(b.y & 0xffff0000u) + a0[3]);
                    const unsigned w2 = cvt_pk_bf16(__uint_as_float(b.z << 16) + a1[0], __uint_as_float(b.z & 0xffff0000u) + a1[1]), w3 = cvt_pk_bf16(__uint_as_float(b.w << 16) + a1[2], __uint_as_float(b.w & 0xffff0000u) + a1[3]);
                    u32x4 w; w.x = w0; w.y = w1; w.z = w2; w.w = w3; *(u32x4*)(rowp + bj * HALF) = w;
                    const float e0 = __uint_as_float(w0 << 16), e1 = __uint_as_float(w0 & 0xffff0000u), e2 = __uint_as_float(w1 << 16), e3 = __uint_as_float(w1 & 0xffff0000u);
                    const float e4 = __uint_as_float(w2 << 16), e5 = __uint_as_float(w2 & 0xffff0000u), e6 = __uint_as_float(w3 << 16), e7 = __uint_as_float(w3 & 0xffff0000u);
                    s += ((e0 * e0 + e1 * e1) + (e2 * e2 + e3 * e3)) + ((e4 * e4 + e5 * e5) + (e6 * e6 + e7 * e7)); }
                s += __shfl_xor(s, 16); s += __shfl_xor(s, 32);
                if (fq == 0) atomicAdd(ss + r, s); }
    }
};
struct EpiRelu2 {
    static constexpr bool PERM = true, AFTER_DRAIN = false;
    bf16_t* O; int ldc; const float* ss;
    __device__ __forceinline__ void operator()(const f32x4 (&acc)[2][2][4][2], const Unit& u, int wr, int wc, int fr, int fq) const {
        const int col0 = u.pn * BM + wc * 32 + 8 * fq;
#pragma unroll
        for (int ai = 0; ai < 2; ++ai)
#pragma unroll
            for (int m = 0; m < 4; ++m) { const int r = u.pm * BM + ai * HALF + wr * 64 + m * 16 + fr; const float rs = row_rstd(ss, r), s2 = rs * rs; bf16_t* rowp = O + (size_t)r * ldc + col0;
#pragma unroll
                for (int bj = 0; bj < 2; ++bj) { f32x4 v0 = acc[ai][bj][m][0], v1 = acc[ai][bj][m][1];
#pragma unroll
                    for (int j = 0; j < 4; ++j) { const float a = fmaxf(v0[j], 0.f), b = fmaxf(v1[j], 0.f); v0[j] = a * a * s2; v1[j] = b * b * s2; }
                    u32x4 w; w.x = cvt_pk_bf16(v0[0], v0[1]); w.y = cvt_pk_bf16(v0[2], v0[3]); w.z = cvt_pk_bf16(v1[0], v1[1]); w.w = cvt_pk_bf16(v1[2], v1[3]);
                    *(u32x4*)(rowp + bj * HALF) = w; } }
    }
};
struct EpiWin {
    static constexpr bool PERM = true, AFTER_DRAIN = false;
    bf16_t* BG; bf16_t* V; const float* ss;
    __device__ __forceinline__ void operator()(const f32x4 (&acc)[2][2][4][2], const Unit& u, int wr, int wc, int fr, int fq) const {
#pragma unroll
        for (int ai = 0; ai < 2; ++ai)
#pragma unroll
            for (int m = 0; m < 4; ++m) { const int r = u.pm * BM + ai * HALF + wr * 64 + m * 16 + fr; const float rs = row_rstd(ss, r);
                if (u.pn < 4) { bf16_t* rowp = BG + (size_t)r * 1024 + u.pn * BM + wc * 32 + 8 * fq;
#pragma unroll
                    for (int bj = 0; bj < 2; ++bj) { const f32x4 v0 = acc[ai][bj][m][0] * rs, v1 = acc[ai][bj][m][1] * rs;
                        u32x4 w; w.x = cvt_pk_bf16(v0[0], v0[1]); w.y = cvt_pk_bf16(v0[2], v0[3]); w.z = cvt_pk_bf16(v1[0], v1[1]); w.w = cvt_pk_bf16(v1[2], v1[3]);
                        *(u32x4*)(rowp + bj * HALF) = w; }
                } else { bf16_t* rowp = V + (size_t)r * 1024 + (u.pn - 4) * HALF + wc * 32 + 8 * fq; const float s2 = rs * rs;
                    const f32x4 v0 = acc[ai][0][m][0] * acc[ai][1][m][0] * s2, v1 = acc[ai][0][m][1] * acc[ai][1][m][1] * s2;
                    u32x4 w; w.x = cvt_pk_bf16(v0[0], v0[1]); w.y = cvt_pk_bf16(v0[2], v0[3]); w.z = cvt_pk_bf16(v1[0], v1[1]); w.w = cvt_pk_bf16(v1[2], v1[3]);
                    *(u32x4*)rowp = w; } }
    }
};
struct EpiKvq {
    static constexpr bool PERM = true, AFTER_DRAIN = false;
    bf16_t* O; size_t tstride; const float* ss;
    __device__ __forceinline__ void operator()(const f32x4 (&acc)[2][2][4][2], const Unit& u, int wr, int wc, int fr, int fq) const {
        bf16_t* base = O + (size_t)u.pn * tstride + wc * 32 + 8 * fq; const bool sig = (u.pn == 10);
#pragma unroll
        for (int ai = 0; ai < 2; ++ai)
#pragma unroll
            for (int m = 0; m < 4; ++m) { const int r = u.pm * BM + ai * HALF + wr * 64 + m * 16 + fr; const float rs = row_rstd(ss, r); bf16_t* rowp = base + (size_t)r * 256;
#pragma unroll
                for (int bj = 0; bj < 2; ++bj) { f32x4 v0 = acc[ai][bj][m][0] * rs, v1 = acc[ai][bj][m][1] * rs;
                    if (sig) {
#pragma unroll
                        for (int j = 0; j < 4; ++j) { v0[j] = 1.0f / (1.0f + __expf(-v0[j])); v1[j] = 1.0f / (1.0f + __expf(-v1[j])); } }
                    u32x4 w; w.x = cvt_pk_bf16(v0[0], v0[1]); w.y = cvt_pk_bf16(v0[2], v0[3]); w.z = cvt_pk_bf16(v1[0], v1[1]); w.w = cvt_pk_bf16(v1[2], v1[3]);
                    *(u32x4*)(rowp + bj * HALF) = w; } }
    }
};
struct EpiPhi {
    static constexpr bool PERM = true, AFTER_DRAIN = false;
    bf16_t* O; const float* bias;
    __device__ __forceinline__ void operator()(const f32x4 (&acc)[2][2][4][2], const Unit& u, int wr, int wc, int fr, int fq) const {
        const int col0 = wc * 32 + 8 * fq;
        f32x4 bv[2][2];
#pragma unroll
        for (int bj = 0; bj < 2; ++bj)
#pragma unroll
            for (int n = 0; n < 2; ++n) bv[bj][n] = *(const f32x4*)(bias + col0 + bj * HALF + 4 * n);
#pragma unroll
        for (int ai = 0; ai < 2; ++ai)
#pragma unroll
            for (int m = 0; m < 4; ++m) { const int r = u.pm * BM + ai * HALF + wr * 64 + m * 16 + fr; bf16_t* rowp = O + (size_t)r * 256 + col0;
#pragma unroll
                for (int bj = 0; bj < 2; ++bj) { f32x4 v0 = acc[ai][bj][m][0] + bv[bj][0], v1 = acc[ai][bj][m][1] + bv[bj][1];
#pragma unroll
                    for (int j = 0; j < 4; ++j) { v0[j] = v0[j] / (1.0f + __expf(-v0[j])); v1[j] = v1[j] / (1.0f + __expf(-v1[j])); }
                    u32x4 w; w.x = cvt_pk_bf16(v0[0], v0[1]); w.y = cvt_pk_bf16(v0[2], v0[3]); w.z = cvt_pk_bf16(v1[0], v1[1]); w.w = cvt_pk_bf16(v1[2], v1[3]);
                    *(u32x4*)(rowp + bj * HALF) = w; } }
    }
};
struct PhiOrder {
    int c;
    __device__ __forceinline__ bool next(int i, Unit& u) const { if (i > 0 || c >= 64) return false; u.pm = c & 31; u.pn = 0; return true; }
    __device__ __forceinline__ void a_ready(const Unit&) const {}
    __device__ __forceinline__ void done(const Unit&) const {}
};
template <class Epi, class Sched, bool ALIGN_EPI = false, bool SP2 = false>
__device__ __forceinline__ void gemm_phase(PG8_LAS unsigned char* lds, const Gemm g, const Sched& S, const Epi& E, const int wid  ) {
    const int lane = fresh_lane(), tid = wid * 64 + lane, wr = wid >> 2, wc = wid & 3, fr = lane & 15, fq = lane >> 4;
    const int K = g.K, nt = K / BK;
    unsigned voffA[2], voffB[2];
#pragma unroll
    for (int i = 0; i < 2; ++i) { int R, C; stage_rc(tid * 16 + i * 8192, R, C); const int Rb = Epi::PERM ? ((R & ~31) + perm32(R & 31)) : R;
        voffA[i] = g.a_gather ? (unsigned)((R >> 2) * 8192 + (R & 3) * 128 + C * 2) : (unsigned)(R * K + C) * 2u; voffB[i] = (unsigned)(Rb * K + C) * 2u; }
    const size_t kstep = (size_t)(BK * 2);
    const size_t hstep = (size_t)HALF * K * 2;
    const size_t tstep = 2 * hstep;
    const size_t kstepA = g.a_gather ? (size_t)512 : kstep, hstepA = g.a_gather ? (size_t)262144 : hstep, tstepA = g.a_gather ? (size_t)524288 : tstep;
    const unsigned ldsw = (unsigned)wid * 1024u;
    const int aoff = lds_byte(wr * 64 + fr, fq * 8), boff = lds_byte(wc * 32 + fr, fq * 8);
#define PG8_SA(b, h) (((b) * 2 + (h)) * HTB)
#define PG8_SB(b, h) ((4 + (b) * 2 + (h)) * HTB)
#define PG8_STAGE(bufoff, gbase, voff) do { _Pragma("unroll") for (int _i = 0; _i < 2; ++_i) \
        __builtin_amdgcn_global_load_lds((const unsigned*)((const char*)(gbase) + (voff)[_i]), (PG8_LAS unsigned*)(lds + (bufoff) + ldsw + _i * 8192), 16, 0, 0); } while (0)
#define PG8_LDA(dst, b, h) do { _Pragma("unroll") for (int m = 0; m < 4; ++m) _Pragma("unroll") for (int k = 0; k < 2; ++k) dst[m][k] = *(const PG8_LAS bf16x8*)(lds + PG8_SA(b, h) + aoff + m * 2048 + k * 1024); } while (0)
#define PG8_LDB(dst, b, h) do { _Pragma("unroll") for (int n = 0; n < 2; ++n) _Pragma("unroll") for (int k = 0; k < 2; ++k) dst[n][k] = *(const PG8_LAS bf16x8*)(lds + PG8_SB(b, h) + boff + n * 2048 + k * 1024); } while (0)
#define PG8_MMA(ai, bj, At, Bt) do { __builtin_amdgcn_s_setprio(1); _Pragma("unroll") for (int m = 0; m < 4; ++m) _Pragma("unroll") for (int n = 0; n < 2; ++n) _Pragma("unroll") for (int k = 0; k < 2; ++k) \
        acc[ai][bj][m][n] = __builtin_amdgcn_mfma_f32_16x16x32_bf16(Bt[n][k], At[m][k], acc[ai][bj][m][n], 0, 0, 0); __builtin_amdgcn_s_setprio(0); } while (0)
#define PG8_WAIT_V(n) asm volatile("s_waitcnt vmcnt(" #n ")" ::: "memory")
#define PG8_WAIT_L(n) asm volatile("s_waitcnt lgkmcnt(" #n ")" ::: "memory")
#define PG8_BAR __builtin_amdgcn_s_barrier()
#define PG8_SCHED __builtin_amdgcn_sched_barrier(0)
    Unit cur, nxt; int ui = 0;
    if (!S.next(0, cur)) return;
    f32x4 acc[2][2][4][2];
#pragma unroll
    for (int a = 0; a < 2; ++a)
#pragma unroll
        for (int b = 0; b < 2; ++b)
#pragma unroll
            for (int m = 0; m < 4; ++m)
#pragma unroll
                for (int n = 0; n < 2; ++n) acc[a][b][m][n] = (f32x4){0.f, 0.f, 0.f, 0.f};
    bf16x8 At[4][2], B0[2][2], B1[2][2];
    const char* cA = (const char*)g.A + (size_t)cur.pm * tstepA; const char* cB = (const char*)g.Bt + (size_t)cur.pn * tstep;
    S.a_ready(cur);
    if constexpr (SP2) {
        PG8_STAGE(PG8_SB(0, 0), cB, voffB); PG8_STAGE(PG8_SB(0, 1), cB + hstep, voffB); PG8_STAGE(PG8_SA(0, 0), cA, voffA); PG8_STAGE(PG8_SA(0, 1), cA + hstepA, voffA);
        if (wr == 1) PG8_BAR;
        PG8_WAIT_V(2); PG8_BAR;
        PG8_STAGE(PG8_SB(1, 0), cB + kstep, voffB); PG8_STAGE(PG8_SA(1, 0), cA + kstepA, voffA); PG8_STAGE(PG8_SB(1, 1), cB + hstep + kstep, voffB);
        PG8_WAIT_V(6); PG8_BAR;
    } else {
        PG8_STAGE(PG8_SB(0, 0), cB, voffB); PG8_STAGE(PG8_SA(0, 0), cA, voffA); PG8_STAGE(PG8_SB(0, 1), cB + hstep, voffB); PG8_STAGE(PG8_SA(0, 1), cA + hstepA, voffA);
        if (wr == 1) PG8_BAR;
        PG8_WAIT_V(4); PG8_BAR;
        PG8_STAGE(PG8_SB(1, 0), cB + kstep, voffB); PG8_STAGE(PG8_SA(1, 0), cA + kstepA, voffA); PG8_STAGE(PG8_SB(1, 1), cB + hstep + kstep, voffB);
        PG8_WAIT_V(6); PG8_BAR;
    }
    for (;;) {
        const bool has_next = S.next(ui + 1, nxt);
        const char* nA = has_next ? (const char*)g.A + (size_t)nxt.pm * tstepA : cA; const char* nB = has_next ? (const char*)g.Bt + (size_t)nxt.pn * tstep : cB;
        for (int t = 0; t < nt; t += 2) {
            const bool last = (t == nt - 2);
            const char* a1 = cA + (size_t)(t + 1) * kstepA;
            const char* a2 = last ? nA : cA + (size_t)(t + 2) * kstepA; const char* b2 = last ? nB : cB + (size_t)(t + 2) * kstep;
            const char* a3 = a2 + kstepA; const char* b3 = b2 + kstep;
            if (last && has_next) S.a_ready(nxt);
            if constexpr (SP2) {
            PG8_LDB(B0, 0, 0); PG8_LDB(B1, 0, 1); PG8_SCHED; PG8_LDA(At, 0, 0); PG8_STAGE(PG8_SA(1, 1), a1 + hstepA, voffA);
            PG8_WAIT_V(8); PG8_WAIT_L(0); PG8_BAR; PG8_MMA(0, 0, At, B0); PG8_MMA(0, 1, At, B1); PG8_BAR; PG8_SCHED;
            PG8_LDA(At, 0, 1); PG8_STAGE(PG8_SB(0, 0), b2, voffB); PG8_STAGE(PG8_SB(0, 1), b2 + hstep, voffB); PG8_STAGE(PG8_SA(0, 0), a2, voffA);
            PG8_WAIT_V(8); PG8_WAIT_L(0); PG8_BAR; PG8_MMA(1, 0, At, B0); PG8_MMA(1, 1, At, B1); PG8_BAR; PG8_SCHED;
            PG8_LDB(B0, 1, 0); PG8_LDB(B1, 1, 1); PG8_SCHED; PG8_LDA(At, 1, 0); PG8_STAGE(PG8_SA(0, 1), a2 + hstepA, voffA);
            PG8_WAIT_V(8); PG8_WAIT_L(0); PG8_BAR; PG8_MMA(0, 0, At, B0); PG8_MMA(0, 1, At, B1); PG8_BAR; PG8_SCHED;
            PG8_LDA(At, 1, 1); PG8_STAGE(PG8_SB(1, 0), b3, voffB); PG8_STAGE(PG8_SB(1, 1), b3 + hstep, voffB); PG8_STAGE(PG8_SA(1, 0), a3, voffA);
            PG8_WAIT_V(8); PG8_WAIT_L(0); PG8_BAR; PG8_MMA(1, 0, At, B0); PG8_MMA(1, 1, At, B1); PG8_BAR; PG8_SCHED;
            } else {
            PG8_LDB(B0, 0, 0); PG8_SCHED; PG8_LDA(At, 0, 0); PG8_STAGE(PG8_SA(1, 1), a1 + hstepA, voffA);
            PG8_WAIT_L(8); PG8_BAR; PG8_WAIT_L(0); PG8_MMA(0, 0, At, B0); PG8_BAR; PG8_SCHED;
            PG8_LDB(B1, 0, 1); PG8_STAGE(PG8_SB(0, 0), b2, voffB);
            PG8_BAR; PG8_WAIT_L(0); PG8_MMA(0, 1, At, B1); PG8_BAR;
            PG8_LDA(At, 0, 1); PG8_STAGE(PG8_SA(0, 0), a2, voffA);
            PG8_BAR; PG8_WAIT_L(0); PG8_MMA(1, 0, At, B0); PG8_BAR; PG8_SCHED;
            PG8_STAGE(PG8_SB(0, 1), b2 + hstep, voffB);
            PG8_WAIT_V(6); PG8_BAR; PG8_MMA(1, 1, At, B1); PG8_BAR;
            PG8_LDB(B0, 1, 0); PG8_SCHED; PG8_LDA(At, 1, 0); PG8_STAGE(PG8_SA(0, 1), a2 + hstepA, voffA);
            PG8_WAIT_L(8); PG8_BAR; PG8_WAIT_L(0); PG8_MMA(0, 0, At, B0); PG8_BAR; PG8_SCHED;
            PG8_LDB(B1, 1, 1); PG8_STAGE(PG8_SB(1, 0), b3, voffB);
            PG8_BAR; PG8_WAIT_L(0); PG8_MMA(0, 1, At, B1); PG8_BAR;
            PG8_LDA(At, 1, 1); PG8_STAGE(PG8_SA(1, 0), a3, voffA);
            PG8_BAR; PG8_WAIT_L(0); PG8_MMA(1, 0, At, B0); PG8_BAR; PG8_SCHED;
            PG8_STAGE(PG8_SB(1, 1), b3 + hstep, voffB);
            PG8_WAIT_V(6); PG8_BAR; PG8_MMA(1, 1, At, B1); PG8_BAR;
            }
        }
        if constexpr (ALIGN_EPI) { if (wr == 0) PG8_BAR; }
        if constexpr (!Epi::AFTER_DRAIN) { E(acc, cur, wr, wc, fr, fq); S.done(cur); }
        if (!has_next) break;
#pragma unroll
        for (int a = 0; a < 2; ++a)
#pragma unroll
            for (int b = 0; b < 2; ++b)
#pragma unroll
                for (int m = 0; m < 4; ++m)
#pragma unroll
                    for (int n = 0; n < 2; ++n) acc[a][b][m][n] = (f32x4){0.f, 0.f, 0.f, 0.f};
        cur = nxt; cA = nA; cB = nB; ++ui;
        if constexpr (ALIGN_EPI) { if (wr == 1) PG8_BAR; }
    }
    PG8_WAIT_V(0);
    if constexpr (!ALIGN_EPI) { if (wr == 0) PG8_BAR; }
    PG8_BAR;
    if constexpr (Epi::AFTER_DRAIN) { E.fused(acc, cur, wr, wc, fr, fq, lds, wid, lane); S.done(cur); }
#undef PG8_SA
#undef PG8_SB
#undef PG8_STAGE
#undef PG8_LDA
#undef PG8_LDB
#undef PG8_MMA
#undef PG8_WAIT_V
#undef PG8_WAIT_L
#undef PG8_BAR
#undef PG8_SCHED
}
}

constexpr int NWAVES = 8;
constexpr int BATCH = 4, SEQ = 8192, DM = 1024, T = BATCH * SEQ, FF = 4096, NH = 16, HD = 64, NG = 4;
constexpr int NKVQ = 2816;
constexpr int PHI_ROWS = 8192;
constexpr size_t MiB = 1u << 20;
constexpr size_t WS_CTL = 0, CTL_ZERO_BYTES = 2 * MiB;
constexpr size_t WS_SS = 1 * MiB;
constexpr size_t WS_PHIB = WS_SS + 5 * 128 * 1024;
constexpr size_t WS_WIN = 2 * MiB, WS_WOUT = 8 * MiB, WS_W1 = 10 * MiB  , WS_W2 = 26 * MiB  , WS_WKVQ = 42 * MiB  , WS_WO = 48 * MiB, WS_PW1 = 50 * MiB  ;
constexpr size_t WS_KCMP = 53 * MiB, WS_VCMP = 54 * MiB;
constexpr size_t WS_PHIH = 56 * MiB;
constexpr size_t WS_XB = 64 * MiB;
constexpr size_t WS_H = 128 * MiB;
constexpr size_t WS_BG = 128 * MiB, WS_V = 192 * MiB;
constexpr size_t WS_KVQ = 128 * MiB, KVQ_TSTRIDE = (size_t)T * 256;
constexpr size_t WS_O = 448 * MiB;
constexpr size_t WS_SELM = 384 * MiB;
constexpr size_t WS_VT = 400 * MiB;
constexpr size_t WS_END = 512 * MiB;
static_assert(WS_KVQ + 11 * KVQ_TSTRIDE * 2 <= WS_H + (size_t)T * FF * 2 && WS_H + (size_t)T * FF * 2 <= 384 * MiB && WS_O + (size_t)T * 1024 * 2 <= WS_END, "ws map");
constexpr int CW_BAR = 4096;
constexpr int RING_OFF = 0, RING_BYTES = 131072;
constexpr int LDS_BYTES = 163840;
constexpr int LDSCTL_OFF = LDS_BYTES - 512, MISC_OFF = LDSCTL_OFF + 320;
#define GAS __attribute__((address_space(1)))
#define LAS __attribute__((address_space(3)))
typedef unsigned short bf16;
typedef unsigned v4u __attribute__((ext_vector_type(4)));
typedef float f32x4 __attribute__((ext_vector_type(4)));
typedef short bf16x8 __attribute__((ext_vector_type(8)));
typedef GAS unsigned gu32;
typedef GAS unsigned long long gu64;
#define RLX_AGENT __ATOMIC_RELAXED, __HIP_MEMORY_SCOPE_AGENT
#define LDS_WAIT() asm volatile("s_waitcnt lgkmcnt(0)" ::: "memory")
#define VM_WAIT() asm volatile("s_waitcnt vmcnt(0)" ::: "memory")
__device__ __forceinline__ unsigned long long rt() { return __builtin_amdgcn_s_memrealtime(); }
__device__ __forceinline__ unsigned f2bf(float f) { unsigned u = __builtin_bit_cast(unsigned, f); return (u + 0x7fffu + ((u >> 16) & 1u)) >> 16; }
__device__ __forceinline__ unsigned pk2(float lo, float hi) { return f2bf(lo) | (f2bf(hi) << 16); }

#define XB_TMO      128
#define XB_XCNT(j)  (256  + 64 * (j))
#define XB_XSUB(j)  (1280 + 64 * (j))
#define XB_XGEN(j)  (2304 + 64 * (j))
#define XB_TOP      3328
#define XB_TOPGEN   3392
#define XCD_BAR_WORDS 3456
#define XB_SPIN_CAP (1u << 18)

__device__ __forceinline__ unsigned xb_ld(unsigned* p)              { return __hip_atomic_load(p, __ATOMIC_RELAXED, __HIP_MEMORY_SCOPE_AGENT); }
__device__ __forceinline__ unsigned xb_add(unsigned* p, unsigned v) { return __hip_atomic_fetch_add(p, v, __ATOMIC_RELAXED, __HIP_MEMORY_SCOPE_AGENT); }
__device__ __forceinline__ unsigned xb_xcc_id() { return (unsigned)__builtin_amdgcn_s_getreg((3 << 11) | 20) & 0xFu; }
#define XB_SPIN(cond, bar) do { unsigned _sp = 0; while (cond) { __builtin_amdgcn_s_sleep(1); \
    if ((++_sp & 255u) == 0u) { if (xb_ld(&(bar)[XB_TMO])) break; if (_sp > XB_SPIN_CAP) { atomicAdd(&(bar)[XB_TMO], 1u); break; } } } } while (0)

struct XcdBarrier {
    unsigned* bar; unsigned x; unsigned G;
    volatile LAS unsigned* st;
};

__device__ __forceinline__ XcdBarrier xcd_barrier_post(unsigned* bar, volatile LAS unsigned* st, bool leader  , unsigned G  ) {
    XcdBarrier b; b.bar = bar; b.x = xb_xcc_id(); b.st = st; b.G = G;
    if (leader) (void)xb_add(&bar[XB_XCNT(b.x)], 1u);
    return b;
}
__device__ __forceinline__ void xcd_barrier_complete(unsigned* bar, unsigned x, unsigned& nloc, unsigned& nx, const unsigned G) {
    unsigned sum, cnt, mine, sp = 0u;
    for (;;) {
        sum = 0u; cnt = 0u; mine = 0u;
#pragma unroll
        for (unsigned j = 0; j < 16; ++j) { const unsigned c = xb_ld(&bar[XB_XCNT(j)]); sum += c; cnt += (c > 0u) ? 1u : 0u; mine = (j == x) ? c : mine; }
        if (sum == G) break;
        __builtin_amdgcn_s_sleep(1);
        if ((++sp & 255u) == 0u) { if (xb_ld(&bar[XB_TMO])) break; if (sp > XB_SPIN_CAP) { atomicAdd(&bar[XB_TMO], 1u); break; } }
    }
    nloc = mine > 0u ? mine : 1u; nx = cnt > 0u ? cnt : 1u;
}

__device__ __forceinline__ void xcd_barrier(const XcdBarrier& b, bool leader  ) {
    asm volatile("s_waitcnt vmcnt(0)" ::: "memory");
    __syncthreads();
    if (leader) {
        unsigned* bar = b.bar;
        __builtin_amdgcn_s_waitcnt(0);
        unsigned nloc = b.st[0], nx = b.st[1];
        if (nloc == 0u) { xcd_barrier_complete(bar, b.x, nloc, nx, b.G); b.st[0] = nloc; b.st[1] = nx; }
        const unsigned old = xb_add(&bar[XB_XSUB(b.x)], 1u);
        const unsigned gen = old / nloc;
        if (old + 1u == (gen + 1u) * nloc) {
            __builtin_amdgcn_fence(__ATOMIC_RELEASE, "agent");
            asm volatile("s_waitcnt vmcnt(0)" ::: "memory");
            const unsigned og = xb_add(&bar[XB_TOP], 1u);
            const unsigned tg = og / nx;
            if (og + 1u == (tg + 1u) * nx) xb_add(&bar[XB_TOPGEN], 1u);
            else XB_SPIN(xb_ld(&bar[XB_TOPGEN]) == tg, bar);
            __builtin_amdgcn_fence(__ATOMIC_ACQUIRE, "agent");
            xb_add(&bar[XB_XGEN(b.x)], 1u);
            asm volatile("s_waitcnt vmcnt(0)" ::: "memory");
        } else {
            XB_SPIN(xb_ld(&bar[XB_XGEN(b.x)]) == gen, bar);
            __builtin_amdgcn_fence(__ATOMIC_ACQUIRE, "agent");
            asm volatile("s_waitcnt vmcnt(0)" ::: "memory");
        }
    }
    __syncthreads();
}

struct Frame {
    LAS unsigned char* lds;
    volatile LAS unsigned* MISC;
    gu32* ctl;
    int tid, lane, wave;
    int vcu, G;
    const float* const* in;
    float* out; unsigned char* ws;
};
__device__ __forceinline__ float wave_sum(float v) {
#pragma unroll
    for (int o = 1; o < 64; o <<= 1) v += __shfl_xor(v, o);
    return v;
}
__device__ __forceinline__ float wave_max(float v) {
#pragma unroll
    for (int o = 1; o < 64; o <<= 1) v = fmaxf(v, __shfl_xor(v, o));
    return v;
}
__device__ __forceinline__ float bf2f(unsigned short b) { return __uint_as_float(((unsigned)b) << 16); }
__device__ __forceinline__ float bflo(unsigned w) { return __uint_as_float(w << 16); }
__device__ __forceinline__ float bfhi(unsigned w) { return __uint_as_float(w & 0xffff0000u); }

__device__ __forceinline__ void p0_transpose_item(const float* W, int ldw, int nvalid, const float* gain, float scale, bf16* WT, int K, int drow, int k0, int n0, LAS float* scr, int lane) {
    float wv[32];
#pragma unroll
    for (int i = 0; i < 32; ++i) { const int kk = 2 * i + (lane >> 5), n = n0 + (lane & 31); wv[i] = (n < nvalid) ? W[(size_t)(k0 + kk) * ldw + n] : 0.f; }
#pragma unroll
    for (int i = 0; i < 32; ++i) { const int kk = 2 * i + (lane >> 5); float v = wv[i]; if (gain) v *= gain[k0 + kk]; scr[kk * 33 + (lane & 31)] = v * scale; }
    LDS_WAIT(); asm volatile("" ::: "memory");
    const int c = lane & 7;
#pragma unroll
    for (int j = 0; j < 4; ++j) { const int n = (lane >> 3) + 8 * j; const LAS float* s = scr + (8 * c) * 33 + n;
        v4u o; o.x = pk2(s[0 * 33], s[1 * 33]); o.y = pk2(s[2 * 33], s[3 * 33]); o.z = pk2(s[4 * 33], s[5 * 33]); o.w = pk2(s[6 * 33], s[7 * 33]);
        *(GAS v4u*)(WT + (size_t)(drow + n) * K + k0 + 8 * c) = o; }
    LDS_WAIT(); asm volatile("" ::: "memory");
}
struct MatSpec { const float* W; int K, ldw, nvalid, niter; const float* gain; bf16* WT; int kind; };
__device__ __forceinline__ void p0_matrix_item(const MatSpec& m, int item, LAS float* scr, int lane) {
    const int nblk = m.niter / 32, kb = item / nblk, nb = item % nblk, k0 = 64 * kb, n0 = 32 * nb;
    int drow = n0; float scale = 1.f;
    if (m.kind == 1) { if (n0 >= 1024) { const int isu = n0 >= 2048, j = n0 - (isu ? 2048 : 1024); drow = 1024 + (j >> 7) * 256 + isu * 128 + (j & 127); } }
    else if (m.kind == 2) { if (n0 < 1024) { drow = 1536 + n0; scale = 0.125f; } else drow = 2560 + (n0 - 1024); }
    p0_transpose_item(m.W, m.ldw, m.nvalid, m.gain, scale, m.WT, m.K, drow, k0, n0, scr, lane);
}
__device__ __forceinline__ void p0_prologue(Frame& F) {
    LAS float* scr = (LAS float*)(F.lds + RING_OFF + F.wave * 16384);
    const int gw = F.vcu * NWAVES + F.wave, NGW = F.G * NWAVES;
    unsigned char* ws = F.ws;
    int it = gw;
#define DO_MAT(...) do { const MatSpec m_ = MatSpec{__VA_ARGS__}; const int n_ = (m_.K / 64) * (m_.niter / 32); _Pragma("unroll 1") for (; it < n_; it += NGW) p0_matrix_item(m_, it, scr, F.lane); it -= n_; } while (0)
    DO_MAT(F.in[6],  1024, 3072, 3072, 3072, F.in[2],           (bf16*)(ws + WS_WIN), 1);
    DO_MAT(F.in[8],  1024, 1024, 1024, 1024, nullptr,           (bf16*)(ws + WS_WOUT), 0);
    DO_MAT(F.in[4],  1024, 4096, 4096, 4096, F.in[3],           (bf16*)(ws + WS_W1), 0);
    DO_MAT(F.in[4] + (size_t)1024 * 4096, 1024, 4096, 4096, 4096, F.in[3] + 1024, (bf16*)(ws + WS_W1 + 8 * MiB), 0);
    DO_MAT(F.in[5],  4096, 1024, 1024, 1024, nullptr,           (bf16*)(ws + WS_W2), 0);
    DO_MAT(F.in[5] + (size_t)4096 * 1024, 4096, 1024, 1024, 1024, nullptr, (bf16*)(ws + WS_W2 + 8 * MiB), 0);
    DO_MAT(F.in[10], 1024, 1536, 1536, 1536, F.in[9],           (bf16*)(ws + WS_WKVQ), 0);
    DO_MAT(F.in[17], 1024, 1072, 1072, 1280, F.in[2] + 1024,    (bf16*)(ws + WS_WKVQ), 2);
    DO_MAT(F.in[18], 1024, 1024, 1024, 1024, nullptr,           (bf16*)(ws + WS_WO), 0);
    DO_MAT(F.in[13], 2048, 256, 256, 256, nullptr,              (bf16*)(ws + WS_PW1), 0);
    DO_MAT(F.in[15], 2048, 256, 256, 256, nullptr,              (bf16*)(ws + WS_PW1 + 1 * MiB), 0);
#undef DO_MAT
    { bf16* XB = (bf16*)(ws + WS_XB); float* ss0 = (float*)(ws + WS_SS);
      for (int m = gw; m < T; m += 2 * NGW) { const int m2 = m + NGW;
          const GAS f32x4* xr = (const GAS f32x4*)(F.in[0] + (size_t)m * DM) + F.lane; const GAS f32x4* xr2 = (const GAS f32x4*)(F.in[0] + (size_t)m2 * DM) + F.lane;
          GAS unsigned long long* o8 = (GAS unsigned long long*)(XB + (size_t)m * DM) + F.lane; GAS unsigned long long* o82 = (GAS unsigned long long*)(XB + (size_t)m2 * DM) + F.lane;
          f32x4 va[4], vb[4];
#pragma unroll
          for (int j = 0; j < 4; ++j) { va[j] = xr[64 * j]; vb[j] = xr2[64 * j]; }
          float s = 0.f, s2 = 0.f;
#pragma unroll
          for (int j = 0; j < 4; ++j) { const f32x4 v = va[j], w = vb[j];
              const unsigned long long pa = (unsigned long long)pk2(v.x, v.y) | ((unsigned long long)pk2(v.z, v.w) << 32), pb = (unsigned long long)pk2(w.x, w.y) | ((unsigned long long)pk2(w.z, w.w) << 32);
              o8[64 * j] = pa; o82[64 * j] = pb;
              const float a0 = bflo((unsigned)pa), a1 = bfhi((unsigned)pa), a2 = bflo((unsigned)(pa >> 32)), a3 = bfhi((unsigned)(pa >> 32)); s += (a0 * a0 + a1 * a1) + (a2 * a2 + a3 * a3);
              const float b0 = bflo((unsigned)pb), b1 = bfhi((unsigned)pb), b2 = bflo((unsigned)(pb >> 32)), b3 = bfhi((unsigned)(pb >> 32)); s2 += (b0 * b0 + b1 * b1) + (b2 * b2 + b3 * b3); }
          s = wave_sum(s); s2 = wave_sum(s2); if (F.lane == 0) { ss0[m] = s; ss0[m2] = s2; } } }
    { float* pb = (float*)(ws + WS_PHIB);
      for (int task = gw; task < 2 * 32 * 4; task += NGW) { const int side = task >> 7, kc = (task >> 2) & 31, cc = task & 3; const float* pe = F.in[side ? 12 : 11]; const float* w1 = F.in[side ? 15 : 13]; float a = 0.f;
          for (int kk = kc * 64; kk < kc * 64 + 64; ++kk) a += pe[kk] * w1[(size_t)kk * 256 + cc * 64 + F.lane];
          atomicAdd(pb + side * 256 + cc * 64 + F.lane, a); } }
}
__device__ __forceinline__ void conv_gate_phase(Frame& F) {
    bf16* BG = (bf16*)(F.ws + WS_BG); const bf16* V = (const bf16*)(F.ws + WS_V); const float* cw = F.in[7];
    const bool grp = (F.G == 256); const int rbase = grp ? (F.vcu >> 5) * 4096 * 128 : 0, nit = grp ? 4096 * 128 : T * 128;
    const int gt = (grp ? (F.vcu & 31) : F.vcu) * (NWAVES * 64) + F.tid, NGT = (grp ? 32 : F.G) * NWAVES * 64;
    const int c0 = (gt & 127) * 8;
    float w0[8], w1[8], w2[8];
#pragma unroll
    for (int j = 0; j < 8; ++j) { w0[j] = cw[c0 + j]; w1[j] = cw[1024 + c0 + j]; w2[j] = cw[2048 + c0 + j]; }
    const v4u z = {0u, 0u, 0u, 0u};
    for (int it = gt; it < nit; it += 2 * NGT) { const int rowa = (rbase + it) >> 7, rowb = (rbase + it + NGT) >> 7, ta = rowa & (SEQ - 1), tb = rowb & (SEQ - 1);
        const v4u a2 = *(const v4u*)(V + (size_t)rowa * 1024 + c0), a1 = ta >= 1 ? *(const v4u*)(V + (size_t)(rowa - 1) * 1024 + c0) : z, a0 = ta >= 2 ? *(const v4u*)(V + (size_t)(rowa - 2) * 1024 + c0) : z, ba = *(const v4u*)(BG + (size_t)rowa * 1024 + c0);
        const v4u b2 = *(const v4u*)(V + (size_t)rowb * 1024 + c0), b1 = tb >= 1 ? *(const v4u*)(V + (size_t)(rowb - 1) * 1024 + c0) : z, b0 = tb >= 2 ? *(const v4u*)(V + (size_t)(rowb - 2) * 1024 + c0) : z, bb = *(const v4u*)(BG + (size_t)rowb * 1024 + c0);
        v4u oa, ob;
#pragma unroll
        for (int j = 0; j < 4; ++j) {
            oa[j] = pk2(bflo(ba[j]) * (w0[2 * j] * bflo(a0[j]) + w1[2 * j] * bflo(a1[j]) + w2[2 * j] * bflo(a2[j])), bfhi(ba[j]) * (w0[2 * j + 1] * bfhi(a0[j]) + w1[2 * j + 1] * bfhi(a1[j]) + w2[2 * j + 1] * bfhi(a2[j])));
            ob[j] = pk2(bflo(bb[j]) * (w0[2 * j] * bflo(b0[j]) + w1[2 * j] * bflo(b1[j]) + w2[2 * j] * bflo(b2[j])), bfhi(bb[j]) * (w0[2 * j + 1] * bfhi(b0[j]) + w1[2 * j + 1] * bfhi(b1[j]) + w2[2 * j + 1] * bfhi(b2[j]))); }
        *(v4u*)(BG + (size_t)rowa * 1024 + c0) = oa; *(v4u*)(BG + (size_t)rowb * 1024 + c0) = ob; }
}
__device__ __forceinline__ void phi2_phase(Frame& F, int task0, int tstep, int tend) {
    LAS float* hs = (LAS float*)(F.lds + RING_OFF + F.wave * 8192);
    for (int task = task0; task < tend; task += tstep) { const int side = task / (PHI_ROWS / 8), r0 = (task % (PHI_ROWS / 8)) * 8;
        const bf16* H = (const bf16*)(F.ws + WS_PHIH) + (size_t)side * PHI_ROWS * 256 + (size_t)r0 * 256; const float* w2 = F.in[side ? 16 : 14];
#pragma unroll
        for (int j = 0; j < 4; ++j) { const v4u w = *(const v4u*)(H + F.lane * 32 + j * 8);
#pragma unroll
            for (int q = 0; q < 4; ++q) { hs[F.lane * 32 + j * 8 + 2 * q] = bflo(w[q]); hs[F.lane * 32 + j * 8 + 2 * q + 1] = bfhi(w[q]); } }
        LDS_WAIT(); asm volatile("" ::: "memory");
        float acc[8] = {0.f, 0.f, 0.f, 0.f, 0.f, 0.f, 0.f, 0.f};
        for (int c = 0; c < 256; c += 4) { const float wa = w2[(c + 0) * 64 + F.lane], wb = w2[(c + 1) * 64 + F.lane], wc = w2[(c + 2) * 64 + F.lane], wd = w2[(c + 3) * 64 + F.lane];
#pragma unroll
            for (int i = 0; i < 8; ++i) { const f32x4 h = *(const LAS f32x4*)(hs + i * 256 + c); acc[i] += h.x * wa + h.y * wb + h.z * wc + h.w * wd; } }
        bf16* O = (bf16*)(F.ws + (side ? WS_VCMP : WS_KCMP));
#pragma unroll
        for (int i = 0; i < 8; ++i) O[(size_t)(r0 + i) * 64 + F.lane] = (bf16)f2bf(acc[i]);
        LDS_WAIT(); asm volatile("" ::: "memory"); }
}
__device__ __forceinline__ void vsel_transpose_phase(Frame& F, int task0, int tstep) {
    LAS unsigned short* ts = (LAS unsigned short*)(F.lds + RING_OFF + F.wave * 16384);
    const int lane = F.lane;
    const bf16* VSEL = (const bf16*)(F.ws + WS_KVQ) + 3 * KVQ_TSTRIDE; bf16* VT = (bf16*)(F.ws + WS_VT);
    const int key = lane, s = key >> 5, k5 = key & 31, e = ((k5 >> 4) << 2) | (k5 & 3), q4 = (k5 >> 2) & 3, slot = 32 * s + 8 * q4 + e;
    for (int task = task0; task < BATCH * NG * 128; task += tstep) { const int blk = task & 127, g = (task >> 7) & 3, b = task >> 9;
        const v4u* src = (const v4u*)(VSEL + ((size_t)b * SEQ + 64 * blk + key) * 256 + g * 64);
#pragma unroll
        for (int c = 0; c < 8; ++c) { const v4u w = src[c];
#pragma unroll
            for (int q = 0; q < 4; ++q) { ts[(8 * c + 2 * q) * 72 + slot] = (unsigned short)(w[q] & 0xffffu); ts[(8 * c + 2 * q + 1) * 72 + slot] = (unsigned short)(w[q] >> 16); } }
        LDS_WAIT(); asm volatile("" ::: "memory");
        v4u* dst = (v4u*)(VT + (size_t)task * 4096 + lane * 64);
#pragma unroll
        for (int c = 0; c < 8; ++c) dst[c] = *(const LAS v4u*)(ts + lane * 72 + 8 * c);
        LDS_WAIT(); asm volatile("" ::: "memory"); }
}
__device__ __forceinline__ void final_norm_phase(Frame& F) {
    const bool grp = (F.G == 256); const int mbase = grp ? (F.vcu >> 5) * 4096 : 0, mend = grp ? mbase + 4096 : T;
    const int gw = mbase + (grp ? (F.vcu & 31) : F.vcu) * NWAVES + F.wave, NGW = (grp ? 32 : F.G) * NWAVES; const float* ss = (const float*)(F.ws + WS_SS) + 4 * T; const float* gn = F.in[19]; const bf16* XB = (const bf16*)(F.ws + WS_XB);
    f32x4 g4[4];
#pragma unroll
    for (int j = 0; j < 4; ++j) g4[j] = *((const f32x4*)gn + F.lane + 64 * j);
    for (int m = gw; m < mend; m += 2 * NGW) { const int m2 = m + NGW;
        GAS f32x4* xr = (GAS f32x4*)(F.out + (size_t)m * DM) + F.lane; GAS f32x4* xr2 = (GAS f32x4*)(F.out + (size_t)m2 * DM) + F.lane;
        const GAS unsigned long long* xs = (const GAS unsigned long long*)(XB + (size_t)m * DM) + F.lane; const GAS unsigned long long* xs2 = (const GAS unsigned long long*)(XB + (size_t)m2 * DM) + F.lane;
        unsigned long long wa[4], wb[4];
#pragma unroll
        for (int j = 0; j < 4; ++j) { wa[j] = xs[64 * j]; wb[j] = xs2[64 * j]; }
        const float rs = __builtin_amdgcn_rsqf(ss[m] * (1.0f / 1024.0f) + 1e-6f), rs2 = __builtin_amdgcn_rsqf(ss[m2] * (1.0f / 1024.0f) + 1e-6f);
#pragma unroll
        for (int j = 0; j < 4; ++j) { f32x4 v = (f32x4){bflo((unsigned)wa[j]), bfhi((unsigned)wa[j]), bflo((unsigned)(wa[j] >> 32)), bfhi((unsigned)(wa[j] >> 32))}; xr[64 * j] = v * rs * g4[j];
            f32x4 w = (f32x4){bflo((unsigned)wb[j]), bfhi((unsigned)wb[j]), bflo((unsigned)(wb[j] >> 32)), bfhi((unsigned)(wb[j] >> 32))}; xr2[64 * j] = w * rs2 * g4[j]; } }
}

__device__ __forceinline__ int t5_bucket_dev(int d) {
    if (d < 16) return d;
    int b = 16;
    b += (d >= 19); b += (d >= 21); b += (d >= 24); b += (d >= 27); b += (d >= 31); b += (d >= 35); b += (d >= 40); b += (d >= 46);
    b += (d >= 52); b += (d >= 59); b += (d >= 67); b += (d >= 77); b += (d >= 87); b += (d >= 99); b += (d >= 113);
    return b;
}
__device__ __forceinline__ void build_bias_table(Frame& F, LAS float* BT) {
    for (int i = F.tid; i < 128 * 16; i += NWAVES * 64) BT[i] = F.in[1][t5_bucket_dev(i >> 4) * 16 + (i & 15)];
}
__device__ __forceinline__ void attn_naive_phase(Frame& F, bf16* O) {
    LAS float* BT = (LAS float*)(F.lds + RING_OFF);
    LAS float* qs = (LAS float*)(F.lds + RING_OFF + 8192 + F.wave * 4096);
    LAS float* imp = qs + 256;
    LAS int* selb = (LAS int*)(imp + 512);
    LAS float* MC = (LAS float*)(selb + 16);
    LAS float* LG = (LAS float*)(F.lds + RING_OFF + 8192 + 8 * 4096 + F.wave * 8192);
    build_bias_table(F, BT);
    __syncthreads();
    const bf16* KVQ = (const bf16*)(F.ws + WS_KVQ);
    const bf16* GATES = KVQ + 10 * KVQ_TSTRIDE; const bf16* KCMP = (const bf16*)(F.ws + WS_KCMP); const bf16* VCMP = (const bf16*)(F.ws + WS_VCMP);
    const int gw = F.vcu * NWAVES + F.wave, NGW = F.G * NWAVES, lane0 = F.lane;
#pragma unroll 1
    for (int task = gw; task < T * NG; task += NGW) {
        int lane = lane0; asm volatile("" : "+v"(lane));
        const int row = task >> 2, g = task & 3, b = row >> 13, pos = row & (SEQ - 1);
        { const bf16* qp = KVQ + (size_t)(6 + g) * KVQ_TSTRIDE + (size_t)row * 256 + lane * 4; const unsigned long long w = *(const unsigned long long*)qp;
          qs[lane * 4 + 0] = bflo((unsigned)w); qs[lane * 4 + 1] = bfhi((unsigned)w); qs[lane * 4 + 2] = bflo((unsigned)(w >> 32)); qs[lane * 4 + 3] = bfhi((unsigned)(w >> 32)); }
        LDS_WAIT(); asm volatile("" ::: "memory");
        const int nv = pos >= 31 ? ((pos - 31) >> 4) + 1 : 0;
        float oacc[4] = {0.f, 0.f, 0.f, 0.f};
#pragma unroll 1
        for (int br = 0; br < 3; ++br) {
            const bf16* Kt = br == 0 ? KCMP : KVQ + (size_t)(br == 1 ? 2 : 4) * KVQ_TSTRIDE; const bf16* Vt = br == 0 ? VCMP : KVQ + (size_t)(br == 1 ? 3 : 5) * KVQ_TSTRIDE;
            const int nc = br == 0 ? (nv + 63) >> 6 : (br == 1 ? 16 : 8);
            float m[4] = {-1e30f, -1e30f, -1e30f, -1e30f}, Z[4] = {0.f, 0.f, 0.f, 0.f}, o[4] = {0.f, 0.f, 0.f, 0.f};
#pragma unroll 1
            for (int c = 0; c < nc; ++c) { asm volatile("" ::: "memory");
                int ridx, dist; bool valid;
                if (br == 0) { const int n = c * 64 + lane; ridx = b * 512 + n; dist = pos - 16 * n - 31; valid = n < nv; }
                else if (br == 1) { const int bk = selb[c]; const int tok = bk * 64 + lane; ridx = b * SEQ + tok; dist = pos - tok; valid = (bk >= 0) && dist >= 0; }
                else { const int kp = pos - 511 + c * 64 + lane; ridx = b * SEQ + kp; dist = pos - kp; valid = kp >= 0; }
                const unsigned long long vmask = __ballot(valid);
                if (vmask == 0ull) continue;
                float l[4] = {0.f, 0.f, 0.f, 0.f};
                if (valid) { const v4u* kr = (const v4u*)(Kt + (size_t)ridx * 256 + g * 64);
#pragma unroll 2
                    for (int j = 0; j < 8; ++j) { asm volatile("" ::: "memory"); const v4u w = kr[j]; float f[8];
#pragma unroll
                        for (int q = 0; q < 4; ++q) { f[2 * q] = bflo(w[q]); f[2 * q + 1] = bfhi(w[q]); }
#pragma unroll
                        for (int h = 0; h < 4; ++h) { const f32x4 qa = *(const LAS f32x4*)(qs + h * 64 + 8 * j), qb = *(const LAS f32x4*)(qs + h * 64 + 8 * j + 4);
                            l[h] += (f[0] * qa.x + f[1] * qa.y) + (f[2] * qa.z + f[3] * qa.w) + (f[4] * qb.x + f[5] * qb.y) + (f[6] * qb.z + f[7] * qb.w); } }
                    const int dd = dist < 127 ? dist : 127;
#pragma unroll
                    for (int h = 0; h < 4; ++h) l[h] += BT[dd * 16 + g * 4 + h]; }
                float p[4];
#pragma unroll
                for (int h = 0; h < 4; ++h) { const float lv = valid ? l[h] : -1e30f; const float mn = fmaxf(m[h], wave_max(lv)); const float sc = __expf(m[h] - mn);
                    p[h] = valid ? __expf(lv - mn) : 0.f; Z[h] = Z[h] * sc + wave_sum(p[h]); o[h] *= sc; m[h] = mn; }
                if (br == 0) {
#pragma unroll
                    for (int h = 0; h < 4; ++h) { LG[h * 512 + c * 64 + lane] = p[h]; if (lane == 0) MC[c * 4 + h] = m[h]; } }
                unsigned long long vm = vmask;
                while (vm) { const int ll = __builtin_ctzll(vm); vm &= vm - 1ull;
                    const int r = __builtin_amdgcn_readlane(ridx, ll); const float v = bf2f(Vt[(size_t)r * 256 + g * 64 + lane]);
#pragma unroll
                    for (int h = 0; h < 4; ++h) o[h] += __uint_as_float(__builtin_amdgcn_readlane(__float_as_uint(p[h]), ll)) * v; } }
            { const bf16* gp = GATES + (size_t)row * 256 + g * 12 + br;
#pragma unroll
              for (int h = 0; h < 4; ++h) { const float zi = Z[h] > 0.f ? 1.0f / Z[h] : 0.f; Z[h] = zi; oacc[h] += bf2f(gp[h * 3]) * o[h] * zi; } }
            if (br == 0) {
                LDS_WAIT(); asm volatile("" ::: "memory");
#pragma unroll 1
                for (int c = 0; c < 8; ++c) { const int n = c * 64 + lane; float s = 0.f;
                    if (c < nc) {
#pragma unroll
                        for (int h = 0; h < 4; ++h) s += LG[h * 512 + n] * __expf(MC[c * 4 + h] - m[h]) * Z[h]; }
                    imp[n] = s; }
                LDS_WAIT(); asm volatile("" ::: "memory");
                unsigned khi[2], klo[2]; const int cb = pos >> 6;
#pragma unroll
                for (int k = 0; k < 2; ++k) { const int j = lane + 64 * k; float s = 2.0f * (imp[4 * j] + imp[4 * j + 1] + imp[4 * j + 2]) + imp[4 * j + 3]; if (j > 0) s += imp[4 * j - 1];
                    const bool forced = (j == 0) || (j == cb) || (j == cb - 1), future = j > cb; const float sc = forced ? 1e9f : s;
                    khi[k] = future ? 0u : (__float_as_uint(sc) + 1u); klo[k] = 128u - (unsigned)j; }
                LDS_WAIT(); asm volatile("" ::: "memory");
#pragma unroll 1
                for (int i = 0; i < 16; ++i) { unsigned h, l; const bool first = (khi[0] > khi[1]) || (khi[0] == khi[1] && klo[0] > klo[1]); h = first ? khi[0] : khi[1]; l = first ? klo[0] : klo[1];
#pragma unroll
                    for (int off = 1; off < 64; off <<= 1) { const unsigned oh = __shfl_xor(h, off), ol = __shfl_xor(l, off); if (oh > h || (oh == h && ol > l)) { h = oh; l = ol; } }
                    h = __builtin_amdgcn_readfirstlane(h); l = __builtin_amdgcn_readfirstlane(l);
                    if (lane == 0) selb[i] = (h != 0u) ? 128 - (int)l : -1;
#pragma unroll
                    for (int k = 0; k < 2; ++k) if (klo[k] == l) { khi[k] = 0u; klo[k] = 0u; } }
                LDS_WAIT(); asm volatile("" ::: "memory");
            }
        }
#pragma unroll
        for (int h = 0; h < 4; ++h) O[(size_t)row * 1024 + (g * 4 + h) * 64 + lane] = (bf16)f2bf(oacc[h]);
    }
}

namespace nsa {
typedef float f32x16 __attribute__((ext_vector_type(16)));
typedef short s16x4 __attribute__((ext_vector_type(4)));
typedef short v4i16_t __attribute__((ext_vector_type(4)));
constexpr float LOG2E = 1.4426950408889634f, MASKV = -3.0e30f, MINIT = -1.0e30f;
constexpr int KSTR = 144, VSTR = 136, KVBUF = 64 * KSTR + 64 * VSTR;
constexpr int L_KV = 0, L_SC = 35840, L_TB = 72704, L_WSF = L_TB + 8320, L_SELM = L_WSF + 2048, L_NMREF = L_SELM + 1024, L_GS = L_NMREF + 1024, L_FLAG = L_GS + 1024, L_QS = L_FLAG + 128, QS_STR = 144, L_PO = L_QS + 256 * QS_STR, L_G2 = L_PO + 256 * 128, L_LSD = L_G2 + 2048, L_END = L_LSD + 1024;
constexpr int SG = 2, ST_RSTR = 136, ST_LVAL = 256 * ST_RSTR, ST_TAGS = ST_LVAL + 1024, L_ST = 0, STBUF = ST_TAGS + 64;
constexpr int L_ZERO = 2 * STBUF;
static_assert(L_SC + 64 * 128 * 4 <= L_TB && L_ZERO + 4 * ST_RSTR + 16 <= L_TB && L_ZERO % 16 == 0 && (4 * ST_RSTR) % 16 == 0 && L_END <= 163328, "attention LDS map");
constexpr int LSTR = 400;
constexpr int TBN = 130;
__device__ __forceinline__ int crow(int r, int hi) { return (r & 3) + 8 * (r >> 2) + 4 * hi; }
__device__ __forceinline__ float swap_other(float x, int hi) { auto rr = __builtin_amdgcn_permlane32_swap(__float_as_uint(x), __float_as_uint(x), false, false); return hi ? __uint_as_float(rr[0]) : __uint_as_float(rr[1]); }
#define NSA_DPP(x, ctrl) __uint_as_float((unsigned)__builtin_amdgcn_update_dpp(0, (int)__float_as_uint(x), ctrl, 0xF, 0xF, true))
#define NSA_DPPU(x, ctrl) ((unsigned)__builtin_amdgcn_update_dpp(0, (int)(x), ctrl, 0xF, 0xF, true))
__device__ __forceinline__ unsigned cvtpk(float lo, float hi) { typedef float f2 __attribute__((ext_vector_type(2))); typedef __bf16 b2 __attribute__((ext_vector_type(2))); f2 v = {lo, hi}; b2 b = __builtin_convertvector(v, b2); return __builtin_bit_cast(unsigned, b); }

struct TileRegs { v4u k, v; };
__device__ __forceinline__ void tile_load(TileRegs& R, const bf16* Kt, const bf16* Vt, long row0, long rowmax, int tid) {
    long r = row0 + (tid >> 3); r = r < 0 ? 0 : (r > rowmax ? rowmax : r);
    R.k = *(const v4u*)(Kt + r * 256 + (tid & 7) * 8); R.v = *(const v4u*)(Vt + r * 256 + (tid & 7) * 8);
}
__device__ __forceinline__ void tile_store(const TileRegs& R, LAS unsigned char* buf, int tid) {
    *(LAS v4u*)(buf + (tid >> 3) * KSTR + (tid & 7) * 16) = R.k;
    typedef unsigned u2 __attribute__((ext_vector_type(2)));
    LAS unsigned char* vp = buf + 64 * KSTR + (tid >> 3) * VSTR + (tid & 7) * 16;
    *(LAS u2*)vp = (u2){R.v.x, R.v.y}; *(LAS u2*)(vp + 8) = (u2){R.v.z, R.v.w};
}
__device__ __forceinline__ void qkt(f32x16& p0, f32x16& p1, const LAS unsigned char* buf, const LAS unsigned char* qrow  , int r32, int hi) {
    const LAS unsigned char* kb = buf + r32 * KSTR + hi * 16;
    p0 = f32x16{}; p1 = f32x16{};
#pragma unroll
    for (int d0 = 0; d0 < 4; ++d0) { const bf16x8 a0 = *(const LAS bf16x8*)(kb + d0 * 32), a1 = *(const LAS bf16x8*)(kb + 32 * KSTR + d0 * 32), qf = *(const LAS bf16x8*)(qrow + d0 * 32);
        p0 = __builtin_amdgcn_mfma_f32_32x32x16_bf16(a0, qf, p0, 0, 0, 0); p1 = __builtin_amdgcn_mfma_f32_32x32x16_bf16(a1, qf, p1, 0, 0, 0); }
}
__device__ __forceinline__ s16x4 vtr(const LAS unsigned char* p) { return __builtin_bit_cast(s16x4, __builtin_amdgcn_ds_read_tr16_b64_v4i16((LAS v4i16_t*)p)); }
__device__ __forceinline__ void pv(f32x16 (&o)[2], const LAS unsigned char* buf, const unsigned (&pw)[16], int lane) {
    const int hi = lane >> 5; const LAS unsigned char* vb = buf + 64 * KSTR + (((lane & 15) >> 2) + 4 * hi) * VSTR + (lane & 3) * 8 + ((lane >> 4) & 1) * 32;
#pragma unroll
    for (int s = 0; s < 4; ++s) { const bf16x8 pa = __builtin_bit_cast(bf16x8, (v4u){pw[4 * s], pw[4 * s + 1], pw[4 * s + 2], pw[4 * s + 3]});
#pragma unroll
        for (int d0 = 0; d0 < 2; ++d0) { const s16x4 lo = vtr(vb + (16 * s) * VSTR + d0 * 64), hh = vtr(vb + (16 * s + 8) * VSTR + d0 * 64);
            const bf16x8 vf = (bf16x8){lo[0], lo[1], lo[2], lo[3], hh[0], hh[1], hh[2], hh[3]};
            o[d0] = __builtin_amdgcn_mfma_f32_32x32x16_bf16(pa, vf, o[d0], 0, 0, 0); } }
}
__device__ __forceinline__ float rowmax32(const f32x16& p0, const f32x16& p1, int hi) {
    float a = fmaxf(p0[0], p1[0]);
#pragma unroll
    for (int r = 1; r < 16; ++r) a = fmaxf(a, fmaxf(p0[r], p1[r]));
    return fmaxf(a, swap_other(a, hi));
}
template <int MULT, bool FAR>
__device__ __forceinline__ void bias_mask(f32x16& p0, f32x16& p1, int dl, const LAS float* tbl  ) {
#pragma unroll
    for (int r = 0; r < 16; ++r) { const int c = (r & 3) + 8 * (r >> 2);
        const int d0 = dl - MULT * c, d1 = dl - MULT * (c + 32);
        const int i0 = min(max(d0, -1), 128) + 1, i1 = min(max(d1, -1), 128) + 1;
        float b0 = tbl[i0 * 16], b1 = tbl[i1 * 16];
        if (FAR) { if (d0 >= 512) b0 = MASKV; if (d1 >= 512) b1 = MASKV; }
        p0[r] += b0; p1[r] += b1;
        if ((r & 3) == 3) asm volatile("" ::: "memory"); }
}
__device__ __forceinline__ void row_to_regs(float (&fr)[16], float f, LAS float* wsf, int r32, int hi) {
    if (hi == 0) wsf[r32] = f;
    asm volatile("s_waitcnt lgkmcnt(0)" ::: "memory");
#pragma unroll
    for (int r = 0; r < 16; ++r) fr[r] = wsf[crow(r, hi)];
    asm volatile("s_waitcnt lgkmcnt(0)" ::: "memory");
}
}

#ifndef TSEC
#define TSEC 0
#endif
#define TSB(id) do { if (TSEC == (id)) ts0_ = __builtin_amdgcn_s_memrealtime(); } while (0)
#define TSE(id) do { if (TSEC == (id)) tacc_ += __builtin_amdgcn_s_memrealtime() - ts0_; } while (0)
__device__ __forceinline__ void attn_dense_phase(Frame& F) {
    using namespace nsa;
    unsigned long long ts0_ = 0, tacc_ = 0; (void)ts0_;
    LAS unsigned char* L = F.lds + RING_OFF;
    LAS float* TB = (LAS float*)(L + L_TB); LAS float* wsf = (LAS float*)(L + L_WSF) + F.wave * 64; LAS float* SC = (LAS float*)(L + L_SC); LAS unsigned* SELM = (LAS unsigned*)(L + L_SELM);
    const int wave = F.wave;
    for (int i = F.tid; i < TBN * 16; i += NWAVES * 64) { const int idx = i >> 4, hh = i & 15; float v;
        if (idx == 0) v = MASKV; else if (idx == 129) v = 0.f; else v = F.in[1][t5_bucket_dev(idx - 1) * 16 + hh] - F.in[1][31 * 16 + hh];
        TB[i] = v; }
    for (int i = F.tid; i < (4 * ST_RSTR + 16) / 4; i += NWAVES * 64) ((LAS unsigned*)(L + L_ZERO))[i] = 0u;
    __syncthreads();
    const bf16* KVQ = (const bf16*)(F.ws + WS_KVQ); const bf16* GATES = KVQ + 10 * KVQ_TSTRIDE;
    const bf16* KCMP = (const bf16*)(F.ws + WS_KCMP); const bf16* VCMP = (const bf16*)(F.ws + WS_VCMP);
    bf16* O = (bf16*)(F.ws + WS_O);
    unsigned* UCTR0 = (unsigned*)(F.ws + WS_CTL) + 1024; LAS unsigned* UCUR = (LAS unsigned*)(L + L_FLAG) + 17; unsigned ugrp = (unsigned)(F.vcu >> 5) & 7u;
#define NSA_DEAL(dst) do { dst = 2048u; for (int tr_ = 0; tr_ < 8; ++tr_) { const unsigned u_ = atomicAdd(UCTR0 + 64 * ugrp, 1u); if (u_ < 256u) { dst = 256u * ugrp + u_; break; } ugrp = (ugrp + 1u) & 7u; } } while (0)
    if (F.tid == 0) { unsigned d0_; NSA_DEAL(d0_); UCUR[0] = d0_; }
    __syncthreads();
#pragma unroll 1
    for (unsigned ucur = UCUR[0]; ucur < 2048u; ucur = UCUR[0]) {
        const int lane = fresh_lane(), tid = wave * 64 + lane, r32 = lane & 31, hi = lane >> 5, ql = r32 >> 2, h = r32 & 3;
        unsigned unext = 2048u; if (tid == 0) NSA_DEAL(unext);
        const int bg = 2 * (int)(ucur >> 8) + (int)((ucur >> 7) & 1u), b = bg >> 2, g = bg & 3, qt = 127 - (int)(ucur & 127u), t0 = qt * 64, cb = qt;
        const int i = 8 * wave + ql, pos = t0 + i; const long row = (long)b * SEQ + pos;
        const LAS float* tbl = TB + g * 4 + h;
        const LAS unsigned char* qr = L + L_QS + (32 * wave + r32) * QS_STR + hi * 16;
        { const bf16* qp = KVQ + (size_t)(6 + g) * KVQ_TSTRIDE + row * 256 + h * 64 + hi * 8;
#pragma unroll
          for (int d0 = 0; d0 < 4; ++d0) *(LAS bf16x8*)(L + L_QS + (32 * wave + r32) * QS_STR + hi * 16 + d0 * 32) = *(const bf16x8*)(qp + d0 * 16); }
        if (hi == 0) { const bf16* gp = GATES + row * 256 + g * 12 + h * 3; LAS float* G2 = (LAS float*)(L + L_G2) + (32 * wave + r32) * 2; G2[0] = bf2f(gp[0]); G2[1] = bf2f(gp[2]); ((LAS float*)(L + L_GS))[32 * wave + r32] = bf2f(gp[1]); }
        float mwin;
        f32x16 oacc[2];
        TileRegs TR, TF;
        TSB(1);
        TileRegs TC;
        if (t0 + 63 >= 31) tile_load(TC, KCMP + g * 64, VCMP + g * 64, (long)b * 512, (long)BATCH * 512 - 1, tid);
        { const bf16* Kt = KVQ + 4 * KVQ_TSTRIDE + g * 64; const bf16* Vt = KVQ + 5 * KVQ_TSTRIDE + g * 64; const long base = (long)b * SEQ, rmax = (long)T - 1;
          const int kt0 = t0 >= 512 ? 0 : 8 - cb;
          LAS float* LINE = (LAS float*)(L + L_SC);
          if (tid < LSTR) {
#pragma unroll
              for (int hh = 0; hh < 4; ++hh) { float v; if (tid < 260) { const int d = tid - 68; v = d < 0 ? MASKV : TB[(min(d, 128) + 1) * 16 + g * 4 + hh]; } else v = tid + 184 >= 512 ? MASKV : 0.f;
                  LINE[hh * LSTR + tid] = v; } }
          f32x16 (&o)[2] = oacc; o[0] = f32x16{}; o[1] = f32x16{}; float m = MINIT, l = 0.f;
          tile_load(TR, Kt, Vt, base + t0 - 512 + 64 * kt0, rmax, tid); tile_store(TR, L + L_KV, tid); __syncthreads();
#pragma unroll 1
          for (int kt = kt0; kt < 9; ++kt) { LAS unsigned char* buf = L + L_KV + ((kt - kt0) & 1) * KVBUF;
              if (kt < 8) tile_load(TR, Kt, Vt, base + t0 - 512 + 64 * (kt + 1), rmax, tid);
              f32x16 p0, p1; qkt(p0, p1, buf, qr, r32, hi);
              if (kt == 0 || kt >= 6) { const int dl = 512 - 64 * kt + i - 4 * hi;
                  const LAS float* lp = LINE + h * LSTR + (kt == 0 ? dl - 247 : dl + 5);
#pragma unroll
                  for (int r = 0; r < 16; ++r) { const int c = (r & 3) + 8 * (r >> 2); p0[r] += lp[63 - c]; p1[r] += lp[31 - c]; } }
              p0 *= LOG2E; p1 *= LOG2E;
              const float rm = rowmax32(p0, p1, hi), mn = fmaxf(m, rm), f = __builtin_amdgcn_exp2f(m - mn), nmn = -mn; m = mn; l *= f;
              if (__any(f != 1.0f)) { float fr[16]; row_to_regs(fr, f, wsf, r32, hi);
#pragma unroll
                  for (int r = 0; r < 16; ++r) { o[0][r] *= fr[r]; o[1][r] *= fr[r]; } }
              unsigned pw[16]; p0 += nmn; p1 += nmn;
#pragma unroll
              for (int r = 0; r < 16; ++r) { p0[r] = __builtin_amdgcn_exp2f(p0[r]); p1[r] = __builtin_amdgcn_exp2f(p1[r]); }
              { const f32x16 s = p0 + p1; typedef float f32x2 __attribute__((ext_vector_type(2))); f32x2 s2 = {s[0], s[1]};
#pragma unroll
                for (int r = 1; r < 8; ++r) s2 += (f32x2){s[2 * r], s[2 * r + 1]};
                l += s2.x + s2.y; }
#pragma unroll
              for (int r = 0; r < 8; ++r) { pw[r] = cvtpk(p0[2 * r], p0[2 * r + 1]); pw[8 + r] = cvtpk(p1[2 * r], p1[2 * r + 1]); }
              pv(o, buf, pw, lane);
              if (kt < 8) tile_store(TR, L + L_KV + ((kt - kt0 + 1) & 1) * KVBUF, tid);
              __syncthreads(); }
          const float g_w = ((const LAS float*)(L + L_G2))[(32 * wave + r32) * 2 + 1]; const float lt = l + swap_other(l, hi); float fr[16]; row_to_regs(fr, lt > 0.f ? g_w / lt : 0.f, wsf, r32, hi); mwin = m * (1.0f / LOG2E);
#pragma unroll
          for (int r = 0; r < 16; ++r) { oacc[0][r] *= fr[r]; oacc[1][r] *= fr[r]; } }
        TSE(1); TSB(2);
        { const bf16* Kt = KCMP + g * 64; const bf16* Vt = VCMP + g * 64; const long base = (long)b * 512, rmax = (long)BATCH * 512 - 1;
          const int nvmax = t0 + 63 >= 31 ? ((t0 + 32) >> 4) + 1 : 0, ntc = (nvmax + 63) >> 6;
          float m = MINIT, l = 0.f;
          if (ntc > 0) tile_store(TC, L + L_KV, tid);
          __syncthreads();
#pragma unroll 1
          for (int tc = 0; tc < ntc; ++tc) { LAS unsigned char* buf = L + L_KV + (tc & 1) * KVBUF;
              tile_load(TR, Kt, Vt, base + 64 * (tc + 1 < ntc ? tc + 1 : 0), rmax, tid);
              f32x16 p0, p1; qkt(p0, p1, buf, qr, r32, hi);
              if (t0 - 1024 * tc - 1039 < 128) bias_mask<16, false>(p0, p1, pos - 31 - 1024 * tc - 64 * hi, tbl);
              p0 *= LOG2E; p1 *= LOG2E;
              const float rm = rowmax32(p0, p1, hi), mn = fmaxf(m, rm), nmn = -mn; l *= __builtin_amdgcn_exp2f(m - mn); m = mn;
              p0 += nmn; p1 += nmn;
#pragma unroll
              for (int r = 0; r < 16; ++r) { p0[r] = __builtin_amdgcn_exp2f(p0[r]); p1[r] = __builtin_amdgcn_exp2f(p1[r]); }
              { const f32x16 s = p0 + p1; typedef float f32x2 __attribute__((ext_vector_type(2))); f32x2 s2 = {s[0], s[1]};
#pragma unroll
                for (int r = 1; r < 8; ++r) s2 += (f32x2){s[2 * r], s[2 * r + 1]};
                l += s2.x + s2.y; }
              tile_store(TR, L + L_KV + ((tc + 1) & 1) * KVBUF, tid);
              __syncthreads(); }
          const float g_c = ((const LAS float*)(L + L_G2))[(32 * wave + r32) * 2]; const float lt = l + swap_other(l, hi), linv = lt > 0.f ? 1.0f / lt : 0.f, nm = -m;
          float carry = 0.f;
          tile_load(TF, KVQ + 2 * KVQ_TSTRIDE + g * 64, KVQ + 3 * KVQ_TSTRIDE + g * 64, (long)b * SEQ, (long)T - 1, tid);
#pragma unroll 1
          for (int tc = 0; tc < ntc; ++tc) { LAS unsigned char* buf = L + L_KV + ((ntc + tc) & 1) * KVBUF;
              if (tc + 1 < ntc) tile_load(TR, Kt, Vt, base + 64 * (tc + 1), rmax, tid);
              f32x16 p0, p1; qkt(p0, p1, buf, qr, r32, hi);
              if (t0 - 1024 * tc - 1039 < 128) bias_mask<16, false>(p0, p1, pos - 31 - 1024 * tc - 64 * hi, tbl);
              unsigned pw[16];
#pragma unroll
              for (int r = 0; r < 16; ++r) { p0[r] = __builtin_amdgcn_exp2f(fmaf(p0[r], LOG2E, nm)); p1[r] = __builtin_amdgcn_exp2f(fmaf(p1[r], LOG2E, nm)); }
              p0 *= linv; p1 *= linv;
#pragma unroll
              for (int r = 0; r < 8; ++r) { pw[r] = cvtpk(p0[2 * r] * g_c, p0[2 * r + 1] * g_c); pw[8 + r] = cvtpk(p1[2 * r] * g_c, p1[2 * r + 1] * g_c); }
              pv(oacc, buf, pw, lane);
              float w8[8], c8[8];
#pragma unroll
              for (int kq = 0; kq < 8; ++kq) { float a[4];
#pragma unroll
                  for (int e = 0; e < 4; ++e) { float x = kq < 4 ? p0[4 * kq + e] : p1[4 * (kq - 4) + e]; x += NSA_DPP(x, 0xB1); x += NSA_DPP(x, 0x4E); a[e] = x; }
                  w8[kq] = 2.0f * (a[0] + a[1] + a[2]) + a[3]; c8[kq] = a[3]; }
#pragma unroll
              for (int kq = 0; kq < 8; ++kq) { const float ok = swap_other(c8[kq], hi); w8[kq] += hi ? ok : carry; carry = ok; }
              LAS float* scq = SC + i * 128 + 16 * tc;
#pragma unroll
              for (int kq = 0; kq < 8; ++kq) if ((kq & 3) == h) scq[2 * kq + hi] = w8[kq];
              if (tc + 1 < ntc) tile_store(TR, L + L_KV + ((ntc + tc + 1) & 1) * KVBUF, tid);
              __syncthreads(); }
        }
        TSE(2); TSB(3);
        { const int lq = lane >> 3, sub = lane & 7; unsigned msk[4] = {0u, 0u, 0u, 0u};
          if (cb <= 15) { msk[0] = (cb == 31) ? 0xffffffffu : ((1u << (cb + 1)) - 1u); }
          else { unsigned key[16]; const LAS float* scq = SC + (8 * wave + lq) * 128;
              asm volatile("s_waitcnt lgkmcnt(0)" ::: "memory");
#pragma unroll
              for (int kk = 0; kk < 16; ++kk) { const int j = sub + 8 * kk; const float s = scq[j]; key[kk] = (j >= 1 && j <= cb - 2) ? ((__float_as_uint(s) & 0xFFFFFF80u) | (unsigned)(127 - j)) : 0u; }
#pragma unroll 1
              for (int rd = 0; rd < 13; ++rd) { unsigned mx = key[0];
#pragma unroll
                  for (int kk = 1; kk < 16; ++kk) mx = mx > key[kk] ? mx : key[kk];
                  { unsigned o1 = NSA_DPPU(mx, 0xB1); mx = mx > o1 ? mx : o1; o1 = NSA_DPPU(mx, 0x4E); mx = mx > o1 ? mx : o1; o1 = NSA_DPPU(mx, 0x141); mx = mx > o1 ? mx : o1; }
                  const int j = 127 - (int)(mx & 127u);
#pragma unroll
                  for (int w4 = 0; w4 < 4; ++w4) if (mx != 0u && (j >> 5) == w4) msk[w4] |= 1u << (j & 31);
#pragma unroll
                  for (int kk = 0; kk < 16; ++kk) if (key[kk] == mx) key[kk] = 0u; }
              msk[0] |= 1u;
#pragma unroll
              for (int w4 = 0; w4 < 4; ++w4) { if (((cb - 1) >> 5) == w4) msk[w4] |= 1u << ((cb - 1) & 31); if ((cb >> 5) == w4) msk[w4] |= 1u << (cb & 31); } }
          if (sub < 4) { const unsigned mv = sub == 0 ? msk[0] : sub == 1 ? msk[1] : sub == 2 ? msk[2] : msk[3];
              SELM[(8 * wave + lq) * 4 + sub] = mv; } }
        TSE(3); TSB(4);
        { LAS unsigned short* PO = (LAS unsigned short*)(L + L_PO);
#pragma unroll
          for (int r = 0; r < 16; ++r) { const int rw = 32 * wave + crow(r, hi); PO[rw * 64 + r32] = (unsigned short)f2bf(oacc[0][r]); PO[rw * 64 + 32 + r32] = (unsigned short)f2bf(oacc[1][r]); } }
        { LAS float* NMREF = (LAS float*)(L + L_NMREF); LAS float* GS = (LAS float*)(L + L_GS); LAS unsigned char* QS = L + L_QS; LAS unsigned* FLAG = (LAS unsigned*)(L + L_FLAG);
          { const int l2 = fresh_lane(); if (l2 < 32) NMREF[32 * wave + l2] = -mwin * LOG2E; if (wave == 0 && l2 == 0) FLAG[16] = 1u; }
          __syncthreads();
          if (tid < 260) {
#pragma unroll
              for (int hh = 0; hh < 4; ++hh) { const int d = tid - 68; ((LAS float*)(L + L_SC))[hh * LSTR + tid] = d < 0 ? MASKV : TB[(min(d, 128) + 1) * 16 + g * 4 + hh]; } }
          f32x16 osel[2]; osel[0] = f32x16{}; osel[1] = f32x16{};
          { const bf16* Kt = KVQ + 2 * KVQ_TSTRIDE + g * 64; const bf16* Vt = KVQ + 3 * KVQ_TSTRIDE + g * 64; const long base = (long)b * SEQ, rmax = (long)T - 1;
            const int nd = cb <= 15 ? cb + 1 : 3; const float nmw = -mwin * LOG2E; float lsd = 0.f;
#define NSA_DBLK(ii) (cb <= 15 ? (ii) : ((ii) == 0 ? 0 : cb - 2 + (ii)))
            tile_store(TF, L + L_KV, tid); __syncthreads();
#pragma unroll 1
            for (int ii = 0; ii < nd; ++ii) { LAS unsigned char* buf = L + L_KV + (ii & 1) * KVBUF; const int blk = NSA_DBLK(ii);
                if (ii + 1 < nd) tile_load(TR, Kt, Vt, base + 64 * NSA_DBLK(ii + 1), rmax, tid);
                f32x16 p0, p1; qkt(p0, p1, buf, qr, r32, hi);
                if (blk >= cb - 2) { const LAS float* lp = (const LAS float*)(L + L_SC) + h * LSTR + (t0 + i - 64 * blk - 4 * hi) + 5;
#pragma unroll
                    for (int r = 0; r < 16; ++r) { const int c = (r & 3) + 8 * (r >> 2); p0[r] += lp[63 - c]; p1[r] += lp[31 - c]; } }
                unsigned pw[16]; float ls = 0.f;
#pragma unroll
                for (int r = 0; r < 16; ++r) { p0[r] = __builtin_amdgcn_exp2f(fminf(fmaf(p0[r], LOG2E, nmw), 100.f)); p1[r] = __builtin_amdgcn_exp2f(fminf(fmaf(p1[r], LOG2E, nmw), 100.f)); ls += p0[r] + p1[r]; }
                lsd += ls;
#pragma unroll
                for (int r = 0; r < 8; ++r) { pw[r] = cvtpk(p0[2 * r], p0[2 * r + 1]); pw[8 + r] = cvtpk(p1[2 * r], p1[2 * r + 1]); }
                pv(osel, buf, pw, lane);
                if (ii + 1 < nd) tile_store(TR, L + L_KV + ((ii + 1) & 1) * KVBUF, tid);
                __syncthreads(); }
#undef NSA_DBLK
            lsd += swap_other(lsd, hi); if (hi == 0) ((LAS float*)(L + L_LSD))[32 * wave + r32] = lsd; }
          float osp[4][8]; float lsp[4] = {0.f, 0.f, 0.f, 0.f};
          { LAS float* cv = (LAS float*)(L + L_ST) + wave * 2048;
#pragma unroll
            for (int r = 0; r < 16; ++r) { cv[crow(r, hi) * 64 + r32] = osel[0][r]; cv[crow(r, hi) * 64 + 32 + r32] = osel[1][r]; }
            asm volatile("s_waitcnt lgkmcnt(0)" ::: "memory");
            const LAS float* cr = cv + (4 * (lane >> 3)) * 64 + 8 * (lane & 7);
#pragma unroll
            for (int hh = 0; hh < 4; ++hh) { const f32x4 a = *(const LAS f32x4*)(cr + hh * 64), bq = *(const LAS f32x4*)(cr + hh * 64 + 4);
#pragma unroll
                for (int e = 0; e < 4; ++e) { osp[hh][e] = a[e]; osp[hh][4 + e] = bq[e]; } } }
          __syncthreads();
          const int fr16 = lane & 15, q4 = lane >> 4, qi = fr16 >> 2, hc = fr16 & 3;
          const bf16* Ks = KVQ + 2 * KVQ_TSTRIDE + ((long)b * SEQ) * 256 + g * 64; const bf16* VT = (const bf16*)(F.ws + WS_VT) + (size_t)((b * 4 + g) * 128) * 4096;
          bf16x8 Kf[4][2] = {}, Vf[4][2] = {}; unsigned long long qm = 0ull, qmn = 0ull; int jn = 0, jc = 0, jcn = 0;
#define NSA_SCAN_NEXT() do { qmn = 0ull; for (;;) { unsigned jx = 0u; if (lane == 0) jx = __hip_atomic_fetch_add(FLAG + 16, 1u, __ATOMIC_RELAXED, __HIP_MEMORY_SCOPE_WORKGROUP); \
              const int j = __builtin_amdgcn_readfirstlane((int)jx); if (j > cb - 2) break;                      \
              { const unsigned wv = SELM[lane * 4 + (j >> 5)]; qmn = __ballot((wv >> (j & 31)) & 1u); } \
              jcn = j; if (qmn) break; } } while (0)
#define NSA_LOAD_K(j) do { const bf16* kp = Ks + (size_t)(64 * (j) + fr16) * 256 + 8 * q4; \
              _Pragma("unroll") for (int a = 0; a < 4; ++a) _Pragma("unroll") for (int s2 = 0; s2 < 2; ++s2) Kf[a][s2] = *(const bf16x8*)(kp + a * 16 * 256 + s2 * 32); } while (0)
#define NSA_LOAD_V(j) do { const bf16* vp = VT + (size_t)(j) * 4096 + fr16 * 64 + 8 * q4; \
              _Pragma("unroll") for (int a = 0; a < 4; ++a) _Pragma("unroll") for (int s2 = 0; s2 < 2; ++s2) Vf[a][s2] = *(const bf16x8*)(vp + a * 16 * 64 + s2 * 32); } while (0)
#define NSA_LOAD_K_D(j, dep) do { const bf16* kp = Ks + (size_t)(64 * (j) + fr16) * 256 + 8 * q4 + (dep); \
              _Pragma("unroll") for (int a = 0; a < 4; ++a) _Pragma("unroll") for (int s2 = 0; s2 < 2; ++s2) Kf[a][s2] = *(const bf16x8*)(kp + a * 16 * 256 + s2 * 32); } while (0)
#define NSA_LOAD_V_D(j, dep) do { const bf16* vp = VT + (size_t)(j) * 4096 + fr16 * 64 + 8 * q4 + (dep); \
              _Pragma("unroll") for (int a = 0; a < 4; ++a) _Pragma("unroll") for (int s2 = 0; s2 < 2; ++s2) Vf[a][s2] = *(const bf16x8*)(vp + a * 16 * 64 + s2 * 32); } while (0)
          if (cb > 15) {
              int gi = 0, rd = 0; bool fin = false;
              auto consume = [&]() __attribute__((always_inline)) { const LAS unsigned char* sb = L + L_ST + (rd & 1) * STBUF;
                const unsigned tg = *(sb + ST_TAGS + lane);
                const int ql8 = lane >> 3; unsigned long long mym = 0ull;
#pragma unroll
                for (int q = 0; q < 8; ++q) { const unsigned long long bm = __ballot(tg == (unsigned)(8 * wave + q)); if (ql8 == q) mym = bm; }
                typedef unsigned u2 __attribute__((ext_vector_type(2)));
                auto pull2 = [&]() __attribute__((always_inline)) {
                    const bool a0 = mym != 0ull; const int j0 = a0 ? __builtin_ctzll(mym) : 0; mym &= mym - 1ull;
                    const bool a1 = mym != 0ull; const int j1 = a1 ? __builtin_ctzll(mym) : 0; mym &= mym - 1ull;
                    const LAS unsigned char* dp0 = (a0 ? sb + (4 * j0) * ST_RSTR : L + L_ZERO) + 16 * (lane & 7); const LAS unsigned char* dp1 = (a1 ? sb + (4 * j1) * ST_RSTR : L + L_ZERO) + 16 * (lane & 7);
                    const f32x4 lv0 = *(const LAS f32x4*)(a0 ? sb + ST_LVAL + 16 * j0 : L + L_ZERO + 4 * ST_RSTR), lv1 = *(const LAS f32x4*)(a1 ? sb + ST_LVAL + 16 * j1 : L + L_ZERO + 4 * ST_RSTR);
                    u2 d0[4][2], d1[4][2];
#pragma unroll
                    for (int hh = 0; hh < 4; ++hh) { d0[hh][0] = *(const LAS u2*)(dp0 + hh * ST_RSTR); d0[hh][1] = *(const LAS u2*)(dp0 + hh * ST_RSTR + 8); d1[hh][0] = *(const LAS u2*)(dp1 + hh * ST_RSTR); d1[hh][1] = *(const LAS u2*)(dp1 + hh * ST_RSTR + 8); }
#pragma unroll
                    for (int hh = 0; hh < 4; ++hh) {
#pragma unroll
                        for (int w = 0; w < 2; ++w) { const unsigned x0 = d0[hh][w].x, y0 = d0[hh][w].y, x1 = d1[hh][w].x, y1 = d1[hh][w].y;
                            osp[hh][4 * w + 0] += __uint_as_float(x0 << 16) + __uint_as_float(x1 << 16); osp[hh][4 * w + 1] += __uint_as_float(x0 & 0xFFFF0000u) + __uint_as_float(x1 & 0xFFFF0000u);
                            osp[hh][4 * w + 2] += __uint_as_float(y0 << 16) + __uint_as_float(y1 << 16); osp[hh][4 * w + 3] += __uint_as_float(y0 & 0xFFFF0000u) + __uint_as_float(y1 & 0xFFFF0000u); }
                        lsp[hh] += lv0[hh] + lv1[hh]; } };
                if (__ballot(mym != 0ull) != 0ull) { pull2();
                    if (__ballot(mym != 0ull) != 0ull) { pull2();
                        while (__ballot(mym != 0ull) != 0ull) pull2(); } } };
              auto round_end = [&](const bool more) __attribute__((always_inline)) -> bool {
                if (lane == 0) FLAG[(rd & 1) * 8 + wave] = more ? 1u : 0u;
                asm volatile("s_waitcnt lgkmcnt(0)" ::: "memory"); __builtin_amdgcn_s_barrier(); asm volatile("" ::: "memory");
                const unsigned any = FLAG[(rd & 1) * 8 + (lane & 7)];
                consume(); ++rd; gi = 0;
                return __ballot(any != 0u) == 0ull; };
              auto group = [&](const bool last) __attribute__((always_inline)) {
                  LAS unsigned char* stb = L + L_ST + (rd & 1) * STBUF; const int sidx = wave * SG + gi;
                  LAS unsigned char* sdat = stb + (16 * sidx + fr16) * ST_RSTR; LAS float* slv = (LAS float*)(stb + ST_LVAL) + 16 * sidx + fr16; LAS unsigned char* stg = stb + ST_TAGS + 4 * sidx;
                  int iq[4];
#pragma unroll
                  for (int e = 0; e < 4; ++e) { if (qm) { iq[e] = __builtin_ctzll(qm); qm &= qm - 1ull; } else iq[e] = -1; }
                  const int myq = qi == 0 ? iq[0] : qi == 1 ? iq[1] : qi == 2 ? iq[2] : iq[3]; const bool cval = myq >= 0; const int rowq = 4 * (cval ? myq : iq[0]) + hc;
                  const bf16x8 q0 = *(const LAS bf16x8*)(QS + rowq * QS_STR + q4 * 16), q1 = *(const LAS bf16x8*)(QS + rowq * QS_STR + 64 + q4 * 16);
                  const float nmr = NMREF[rowq];
                  f32x4 st[4];
#pragma unroll
                  for (int kt = 0; kt < 4; ++kt) { st[kt] = (f32x4){0.f, 0.f, 0.f, 0.f};
                      st[kt] = __builtin_amdgcn_mfma_f32_16x16x32_bf16(Kf[kt][0], q0, st[kt], 0, 0, 0); st[kt] = __builtin_amdgcn_mfma_f32_16x16x32_bf16(Kf[kt][1], q1, st[kt], 0, 0, 0); }
                  const int jnx = qmn ? jcn : jc;
                  if (last) { int dep = 0; asm volatile("" : "+v"(dep) : "v"(st[0]), "v"(st[1]), "v"(st[2]), "v"(st[3])); NSA_LOAD_K_D(jnx, dep); }
                  if (jc >= cb - 2) { const int dl = t0 + (cval ? myq : iq[0]) - 64 * jc - 4 * q4; const LAS float* tb2 = TB + g * 4 + hc;
#pragma unroll
                      for (int kt = 0; kt < 4; ++kt)
#pragma unroll
                          for (int r = 0; r < 4; ++r) { const int d = dl - 16 * kt - r; st[kt][r] += tb2[(min(max(d, -1), 128) + 1) * 16]; } }
                  float ls = 0.f;
#pragma unroll
                  for (int kt = 0; kt < 4; ++kt)
#pragma unroll
                      for (int r = 0; r < 4; ++r) { const float p = __builtin_amdgcn_exp2f(fminf(fmaf(st[kt][r], LOG2E, nmr), 100.f)); st[kt][r] = p; ls += p; }
                  { const auto s16 = __builtin_amdgcn_permlane16_swap(__float_as_uint(ls), __float_as_uint(ls), false, false); ls = __uint_as_float(s16[0]) + __uint_as_float(s16[1]);
                    const auto s32 = __builtin_amdgcn_permlane32_swap(__float_as_uint(ls), __float_as_uint(ls), false, false); ls = __uint_as_float(s32[0]) + __uint_as_float(s32[1]); }
                  if (q4 == 0) slv[0] = ls;
                  if (lane < 4) stg[lane] = (unsigned char)(lane == 0 ? iq[0] : lane == 1 ? iq[1] : lane == 2 ? iq[2] : iq[3]);
                  bf16x8 pf[2];
#pragma unroll
                  for (int s2 = 0; s2 < 2; ++s2) pf[s2] = __builtin_bit_cast(bf16x8, (v4u){cvtpk(st[2 * s2][0], st[2 * s2][1]), cvtpk(st[2 * s2][2], st[2 * s2][3]), cvtpk(st[2 * s2 + 1][0], st[2 * s2 + 1][1]), cvtpk(st[2 * s2 + 1][2], st[2 * s2 + 1][3])});
                  f32x4 ot[4];
#pragma unroll
                  for (int dt = 0; dt < 4; ++dt) { ot[dt] = (f32x4){0.f, 0.f, 0.f, 0.f};
                      ot[dt] = __builtin_amdgcn_mfma_f32_16x16x32_bf16(Vf[dt][0], pf[0], ot[dt], 0, 0, 0); ot[dt] = __builtin_amdgcn_mfma_f32_16x16x32_bf16(Vf[dt][1], pf[1], ot[dt], 0, 0, 0); }
                  if (last) { int dep = 0; asm volatile("" : "+v"(dep) : "v"(ot[0]), "v"(ot[1]), "v"(ot[2]), "v"(ot[3])); NSA_LOAD_V_D(jnx, dep); }
#pragma unroll
                  for (int dt = 0; dt < 4; ++dt) { typedef unsigned u2 __attribute__((ext_vector_type(2)));
                      *(LAS u2*)(sdat + (16 * dt + 4 * q4) * 2) = (u2){cvtpk(ot[dt][0], ot[dt][1]), cvtpk(ot[dt][2], ot[dt][3])}; } };
              NSA_SCAN_NEXT(); if (qmn) { NSA_LOAD_K(jcn); NSA_LOAD_V(jcn); }
#pragma unroll 1
              while (qmn != 0ull) { qm = qmn; jc = jcn;
#pragma unroll 1
                  while (__builtin_popcountll(qm) > 4) { group(false); if (++gi == SG) round_end(true); }
                  NSA_SCAN_NEXT();
                  group(true);
                  if (++gi == SG) fin = round_end(qmn != 0ull); }
#pragma unroll 1
              while (!fin) { LAS unsigned char* stb = L + L_ST + (rd & 1) * STBUF;
                  for (; gi < SG; ++gi) if (lane < 4) stb[ST_TAGS + 4 * (wave * SG + gi) + lane] = (unsigned char)255;
                  fin = round_end(false); }
          }
          { const int ln = fresh_lane(), q8 = ln >> 3, dg = ln & 7;
#pragma unroll
            for (int hh = 0; hh < 4; ++hh) { const int rw = 32 * wave + 4 * q8 + hh;
                const float lsum = lsp[hh] + ((const LAS float*)(L + L_LSD))[rw]; const float f = lsum > 0.f ? GS[rw] / lsum : 0.f;
                const v4u po = *(const LAS v4u*)(L + L_PO + rw * 128 + 16 * dg); v4u ov;
                ov.x = cvtpk(__uint_as_float(po.x << 16) + osp[hh][0] * f, __uint_as_float(po.x & 0xFFFF0000u) + osp[hh][1] * f); ov.y = cvtpk(__uint_as_float(po.y << 16) + osp[hh][2] * f, __uint_as_float(po.y & 0xFFFF0000u) + osp[hh][3] * f);
                ov.z = cvtpk(__uint_as_float(po.z << 16) + osp[hh][4] * f, __uint_as_float(po.z & 0xFFFF0000u) + osp[hh][5] * f); ov.w = cvtpk(__uint_as_float(po.w << 16) + osp[hh][6] * f, __uint_as_float(po.w & 0xFFFF0000u) + osp[hh][7] * f);
                *(v4u*)(O + ((long)b * SEQ + t0 + 8 * wave + q8) * 1024 + (g * 4 + hh) * 64 + 8 * dg) = ov; } } }
        TSE(4);
        if (tid == 0) UCUR[0] = unext;
        __syncthreads();
    }
    if (TSEC) { const unsigned long long tb_ = __builtin_amdgcn_s_memrealtime(); while (__builtin_amdgcn_s_memrealtime() - tb_ < tacc_) __builtin_amdgcn_s_sleep(4); }
}


#ifndef MK_PER_PHASE
#define MK_PER_PHASE 0
#endif
constexpr int N_PHASES = 14;
struct Args { const float* in[20]; float* out; unsigned char* ws; int ph_lo, ph_hi, li, pad; };
__global__ void __launch_bounds__(NWAVES * 64, 2) nsa_fwd(Args args) {
    extern __shared__ __attribute__((aligned(16))) unsigned char lds[];
    Frame F;
    F.lds = (LAS unsigned char*)lds;
    F.MISC = (volatile LAS unsigned*)(F.lds + MISC_OFF);
    F.tid = threadIdx.x; F.lane = F.tid & 63; F.wave = __builtin_amdgcn_readfirstlane(F.tid >> 6);
    F.G = gridDim.x; { const int bx = blockIdx.x; F.vcu = (F.G % 8 == 0) ? (bx % 8) * (F.G / 8) + bx / 8 : bx; }
    unsigned char* ws = args.ws; F.ws = ws; F.out = args.out;
    F.ctl = (gu32*)(ws + WS_CTL);
    F.in = args.in;
    for (int u = F.tid; u < (LDS_BYTES - LDSCTL_OFF) / 4; u += NWAVES * 64) ((LAS unsigned*)(F.lds + LDSCTL_OFF))[u] = 0u;
    __syncthreads();
    XcdBarrier bar; bar.bar = (unsigned*)(F.ctl + CW_BAR); bar.x = 0; bar.st = nullptr; bar.G = 0;
    if (!MK_PER_PHASE) bar = xcd_barrier_post((unsigned*)(F.ctl + CW_BAR), F.MISC + 8, F.tid == 0, gridDim.x);
    const bool use_gbar = !MK_PER_PHASE && F.G == 256;
    XcdBarrier gbar = bar;
    if (use_gbar) gbar = xcd_barrier_post((unsigned*)(F.ctl + CW_BAR) + XCD_BAR_WORDS * (1 + ((int)blockIdx.x & 7)), F.MISC + 10, F.tid == 0, gridDim.x / 8);
#define GROUP_BAR() do { if (use_gbar) xcd_barrier(gbar, F.wave == 0 && fresh_lane() == 0); else GRID_BAR(); } while (0)
#ifdef TBAR
    unsigned long long tbar_acc = 0;
#define GRID_BAR() do { const unsigned long long tq_ = __builtin_amdgcn_s_memrealtime(); xcd_barrier(bar, F.wave == 0 && fresh_lane() == 0); tbar_acc += __builtin_amdgcn_s_memrealtime() - tq_; } while (0)
#else
#define GRID_BAR() do { if (!MK_PER_PHASE) xcd_barrier(bar, F.wave == 0 && fresh_lane() == 0); } while (0)
#endif
    const int lo = args.ph_lo, hi = args.ph_hi;
#ifndef TPH_MASK
#define TPH_MASK 0
#endif
    unsigned long long tph_acc = 0, tph_t0 = 0; int tph_cur = -1; (void)tph_t0; (void)tph_cur;
#define TPH_MARK(k) (TPH_MASK ? (void)((tph_cur >= 0 && ((TPH_MASK >> tph_cur) & 1)) ? (tph_acc += __builtin_amdgcn_s_memrealtime() - tph_t0) : 0ull, tph_cur = (k), tph_t0 = __builtin_amdgcn_s_memrealtime()) : (void)0)
#ifndef TIMB
#define TIMB -1
#endif
    unsigned long long timb_t0 = 0; (void)timb_t0;
#define TIMB_MARK(k) ((TIMB >= 0 && (k) == TIMB) ? (void)(timb_t0 = __builtin_amdgcn_s_memrealtime()) : (void)0)
#define IN(k) (lo <= (k) && (k) < hi && (TPH_MARK(k), TIMB_MARK(k), F.lane = fresh_lane(), F.tid = F.wave * 64 + F.lane, true))
#define BOTH(k) ((TIMB >= 0 && (k) == TIMB) ? (void)((__syncthreads(), F.wave == 0 && fresh_lane() == 0) ? (atomicMax((unsigned*)(ws + WS_CTL) + 24, ~(unsigned)(__builtin_amdgcn_s_memrealtime() - timb_t0)), atomicMax((unsigned*)(ws + WS_CTL) + 25, (unsigned)(__builtin_amdgcn_s_memrealtime() - timb_t0)), 0) : 0) : (void)0, IN(k) && IN((k) + 1))
    bf16* XB = (bf16*)(ws + WS_XB); float* SS = (float*)(ws + WS_SS);
    const int bx = (int)blockIdx.x;

    if (IN(0)) { p0_prologue(F); if (BOTH(0)) GRID_BAR(); }
    if (IN(1)) {
        pg8::Gemm g{XB, (const bf16*)(ws + WS_WIN), T, 3072, DM, 0}; pg8::StaticOrder S; S.init(T, 3072, F.G, bx);
        pg8::EpiWin E{(bf16*)(ws + WS_BG), (bf16*)(ws + WS_V), SS};
        pg8::gemm_phase<pg8::EpiWin, pg8::StaticOrder, true, true>(F.lds + RING_OFF, g, S, E, F.wave);
#ifdef DUP1
        GRID_BAR(); pg8::gemm_phase<pg8::EpiWin, pg8::StaticOrder, true, true>(F.lds + RING_OFF, g, S, E, F.wave);
#endif
        if (BOTH(1)) GRID_BAR(); }
    if (IN(2)) { conv_gate_phase(F); if (BOTH(2)) GROUP_BAR(); }
    if (IN(3)) {
        pg8::Gemm g{(const bf16*)(ws + WS_BG), (const bf16*)(ws + WS_WOUT), T, DM, DM, 0}; pg8::StaticOrder S; S.init(T, DM, F.G, bx);
        pg8::EpiRes E{XB, SS + T};
        pg8::gemm_phase<pg8::EpiRes, pg8::StaticOrder, true, true>(F.lds + RING_OFF, g, S, E, F.wave);
        if (BOTH(3)) GRID_BAR(); }
    if (IN(4)) {
        pg8::Gemm g{XB, (const bf16*)(ws + WS_W1), T, FF, DM, 0}; pg8::StaticOrder S; S.init(T, FF, F.G, bx);
        pg8::EpiRelu2 E{(bf16*)(ws + WS_H), FF, SS + T};
        pg8::gemm_phase<pg8::EpiRelu2, pg8::StaticOrder, true, true>(F.lds + RING_OFF, g, S, E, F.wave);
#ifdef DUP4
        GRID_BAR(); pg8::gemm_phase<pg8::EpiRelu2, pg8::StaticOrder, true, true>(F.lds + RING_OFF, g, S, E, F.wave);
#endif
        if (BOTH(4)) GROUP_BAR(); }
    if (IN(5)) {
        pg8::Gemm g{(const bf16*)(ws + WS_H), (const bf16*)(ws + WS_W2), T, DM, FF, 0}; pg8::StaticOrder S; S.init(T, DM, F.G, bx);
        pg8::EpiRes E{XB, SS + 2 * T};
        pg8::gemm_phase<pg8::EpiRes, pg8::StaticOrder, true, true>(F.lds + RING_OFF, g, S, E, F.wave);
        if (BOTH(5)) GRID_BAR(); }
    if (IN(6)) {
        pg8::Gemm g{XB, (const bf16*)(ws + WS_WKVQ), T, NKVQ, DM, 0}; pg8::StaticOrder S; S.init(T, NKVQ, F.G, bx);
        pg8::EpiKvq E{(bf16*)(ws + WS_KVQ), KVQ_TSTRIDE, SS + 2 * T};
        pg8::gemm_phase<pg8::EpiKvq, pg8::StaticOrder, true, true>(F.lds + RING_OFF, g, S, E, F.wave);
        if (BOTH(6)) GRID_BAR(); }
    if (IN(7)) {
        const int c = F.vcu, side = (c >> 5) & 1;
        pg8::Gemm g{(const bf16*)(ws + WS_KVQ) + (size_t)side * KVQ_TSTRIDE, (const bf16*)(ws + WS_PW1 + (size_t)side * MiB), PHI_ROWS, 256, 2048, 1}; pg8::PhiOrder S{c};
        pg8::EpiPhi E{(bf16*)(ws + WS_PHIH) + (size_t)side * PHI_ROWS * 256, (const float*)(ws + WS_PHIB) + side * 256};
        pg8::gemm_phase<pg8::EpiPhi, pg8::PhiOrder, false, true>(F.lds + RING_OFF, g, S, E, F.wave);
        if (BOTH(7)) GRID_BAR(); }
    if (IN(8)) { phi2_phase(F, F.vcu * NWAVES + F.wave, F.G * NWAVES, 2 * (PHI_ROWS / 8)); __syncthreads(); vsel_transpose_phase(F, F.vcu * NWAVES + F.wave, F.G * NWAVES); if (BOTH(8)) GRID_BAR(); }
#ifdef TMIN9
    unsigned long long t9_ = 0;
    if (IN(9)) { t9_ = __builtin_amdgcn_s_memrealtime(); }
#endif
    if (IN(9)) { if (F.G == 256) attn_dense_phase(F); else attn_naive_phase(F, (bf16*)(ws + WS_O));
#ifdef TMIN9
        __syncthreads(); if (F.tid == 0) { const unsigned dt = (unsigned)(__builtin_amdgcn_s_memrealtime() - t9_); atomicMax((unsigned*)(ws + WS_CTL) + 20, ~dt); atomicMax((unsigned*)(ws + WS_CTL) + 21, dt); }
#endif
        if (BOTH(9)) GRID_BAR(); }
    if (IN(10)) {
        pg8::Gemm g{(const bf16*)(ws + WS_O), (const bf16*)(ws + WS_WO), T, DM, DM, 0}; pg8::StaticOrder S; S.init(T, DM, F.G, bx);
        pg8::EpiRes E{XB, SS + 3 * T};
        pg8::gemm_phase<pg8::EpiRes, pg8::StaticOrder, true, true>(F.lds + RING_OFF, g, S, E, F.wave);
        if (BOTH(10)) GROUP_BAR(); }
    if (IN(11)) {
        pg8::Gemm g{XB, (const bf16*)(ws + WS_W1 + 8 * MiB), T, FF, DM, 0}; pg8::StaticOrder S; S.init(T, FF, F.G, bx);
        pg8::EpiRelu2 E{(bf16*)(ws + WS_H), FF, SS + 3 * T};
        pg8::gemm_phase<pg8::EpiRelu2, pg8::StaticOrder, true, true>(F.lds + RING_OFF, g, S, E, F.wave);
        if (BOTH(11)) GROUP_BAR(); }
    if (IN(12)) {
        pg8::Gemm g{(const bf16*)(ws + WS_H), (const bf16*)(ws + WS_W2 + 8 * MiB), T, DM, FF, 0}; pg8::StaticOrder S; S.init(T, DM, F.G, bx);
        pg8::EpiRes E{XB, SS + 4 * T};
        pg8::gemm_phase<pg8::EpiRes, pg8::StaticOrder, true, true>(F.lds + RING_OFF, g, S, E, F.wave);
        if (BOTH(12)) GROUP_BAR(); }
    if (IN(13)) { final_norm_phase(F);
    }
    if (TIMB >= 0) { const unsigned mn = ~((const unsigned*)(ws + WS_CTL))[24], mx = ((const unsigned*)(ws + WS_CTL))[25]; const unsigned long long tb_ = __builtin_amdgcn_s_memrealtime(); while (__builtin_amdgcn_s_memrealtime() - tb_ < (unsigned long long)(mx - mn)) __builtin_amdgcn_s_sleep(4); }
#ifdef TMIN9
    { const unsigned mn = ~((const unsigned*)(ws + WS_CTL))[20]; const unsigned long long tb_ = __builtin_amdgcn_s_memrealtime(); while (__builtin_amdgcn_s_memrealtime() - tb_ < (unsigned long long)mn) __builtin_amdgcn_s_sleep(4); }
#endif
#ifdef TBAR
    { const unsigned long long tb_ = __builtin_amdgcn_s_memrealtime(); while (__builtin_amdgcn_s_memrealtime() - tb_ < tbar_acc) __builtin_amdgcn_s_sleep(4); }
#endif
    if (TPH_MASK) { TPH_MARK(14); const unsigned long long tb_ = __builtin_amdgcn_s_memrealtime(); while (__builtin_amdgcn_s_memrealtime() - tb_ < tph_acc) __builtin_amdgcn_s_sleep(4); }
#undef IN
#undef BOTH
}

extern "C" void kernel_launch(void* const* d_in, const int* in_sizes, int n_in, void* d_out, int out_size, void* d_ws, size_t ws_size, hipStream_t stream) {
    static int grid = 0;
    if (grid == 0) {
        if (n_in != 20 || in_sizes[0] != T * DM || out_size != T * DM || ws_size < WS_END) { fprintf(stderr, "kernel_launch: unexpected shapes (n_in %d, in0 %d, out %d, ws %zu)\n", n_in, n_in > 0 ? in_sizes[0] : -1, out_size, ws_size); grid = -1; return; }
        int dev = 0, cus = 0, per_cu = 0;
        if (hipGetDevice(&dev) != hipSuccess || hipDeviceGetAttribute(&cus, hipDeviceAttributeMultiprocessorCount, dev) != hipSuccess) { grid = -1; return; }
        if (hipFuncSetAttribute((const void*)nsa_fwd, hipFuncAttributeMaxDynamicSharedMemorySize, LDS_BYTES) != hipSuccess) { fprintf(stderr, "kernel_launch: hipFuncSetAttribute failed\n"); grid = -1; return; }
        if (hipOccupancyMaxActiveBlocksPerMultiprocessor(&per_cu, (const void*)nsa_fwd, NWAVES * 64, LDS_BYTES) != hipSuccess || per_cu < 1) fprintf(stderr, "kernel_launch: occupancy query reports %d\n", per_cu);
        (void)hipGetLastError();
        grid = cus;
        if (grid != 256) fprintf(stderr, "kernel_launch: %d CUs (built for 256)\n", grid);
    }
    if (grid < 0) return;
    if (hipMemsetAsync((char*)d_ws + WS_CTL, 0, CTL_ZERO_BYTES, stream) != hipSuccess) return;
    Args a{};
    for (int i = 0; i < 20; ++i) a.in[i] = (const float*)d_in[i];
    a.out = (float*)d_out; a.ws = (unsigned char*)d_ws;
#if MK_PER_PHASE
    for (int p = 0; p < N_PHASES; ++p) { a.ph_lo = p; a.ph_hi = p + 1; a.li = p; hipLaunchKernelGGL(nsa_fwd, dim3(grid), dim3(NWAVES * 64), LDS_BYTES, stream, a); }
#else
    a.ph_lo = 0; a.ph_hi = N_PHASES; a.li = 0;
    hipLaunchKernelGGL(nsa_fwd, dim3(grid), dim3(NWAVES * 64), LDS_BYTES, stream, a);
#endif
}
```

```cpp
#include <hip/hip_runtime.h>
#include <cstdio>
#include <cstdint>
__device__ __forceinline__ int fresh_lane() { int l; asm volatile("v_mbcnt_lo_u32_b32 %0, -1, 0\n\tv_mbcnt_hi_u32_b32 %0, -1, %0" : "=v"(l)); return l; }
namespace pg8 {
#define PG8_LAS __attribute__((address_space(3)))
typedef unsigned short bf16_t;
typedef short bf16x8 __attribute__((ext_vector_type(8)));
typedef float f32x4 __attribute__((ext_vector_type(4)));
typedef unsigned u32x4 __attribute__((ext_vector_type(4)));
constexpr int BM = 256, BK = 64, HALF = 128, HTB = HALF * BK * 2  , STAGE_BYTES = 8 * HTB, NXCD = 8, WGM = 8;

__host__ __device__ __forceinline__ int lds_byte(int r, int c) { const int st = (r >> 4) * 2 + (c >> 5), rr = r & 15, cc = c & 31, ob = rr * 64 + cc * 2; return st * 1024 + (ob ^ (((ob >> 9) & 1) << 5)); }
__host__ __device__ __forceinline__ void stage_rc(int b, int& R, int& C) { const int st = b / 1024, sb = b % 1024, swz = sb ^ (((sb >> 9) & 1) << 5); R = (st >> 1) * 16 + swz / 64; C = (st & 1) * 32 + (swz % 64) / 2; }
__host__ __device__ __forceinline__ int perm32(int rho) { const int n = rho >> 4, i = rho & 15; return 8 * (i >> 2) + 4 * n + (i & 3); }

struct Unit { int pm, pn; };
struct Gemm { const bf16_t* A; const bf16_t* Bt; int M, N, K; int a_gather; };

struct StaticOrder {
    int nM, nN, nwg, G, c;
    __host__ __device__ void init(int M, int N, int G_, int c_) { nM = M / BM; nN = N / BM; nwg = nM * nN; G = G_; c = c_; }
    __host__ __device__ bool next(int i, Unit& u) const {
        const long L = (long)i * G + c; if (L >= nwg) return false;
        int wgid = (int)L; { const int q = nwg / NXCD, r = nwg % NXCD, xcd = wgid % NXCD, off = wgid / NXCD; wgid = (xcd < r ? xcd * (q + 1) : r * (q + 1) + (xcd - r) * q) + off; }
        const int nig = WGM * nN, gid = wgid / nig, fm = gid * WGM, gsz = (nM - fm) < WGM ? (nM - fm) : WGM;
        u.pm = fm + ((wgid % nig) % gsz); u.pn = (wgid % nig) / gsz; return true;
    }
    __device__ __forceinline__ void a_ready(const Unit&) const {}
    __device__ __forceinline__ void done(const Unit&) const {}
};

__device__ __forceinline__ unsigned cvt_pk_bf16(float lo, float hi) { unsigned r; asm volatile("v_cvt_pk_bf16_f32 %0, %1, %2" : "=v"(r) : "v"(lo), "v"(hi)); return r; }
typedef float f32x2 __attribute__((ext_vector_type(2)));
typedef unsigned u32x2 __attribute__((ext_vector_type(2)));
constexpr float RMS_EPS = 1e-6f;
__device__ __forceinline__ float row_rstd(const float* ss, int r) { return __builtin_amdgcn_rsqf(ss[r] * (1.0f / 1024.0f) + RMS_EPS); }

struct EpiRes {
    static constexpr bool PERM = true, AFTER_DRAIN = false;
    bf16_t* xb; float* ss;
    __device__ __forceinline__ void operator()(const f32x4 (&acc)[2][2][4][2], const Unit& u, int wr, int wc, int fr, int fq) const {
        const int col0 = u.pn * BM + wc * 32 + 8 * fq;
#pragma unroll
        for (int ai = 0; ai < 2; ++ai)
#pragma unroll
            for (int m = 0; m < 4; ++m) { const int r = u.pm * BM + ai * HALF + wr * 64 + m * 16 + fr; bf16_t* rowp = xb + (size_t)r * 1024 + col0; float s = 0.f;
#pragma unroll
                for (int bj = 0; bj < 2; ++bj) { const u32x4 b = *(const u32x4*)(rowp + bj * HALF); const f32x4 a0 = acc[ai][bj][m][0], a1 = acc[ai][bj][m][1];
                    const unsigned w0 = cvt_pk_bf16(__uint_as_float(b.x << 16) + a0[0], __uint_as_float(b.x & 0xffff0000u) + a0[1]), w1 = cvt_pk_bf16(__uint_as_float(b.y << 16) + a0[2], __uint_as_float(b.y & 0xffff0000u) + a0[3]);
                    const unsigned w2 = cvt_pk_bf16(__uint_as_float(b.z << 16) + a1[0], __uint_as_float(b.z & 0xffff0000u) + a1[1]), w3 = cvt_pk_bf16(__uint_as_float(b.w << 16) + a1[2], __uint_as_float(b.w & 0xffff0000u) + a1[3]);
                    u32x4 w; w.x = w0; w.y = w1; w.z = w2; w.w = w3; *(u32x4*)(rowp + bj * HALF) = w;
                    const float e0 = __uint_as_float(w0 << 16), e1 = __uint_as_float(w0 & 0xffff0000u), e2 = __uint_as_float(w1 << 16), e3 = __uint_as_float(w1 & 0xffff0000u);
                    const float e4 = __uint_as_float(w2 << 16), e5 = __uint_as_float(w2 & 0xffff0000u), e6 = __uint_as_float(w3 << 16), e7 = __uint_as_float(w3 & 0xffff0000u);
                    s += ((e0 * e0 + e1 * e1) + (e2 * e2 + e3 * e3)) + ((e4 * e4 + e5 * e5) + (e6 * e6 + e7 * e7)); }
                s += __shfl_xor(s, 16); s += __shfl_xor(s, 32);
                if (fq == 0) atomicAdd(ss + r, s); }
    }
};
struct EpiRelu2 {
    static constexpr bool PERM = true, AFTER_DRAIN = false;
    bf16_t* O; int ldc; const float* ss;
    __device__ __forceinline__ void operator()(const f32x4 (&acc)[2][2][4][2], const Unit& u, int wr, int wc, int fr, int fq) const {
        const int col0 = u.pn * BM + wc * 32 + 8 * fq;
#pragma unroll
        for (int ai = 0; ai < 2; ++ai)
#pragma unroll
            for (int m = 0; m < 4; ++m) { const int r = u.pm * BM + ai * HALF + wr * 64 + m * 16 + fr; const float rs = row_rstd(ss, r), s2 = rs * rs; bf16_t* rowp = O + (size_t)r * ldc + col0;
#pragma unroll
                for (int bj = 0; bj < 2; ++bj) { f32x4 v0 = acc[ai][bj][m][0], v1 = acc[ai][bj][m][1];
#pragma unroll
                    for (int j = 0; j < 4; ++j) { const float a = fmaxf(v0[j], 0.f), b = fmaxf(v1[j], 0.f); v0[j] = a * a * s2; v1[j] = b * b * s2; }
                    u32x4 w; w.x = cvt_pk_bf16(v0[0], v0[1]); w.y = cvt_pk_bf16(v0[2], v0[3]); w.z = cvt_pk_bf16(v1[0], v1[1]); w.w = cvt_pk_bf16(v1[2], v1[3]);
                    *(u32x4*)(rowp + bj * HALF) = w; } }
    }
};
struct EpiWin {
    static constexpr bool PERM = true, AFTER_DRAIN = false;
    bf16_t* BG; bf16_t* V; const float* ss;
    __device__ __forceinline__ void operator()(const f32x4 (&acc)[2][2][4][2], const Unit& u, int wr, int wc, int fr, int fq) const {
#pragma unroll
        for (int ai = 0; ai < 2; ++ai)
#pragma unroll
            for (int m = 0; m < 4; ++m) { const int r = u.pm * BM + ai * HALF + wr * 64 + m * 16 + fr; const float rs = row_rstd(ss, r);
                if (u.pn < 4) { bf16_t* rowp = BG + (size_t)r * 1024 + u.pn * BM + wc * 32 + 8 * fq;
#pragma unroll
                    for (int bj = 0; bj < 2; ++bj) { const f32x4 v0 = acc[ai][bj][m][0] * rs, v1 = acc[ai][bj][m][1] * rs;
                        u32x4 w; w.x = cvt_pk_bf16(v0[0], v0[1]); w.y = cvt_pk_bf16(v0[2], v0[3]); w.z = cvt_pk_bf16(v1[0], v1[1]); w.w = cvt_pk_bf16(v1[2], v1[3]);
                        *(u32x4*)(rowp + bj * HALF) = w; }
                } else { bf16_t* rowp = V + (size_t)r * 1024 + (u.pn - 4) * HALF + wc * 32 + 8 * fq; const float s2 = rs * rs;
                    const f32x4 v0 = acc[ai][0][m][0] * acc[ai][1][m][0] * s2, v1 = acc[ai][0][m][1] * acc[ai][1][m][1] * s2;
                    u32x4 w; w.x = cvt_pk_bf16(v0[0], v0[1]); w.y = cvt_pk_bf16(v0[2], v0[3]); w.z = cvt_pk_bf16(v1[0], v1[1]); w.w = cvt_pk_bf16(v1[2], v1[3]);
                    *(u32x4*)rowp = w; } }
    }
};
struct EpiKvq {
    static constexpr bool PERM = true, AFTER_DRAIN = false;
    bf16_t* O; size_t tstride; const float* ss;
    __device__ __forceinline__ void operator()(const f32x4 (&acc)[2][2][4][2], const Unit& u, int wr, int wc, int fr, int fq) const {
        bf16_t* base = O + (size_t)u.pn * tstride + wc * 32 + 8 * fq; const bool sig = (u.pn == 10);
#pragma unroll
        for (int ai = 0; ai < 2; ++ai)
#pragma unroll
            for (int m = 0; m < 4; ++m) { const int r = u.pm * BM + ai * HALF + wr * 64 + m * 16 + fr; const float rs = row_rstd(ss, r); bf16_t* rowp = base + (size_t)r * 256;
#pragma unroll
                for (int bj = 0; bj < 2; ++bj) { f32x4 v0 = acc[ai][bj][m][0] * rs, v1 = acc[ai][bj][m][1] * rs;
                    if (sig) {
#pragma unroll
                        for (int j = 0; j < 4; ++j) { v0[j] = 1.0f / (1.0f + __expf(-v0[j])); v1[j] = 1.0f / (1.0f + __expf(-v1[j])); } }
                    u32x4 w; w.x = cvt_pk_bf16(v0[0], v0[1]); w.y = cvt_pk_bf16(v0[2], v0[3]); w.z = cvt_pk_bf16(v1[0], v1[1]); w.w = cvt_pk_bf16(v1[2], v1[3]);
                    *(u32x4*)(rowp + bj * HALF) = w; } }
    }
};
struct EpiPhi {
    static constexpr bool PERM = true, AFTER_DRAIN = false;
    bf16_t* O; const float* bias;
    __device__ __forceinline__ void operator()(const f32x4 (&acc)[2][2][4][2], const Unit& u, int wr, int wc, int fr, int fq) const {
        const int col0 = wc * 32 + 8 * fq;
        f32x4 bv[2][2];
#pragma unroll
        for (int bj = 0; bj < 2; ++bj)
#pragma unroll
            for (int n = 0; n < 2; ++n) bv[bj][n] = *(const f32x4*)(bias + col0 + bj * HALF + 4 * n);
#pragma unroll
        for (int ai = 0; ai < 2; ++ai)
#pragma unroll
            for (int m = 0; m < 4; ++m) { const int r = u.pm * BM + ai * HALF + wr * 64 + m * 16 + fr; bf16_t* rowp = O + (size_t)r * 256 + col0;
#pragma unroll
                for (int bj = 0; bj < 2; ++bj) { f32x4 v0 = acc[ai][bj][m][0] + bv[bj][0], v1 = acc[ai][bj][m][1] + bv[bj][1];
#pragma unroll
                    for (int j = 0; j < 4; ++j) { v0[j] = v0[j] / (1.0f + __expf(-v0[j])); v1[j] = v1[j] / (1.0f + __expf(-v1[j])); }
                    u32x4 w; w.x = cvt_pk_bf16(v0[0], v0[1]); w.y = cvt_pk_bf16(v0[2], v0[3]); w.z = cvt_pk_bf16(v1[0], v1[1]); w.w = cvt_pk_bf16(v1[2], v1[3]);
                    *(u32x4*)(rowp + bj * HALF) = w; } }
    }
};
struct PhiOrder {
    int c;
    __device__ __forceinline__ bool next(int i, Unit& u) const { if (i > 0 || c >= 64) return false; u.pm = c & 31; u.pn = 0; return true; }
    __device__ __forceinline__ void a_ready(const Unit&) const {}
    __device__ __forceinline__ void done(const Unit&) const {}
};
struct GatesOrder {
    int c;
    __device__ __forceinline__ bool next(int i, Unit& u) const { if (i > 0 || c < 64 || c >= 192) return false; u.pm = c - 64; u.pn = 10; return true; }
    __device__ __forceinline__ void a_ready(const Unit&) const {}
    __device__ __forceinline__ void done(const Unit&) const {}
};
struct GatesAll {
    int c, G;
    __device__ __forceinline__ bool next(int i, Unit& u) const { const int p = i * G + c; if (p >= 128) return false; u.pm = p; u.pn = 10; return true; }
    __device__ __forceinline__ void a_ready(const Unit&) const {}
    __device__ __forceinline__ void done(const Unit&) const {}
};
template <class Epi, class Sched, bool ALIGN_EPI = false, bool SP2 = false>
__device__ __forceinline__ void gemm_phase(PG8_LAS unsigned char* lds, const Gemm g, const Sched& S, const Epi& E, const int wid  ) {
    const int lane = fresh_lane(), tid = wid * 64 + lane, wr = wid >> 2, wc = wid & 3, fr = lane & 15, fq = lane >> 4;
    const int K = g.K, nt = K / BK;
    unsigned voffA[2], voffB[2];
#pragma unroll
    for (int i = 0; i < 2; ++i) { int R, C; stage_rc(tid * 16 + i * 8192, R, C); const int Rb = Epi::PERM ? ((R & ~31) + perm32(R & 31)) : R;
        voffA[i] = g.a_gather ? (unsigned)((R >> 2) * 8192 + (R & 3) * 128 + C * 2) : (unsigned)(R * K + C) * 2u; voffB[i] = (unsigned)(Rb * K + C) * 2u; }
    const size_t kstep = (size_t)(BK * 2);
    const size_t hstep = (size_t)HALF * K * 2;
    const size_t tstep = 2 * hstep;
    const size_t kstepA = g.a_gather ? (size_t)512 : kstep, hstepA = g.a_gather ? (size_t)262144 : hstep, tstepA = g.a_gather ? (size_t)524288 : tstep;
    const unsigned ldsw = (unsigned)wid * 1024u;
    const int aoff = lds_byte(wr * 64 + fr, fq * 8), boff = lds_byte(wc * 32 + fr, fq * 8);
#define PG8_SA(b, h) (((b) * 2 + (h)) * HTB)
#define PG8_SB(b, h) ((4 + (b) * 2 + (h)) * HTB)
#define PG8_STAGE(bufoff, gbase, voff) do { _Pragma("unroll") for (int _i = 0; _i < 2; ++_i) \
        __builtin_amdgcn_global_load_lds((const unsigned*)((const char*)(gbase) + (voff)[_i]), (PG8_LAS unsigned*)(lds + (bufoff) + ldsw + _i * 8192), 16, 0, 0); } while (0)
#define PG8_LDA(dst, b, h) do { _Pragma("unroll") for (int m = 0; m < 4; ++m) _Pragma("unroll") for (int k = 0; k < 2; ++k) dst[m][k] = *(const PG8_LAS bf16x8*)(lds + PG8_SA(b, h) + aoff + m * 2048 + k * 1024); } while (0)
#define PG8_LDB(dst, b, h) do { _Pragma("unroll") for (int n = 0; n < 2; ++n) _Pragma("unroll") for (int k = 0; k < 2; ++k) dst[n][k] = *(const PG8_LAS bf16x8*)(lds + PG8_SB(b, h) + boff + n * 2048 + k * 1024); } while (0)
#define PG8_MMA(ai, bj, At, Bt) do { __builtin_amdgcn_s_setprio(1); _Pragma("unroll") for (int m = 0; m < 4; ++m) _Pragma("unroll") for (int n = 0; n < 2; ++n) _Pragma("unroll") for (int k = 0; k < 2; ++k) \
        acc[ai][bj][m][n] = __builtin_amdgcn_mfma_f32_16x16x32_bf16(Bt[n][k], At[m][k], acc[ai][bj][m][n], 0, 0, 0); __builtin_amdgcn_s_setprio(0); } while (0)
#define PG8_WAIT_V(n) asm volatile("s_waitcnt vmcnt(" #n ")" ::: "memory")
#define PG8_WAIT_L(n) asm volatile("s_waitcnt lgkmcnt(" #n ")" ::: "memory")
#define PG8_BAR __builtin_amdgcn_s_barrier()
#define PG8_SCHED __builtin_amdgcn_sched_barrier(0)
    Unit cur, nxt; int ui = 0;
    if (!S.next(0, cur)) return;
    f32x4 acc[2][2][4][2];
#pragma unroll
    for (int a = 0; a < 2; ++a)
#pragma unroll
        for (int b = 0; b < 2; ++b)
#pragma unroll
            for (int m = 0; m < 4; ++m)
#pragma unroll
                for (int n = 0; n < 2; ++n) acc[a][b][m][n] = (f32x4){0.f, 0.f, 0.f, 0.f};
    bf16x8 At[4][2], B0[2][2], B1[2][2];
    const char* cA = (const char*)g.A + (size_t)cur.pm * tstepA; const char* cB = (const char*)g.Bt + (size_t)cur.pn * tstep;
    S.a_ready(cur);
    if constexpr (SP2) {
        PG8_STAGE(PG8_SB(0, 0), cB, voffB); PG8_STAGE(PG8_SB(0, 1), cB + hstep, voffB); PG8_STAGE(PG8_SA(0, 0), cA, voffA); PG8_STAGE(PG8_SA(0, 1), cA + hstepA, voffA);
        if (wr == 1) PG8_BAR;
        PG8_WAIT_V(2); PG8_BAR;
        PG8_STAGE(PG8_SB(1, 0), cB + kstep, voffB); PG8_STAGE(PG8_SA(1, 0), cA + kstepA, voffA); PG8_STAGE(PG8_SB(1, 1), cB + hstep + kstep, voffB);
        PG8_WAIT_V(6); PG8_BAR;
    } else {
        PG8_STAGE(PG8_SB(0, 0), cB, voffB); PG8_STAGE(PG8_SA(0, 0), cA, voffA); PG8_STAGE(PG8_SB(0, 1), cB + hstep, voffB); PG8_STAGE(PG8_SA(0, 1), cA + hstepA, voffA);
        if (wr == 1) PG8_BAR;
        PG8_WAIT_V(4); PG8_BAR;
        PG8_STAGE(PG8_SB(1, 0), cB + kstep, voffB); PG8_STAGE(PG8_SA(1, 0), cA + kstepA, voffA); PG8_STAGE(PG8_SB(1, 1), cB + hstep + kstep, voffB);
        PG8_WAIT_V(6); PG8_BAR;
    }
    for (;;) {
        const bool has_next = S.next(ui + 1, nxt);
        const char* nA = has_next ? (const char*)g.A + (size_t)nxt.pm * tstepA : cA; const char* nB = has_next ? (const char*)g.Bt + (size_t)nxt.pn * tstep : cB;
        for (int t = 0; t < nt; t += 2) {
            const bool last = (t == nt - 2);
            const char* a1 = cA + (size_t)(t + 1) * kstepA;
            const char* a2 = last ? nA : cA + (size_t)(t + 2) * kstepA; const char* b2 = last ? nB : cB + (size_t)(t + 2) * kstep;
            const char* a3 = a2 + kstepA; const char* b3 = b2 + kstep;
            if (last && has_next) S.a_ready(nxt);
            if constexpr (SP2) {
            PG8_LDB(B0, 0, 0); PG8_LDB(B1, 0, 1); PG8_SCHED; PG8_LDA(At, 0, 0); PG8_STAGE(PG8_SA(1, 1), a1 + hstepA, voffA);
            PG8_WAIT_V(8); PG8_WAIT_L(0); PG8_BAR; PG8_MMA(0, 0, At, B0); PG8_MMA(0, 1, At, B1); PG8_BAR; PG8_SCHED;
            PG8_LDA(At, 0, 1); PG8_STAGE(PG8_SB(0, 0), b2, voffB); PG8_STAGE(PG8_SB(0, 1), b2 + hstep, voffB); PG8_STAGE(PG8_SA(0, 0), a2, voffA);
            PG8_WAIT_V(8); PG8_WAIT_L(0); PG8_BAR; PG8_MMA(1, 0, At, B0); PG8_MMA(1, 1, At, B1); PG8_BAR; PG8_SCHED;
            PG8_LDB(B0, 1, 0); PG8_LDB(B1, 1, 1); PG8_SCHED; PG8_LDA(At, 1, 0); PG8_STAGE(PG8_SA(0, 1), a2 + hstepA, voffA);
            PG8_WAIT_V(8); PG8_WAIT_L(0); PG8_BAR; PG8_MMA(0, 0, At, B0); PG8_MMA(0, 1, At, B1); PG8_BAR; PG8_SCHED;
            PG8_LDA(At, 1, 1); PG8_STAGE(PG8_SB(1, 0), b3, voffB); PG8_STAGE(PG8_SB(1, 1), b3 + hstep, voffB); PG8_STAGE(PG8_SA(1, 0), a3, voffA);
            PG8_WAIT_V(8); PG8_WAIT_L(0); PG8_BAR; PG8_MMA(1, 0, At, B0); PG8_MMA(1, 1, At, B1); PG8_BAR; PG8_SCHED;
            } else {
            PG8_LDB(B0, 0, 0); PG8_SCHED; PG8_LDA(At, 0, 0); PG8_STAGE(PG8_SA(1, 1), a1 + hstepA, voffA);
            PG8_WAIT_L(8); PG8_BAR; PG8_WAIT_L(0); PG8_MMA(0, 0, At, B0); PG8_BAR; PG8_SCHED;
            PG8_LDB(B1, 0, 1); PG8_STAGE(PG8_SB(0, 0), b2, voffB);
            PG8_BAR; PG8_WAIT_L(0); PG8_MMA(0, 1, At, B1); PG8_BAR;
            PG8_LDA(At, 0, 1); PG8_STAGE(PG8_SA(0, 0), a2, voffA);
            PG8_BAR; PG8_WAIT_L(0); PG8_MMA(1, 0, At, B0); PG8_BAR; PG8_SCHED;
            PG8_STAGE(PG8_SB(0, 1), b2 + hstep, voffB);
            PG8_WAIT_V(6); PG8_BAR; PG8_MMA(1, 1, At, B1); PG8_BAR;
            PG8_LDB(B0, 1, 0); PG8_SCHED; PG8_LDA(At, 1, 0); PG8_STAGE(PG8_SA(0, 1), a2 + hstepA, voffA);
            PG8_WAIT_L(8); PG8_BAR; PG8_WAIT_L(0); PG8_MMA(0, 0, At, B0); PG8_BAR; PG8_SCHED;
            PG8_LDB(B1, 1, 1); PG8_STAGE(PG8_SB(1, 0), b3, voffB);
            PG8_BAR; PG8_WAIT_L(0); PG8_MMA(0, 1, At, B1); PG8_BAR;
            PG8_LDA(At, 1, 1); PG8_STAGE(PG8_SA(1, 0), a3, voffA);
            PG8_BAR; PG8_WAIT_L(0); PG8_MMA(1, 0, At, B0); PG8_BAR; PG8_SCHED;
            PG8_STAGE(PG8_SB(1, 1), b3 + hstep, voffB);
            PG8_WAIT_V(6); PG8_BAR; PG8_MMA(1, 1, At, B1); PG8_BAR;
            }
        }
        if constexpr (ALIGN_EPI) { if (wr == 0) PG8_BAR; }
        if constexpr (!Epi::AFTER_DRAIN) { E(acc, cur, wr, wc, fr, fq); S.done(cur); }
        if (!has_next) break;
#pragma unroll
        for (int a = 0; a < 2; ++a)
#pragma unroll
            for (int b = 0; b < 2; ++b)
#pragma unroll
                for (int m = 0; m < 4; ++m)
#pragma unroll
                    for (int n = 0; n < 2; ++n) acc[a][b][m][n] = (f32x4){0.f, 0.f, 0.f, 0.f};
        cur = nxt; cA = nA; cB = nB; ++ui;
        if constexpr (ALIGN_EPI) { if (wr == 1) PG8_BAR; }
    }
    PG8_WAIT_V(0);
    if constexpr (!ALIGN_EPI) { if (wr == 0) PG8_BAR; }
    PG8_BAR;
    if constexpr (Epi::AFTER_DRAIN) { E.fused(acc, cur, wr, wc, fr, fq, lds, wid, lane); S.done(cur); }
#undef PG8_SA
#undef PG8_SB
#undef PG8_STAGE
#undef PG8_LDA
#undef PG8_LDB
#undef PG8_MMA
#undef PG8_WAIT_V
#undef PG8_WAIT_L
#undef PG8_BAR
#undef PG8_SCHED
}
}

constexpr int NWAVES = 8;
constexpr int BATCH = 4, SEQ = 8192, DM = 1024, T = BATCH * SEQ, FF = 4096, NH = 16, HD = 64, NG = 4;
constexpr int NKVQ = 2816;
constexpr int PHI_ROWS = 8192;
constexpr size_t MiB = 1u << 20;
constexpr size_t WS_CTL = 0, CTL_ZERO_BYTES = 2 * MiB;
constexpr size_t WS_SS = 1 * MiB;
constexpr size_t WS_PHIB = WS_SS + 5 * 128 * 1024;
constexpr size_t WS_WIN = 2 * MiB, WS_WOUT = 8 * MiB, WS_W1 = 10 * MiB  , WS_W2 = 26 * MiB  , WS_WKVQ = 42 * MiB  , WS_WO = 48 * MiB, WS_PW1 = 50 * MiB  ;
constexpr size_t WS_KCMP = 53 * MiB, WS_VCMP = 54 * MiB;
constexpr size_t WS_PHIH = 56 * MiB;
constexpr size_t WS_XB = 64 * MiB;
constexpr size_t WS_H = 128 * MiB;
constexpr size_t WS_BG = 128 * MiB, WS_V = 192 * MiB;
constexpr size_t WS_KVQ = 128 * MiB, KVQ_TSTRIDE = (size_t)T * 256;
constexpr size_t WS_O = 448 * MiB;
constexpr size_t WS_SELM = 384 * MiB;
constexpr size_t WS_VT = 400 * MiB;
constexpr size_t WS_END = 512 * MiB;
static_assert(WS_KVQ + 11 * KVQ_TSTRIDE * 2 <= WS_H + (size_t)T * FF * 2 && WS_H + (size_t)T * FF * 2 <= 384 * MiB && WS_O + (size_t)T * 1024 * 2 <= WS_END, "ws map");
constexpr int CW_BAR = 4096;
constexpr int RING_OFF = 0, RING_BYTES = 131072;
constexpr int LDS_BYTES = 163840;
constexpr int LDSCTL_OFF = LDS_BYTES - 512, MISC_OFF = LDSCTL_OFF + 320;
#define GAS __attribute__((address_space(1)))
#define LAS __attribute__((address_space(3)))
typedef unsigned short bf16;
typedef unsigned v4u __attribute__((ext_vector_type(4)));
typedef float f32x4 __attribute__((ext_vector_type(4)));
typedef short bf16x8 __attribute__((ext_vector_type(8)));
typedef GAS unsigned gu32;
typedef GAS unsigned long long gu64;
#define RLX_AGENT __ATOMIC_RELAXED, __HIP_MEMORY_SCOPE_AGENT
#define LDS_WAIT() asm volatile("s_waitcnt lgkmcnt(0)" ::: "memory")
#define VM_WAIT() asm volatile("s_waitcnt vmcnt(0)" ::: "memory")
__device__ __forceinline__ unsigned long long rt() { return __builtin_amdgcn_s_memrealtime(); }
__device__ __forceinline__ unsigned f2bf(float f) { unsigned u = __builtin_bit_cast(unsigned, f); return (u + 0x7fffu + ((u >> 16) & 1u)) >> 16; }
__device__ __forceinline__ unsigned pk2(float lo, float hi) { return f2bf(lo) | (f2bf(hi) << 16); }

#define XB_TMO      128
#define XB_XCNT(j)  (256  + 64 * (j))
#define XB_XSUB(j)  (1280 + 64 * (j))
#define XB_XGEN(j)  (2304 + 64 * (j))
#define XB_TOP      3328
#define XB_TOPGEN   3392
#define XCD_BAR_WORDS 3456
#define XB_SPIN_CAP (1u << 18)

__device__ __forceinline__ unsigned xb_ld(unsigned* p)              { return __hip_atomic_load(p, __ATOMIC_RELAXED, __HIP_MEMORY_SCOPE_AGENT); }
__device__ __forceinline__ unsigned xb_add(unsigned* p, unsigned v) { return __hip_atomic_fetch_add(p, v, __ATOMIC_RELAXED, __HIP_MEMORY_SCOPE_AGENT); }
__device__ __forceinline__ unsigned xb_xcc_id() { return (unsigned)__builtin_amdgcn_s_getreg((3 << 11) | 20) & 0xFu; }
#define XB_SPIN(cond, bar) do { unsigned _sp = 0; while (cond) { __builtin_amdgcn_s_sleep(1); \
    if ((++_sp & 255u) == 0u) { if (xb_ld(&(bar)[XB_TMO])) break; if (_sp > XB_SPIN_CAP) { atomicAdd(&(bar)[XB_TMO], 1u); break; } } } } while (0)

struct XcdBarrier {
    unsigned* bar; unsigned x; unsigned G;
    volatile LAS unsigned* st;
};

__device__ __forceinline__ XcdBarrier xcd_barrier_post(unsigned* bar, volatile LAS unsigned* st, bool leader  , unsigned G  ) {
    XcdBarrier b; b.bar = bar; b.x = xb_xcc_id(); b.st = st; b.G = G;
    if (leader) (void)xb_add(&bar[XB_XCNT(b.x)], 1u);
    return b;
}
__device__ __forceinline__ void xcd_barrier_complete(unsigned* bar, unsigned x, unsigned& nloc, unsigned& nx, const unsigned G) {
    unsigned sum, cnt, mine, sp = 0u;
    for (;;) {
        sum = 0u; cnt = 0u; mine = 0u;
#pragma unroll
        for (unsigned j = 0; j < 16; ++j) { const unsigned c = xb_ld(&bar[XB_XCNT(j)]); sum += c; cnt += (c > 0u) ? 1u : 0u; mine = (j == x) ? c : mine; }
        if (sum == G) break;
        __builtin_amdgcn_s_sleep(1);
        if ((++sp & 255u) == 0u) { if (xb_ld(&bar[XB_TMO])) break; if (sp > XB_SPIN_CAP) { atomicAdd(&bar[XB_TMO], 1u); break; } }
    }
    nloc = mine > 0u ? mine : 1u; nx = cnt > 0u ? cnt : 1u;
}

__device__ __forceinline__ void xcd_barrier(const XcdBarrier& b, bool leader  ) {
    asm volatile("s_waitcnt vmcnt(0)" ::: "memory");
    __syncthreads();
    if (leader) {
        unsigned* bar = b.bar;
        __builtin_amdgcn_s_waitcnt(0);
        unsigned nloc = b.st[0], nx = b.st[1];
        if (nloc == 0u) { xcd_barrier_complete(bar, b.x, nloc, nx, b.G); b.st[0] = nloc; b.st[1] = nx; }
        const unsigned old = xb_add(&bar[XB_XSUB(b.x)], 1u);
        const unsigned gen = old / nloc;
        if (old + 1u == (gen + 1u) * nloc) {
            __builtin_amdgcn_fence(__ATOMIC_RELEASE, "agent");
            asm volatile("s_waitcnt vmcnt(0)" ::: "memory");
            const unsigned og = xb_add(&bar[XB_TOP], 1u);
            const unsigned tg = og / nx;
            if (og + 1u == (tg + 1u) * nx) xb_add(&bar[XB_TOPGEN], 1u);
            else XB_SPIN(xb_ld(&bar[XB_TOPGEN]) == tg, bar);
            __builtin_amdgcn_fence(__ATOMIC_ACQUIRE, "agent");
            xb_add(&bar[XB_XGEN(b.x)], 1u);
            asm volatile("s_waitcnt vmcnt(0)" ::: "memory");
        } else {
            XB_SPIN(xb_ld(&bar[XB_XGEN(b.x)]) == gen, bar);
            __builtin_amdgcn_fence(__ATOMIC_ACQUIRE, "agent");
            asm volatile("s_waitcnt vmcnt(0)" ::: "memory");
        }
    }
    __syncthreads();
}

struct Frame {
    LAS unsigned char* lds;
    volatile LAS unsigned* MISC;
    gu32* ctl;
    int tid, lane, wave;
    int vcu, G;
    const float* const* in;
    float* out; unsigned char* ws;
};
__device__ __forceinline__ float wave_sum(float v) {
#pragma unroll
    for (int o = 1; o < 64; o <<= 1) v += __shfl_xor(v, o);
    return v;
}
__device__ __forceinline__ float wave_max(float v) {
#pragma unroll
    for (int o = 1; o < 64; o <<= 1) v = fmaxf(v, __shfl_xor(v, o));
    return v;
}
__device__ __forceinline__ float bf2f(unsigned short b) { return __uint_as_float(((unsigned)b) << 16); }
__device__ __forceinline__ float bflo(unsigned w) { return __uint_as_float(w << 16); }
__device__ __forceinline__ float bfhi(unsigned w) { return __uint_as_float(w & 0xffff0000u); }

__device__ __forceinline__ void p0_transpose_item(const float* W, int ldw, int nvalid, const float* gain, float scale, bf16* WT, int K, int drow, int k0, int n0, LAS float* scr, int lane) {
    float wv[32];
#pragma unroll
    for (int i = 0; i < 32; ++i) { const int kk = 2 * i + (lane >> 5), n = n0 + (lane & 31); wv[i] = (n < nvalid) ? W[(size_t)(k0 + kk) * ldw + n] : 0.f; }
#pragma unroll
    for (int i = 0; i < 32; ++i) { const int kk = 2 * i + (lane >> 5); float v = wv[i]; if (gain) v *= gain[k0 + kk]; scr[kk * 33 + (lane & 31)] = v * scale; }
    LDS_WAIT(); asm volatile("" ::: "memory");
    const int c = lane & 7;
#pragma unroll
    for (int j = 0; j < 4; ++j) { const int n = (lane >> 3) + 8 * j; const LAS float* s = scr + (8 * c) * 33 + n;
        v4u o; o.x = pk2(s[0 * 33], s[1 * 33]); o.y = pk2(s[2 * 33], s[3 * 33]); o.z = pk2(s[4 * 33], s[5 * 33]); o.w = pk2(s[6 * 33], s[7 * 33]);
        *(GAS v4u*)(WT + (size_t)(drow + n) * K + k0 + 8 * c) = o; }
    LDS_WAIT(); asm volatile("" ::: "memory");
}
struct MatSpec { const float* W; int K, ldw, nvalid, niter; const float* gain; bf16* WT; int kind; };
__device__ __forceinline__ void p0_matrix_item(const MatSpec& m, int item, LAS float* scr, int lane) {
    const int nblk = m.niter / 32, kb = item / nblk, nb = item % nblk, k0 = 64 * kb, n0 = 32 * nb;
    int drow = n0; float scale = 1.f;
    if (m.kind == 1) { if (n0 >= 1024) { const int isu = n0 >= 2048, j = n0 - (isu ? 2048 : 1024); drow = 1024 + (j >> 7) * 256 + isu * 128 + (j & 127); } }
    else if (m.kind == 2) { if (n0 < 1024) { drow = 1536 + n0; scale = 0.125f; } else drow = 2560 + (n0 - 1024); }
    p0_transpose_item(m.W, m.ldw, m.nvalid, m.gain, scale, m.WT, m.K, drow, k0, n0, scr, lane);
}
__device__ __forceinline__ void p0_prologue(Frame& F) {
    LAS float* scr = (LAS float*)(F.lds + RING_OFF + F.wave * 16384);
    const int gw = F.vcu * NWAVES + F.wave, NGW = F.G * NWAVES;
    unsigned char* ws = F.ws;
    int it = gw;
#define DO_MAT(...) do { const MatSpec m_ = MatSpec{__VA_ARGS__}; const int n_ = (m_.K / 64) * (m_.niter / 32); _Pragma("unroll 1") for (; it < n_; it += NGW) p0_matrix_item(m_, it, scr, F.lane); it -= n_; } while (0)
    DO_MAT(F.in[6],  1024, 3072, 3072, 3072, F.in[2],           (bf16*)(ws + WS_WIN), 1);
    DO_MAT(F.in[8],  1024, 1024, 1024, 1024, nullptr,           (bf16*)(ws + WS_WOUT), 0);
    DO_MAT(F.in[4],  1024, 4096, 4096, 4096, F.in[3],           (bf16*)(ws + WS_W1), 0);
    DO_MAT(F.in[4] + (size_t)1024 * 4096, 1024, 4096, 4096, 4096, F.in[3] + 1024, (bf16*)(ws + WS_W1 + 8 * MiB), 0);
    DO_MAT(F.in[5],  4096, 1024, 1024, 1024, nullptr,           (bf16*)(ws + WS_W2), 0);
    DO_MAT(F.in[5] + (size_t)4096 * 1024, 4096, 1024, 1024, 1024, nullptr, (bf16*)(ws + WS_W2 + 8 * MiB), 0);
    DO_MAT(F.in[10], 1024, 1536, 1536, 1536, F.in[9],           (bf16*)(ws + WS_WKVQ), 0);
    DO_MAT(F.in[17], 1024, 1072, 1072, 1280, F.in[2] + 1024,    (bf16*)(ws + WS_WKVQ), 2);
    DO_MAT(F.in[18], 1024, 1024, 1024, 1024, nullptr,           (bf16*)(ws + WS_WO), 0);
    DO_MAT(F.in[13], 2048, 256, 256, 256, nullptr,              (bf16*)(ws + WS_PW1), 0);
    DO_MAT(F.in[15], 2048, 256, 256, 256, nullptr,              (bf16*)(ws + WS_PW1 + 1 * MiB), 0);
#undef DO_MAT
    { bf16* XB = (bf16*)(ws + WS_XB); float* ss0 = (float*)(ws + WS_SS);
      for (int m = gw; m < T; m += 2 * NGW) { const int m2 = m + NGW;
          const GAS f32x4* xr = (const GAS f32x4*)(F.in[0] + (size_t)m * DM) + F.lane; const GAS f32x4* xr2 = (const GAS f32x4*)(F.in[0] + (size_t)m2 * DM) + F.lane;
          GAS unsigned long long* o8 = (GAS unsigned long long*)(XB + (size_t)m * DM) + F.lane; GAS unsigned long long* o82 = (GAS unsigned long long*)(XB + (size_t)m2 * DM) + F.lane;
          f32x4 va[4], vb[4];
#pragma unroll
          for (int j = 0; j < 4; ++j) { va[j] = xr[64 * j]; vb[j] = xr2[64 * j]; }
          float s = 0.f, s2 = 0.f;
#pragma unroll
          for (int j = 0; j < 4; ++j) { const f32x4 v = va[j], w = vb[j];
              const unsigned long long pa = (unsigned long long)pk2(v.x, v.y) | ((unsigned long long)pk2(v.z, v.w) << 32), pb = (unsigned long long)pk2(w.x, w.y) | ((unsigned long long)pk2(w.z, w.w) << 32);
              o8[64 * j] = pa; o82[64 * j] = pb;
              const float a0 = bflo((unsigned)pa), a1 = bfhi((unsigned)pa), a2 = bflo((unsigned)(pa >> 32)), a3 = bfhi((unsigned)(pa >> 32)); s += (a0 * a0 + a1 * a1) + (a2 * a2 + a3 * a3);
              const float b0 = bflo((unsigned)pb), b1 = bfhi((unsigned)pb), b2 = bflo((unsigned)(pb >> 32)), b3 = bfhi((unsigned)(pb >> 32)); s2 += (b0 * b0 + b1 * b1) + (b2 * b2 + b3 * b3); }
          s = wave_sum(s); s2 = wave_sum(s2); if (F.lane == 0) { ss0[m] = s; ss0[m2] = s2; } } }
    { float* pb = (float*)(ws + WS_PHIB);
      for (int task = gw; task < 2 * 32 * 4; task += NGW) { const int side = task >> 7, kc = (task >> 2) & 31, cc = task & 3; const float* pe = F.in[side ? 12 : 11]; const float* w1 = F.in[side ? 15 : 13]; float a = 0.f;
          for (int kk = kc * 64; kk < kc * 64 + 64; ++kk) a += pe[kk] * w1[(size_t)kk * 256 + cc * 64 + F.lane];
          atomicAdd(pb + side * 256 + cc * 64 + F.lane, a); } }
}
__device__ __forceinline__ void conv_gate_phase(Frame& F) {
    bf16* BG = (bf16*)(F.ws + WS_BG); const bf16* V = (const bf16*)(F.ws + WS_V); const float* cw = F.in[7];
    const bool grp = (F.G == 256); const int rbase = grp ? (F.vcu >> 5) * 4096 * 128 : 0, nit = grp ? 4096 * 128 : T * 128;
    const int gt = (grp ? (F.vcu & 31) : F.vcu) * (NWAVES * 64) + F.tid, NGT = (grp ? 32 : F.G) * NWAVES * 64;
    const int c0 = (gt & 127) * 8;
    float w0[8], w1[8], w2[8];
#pragma unroll
    for (int j = 0; j < 8; ++j) { w0[j] = cw[c0 + j]; w1[j] = cw[1024 + c0 + j]; w2[j] = cw[2048 + c0 + j]; }
    const v4u z = {0u, 0u, 0u, 0u};
    for (int it = gt; it < nit; it += 2 * NGT) { const int rowa = (rbase + it) >> 7, rowb = (rbase + it + NGT) >> 7, ta = rowa & (SEQ - 1), tb = rowb & (SEQ - 1);
        const v4u a2 = *(const v4u*)(V + (size_t)rowa * 1024 + c0), a1 = ta >= 1 ? *(const v4u*)(V + (size_t)(rowa - 1) * 1024 + c0) : z, a0 = ta >= 2 ? *(const v4u*)(V + (size_t)(rowa - 2) * 1024 + c0) : z, ba = *(const v4u*)(BG + (size_t)rowa * 1024 + c0);
        const v4u b2 = *(const v4u*)(V + (size_t)rowb * 1024 + c0), b1 = tb >= 1 ? *(const v4u*)(V + (size_t)(rowb - 1) * 1024 + c0) : z, b0 = tb >= 2 ? *(const v4u*)(V + (size_t)(rowb - 2) * 1024 + c0) : z, bb = *(const v4u*)(BG + (size_t)rowb * 1024 + c0);
        v4u oa, ob;
#pragma unroll
        for (int j = 0; j < 4; ++j) {
            oa[j] = pk2(bflo(ba[j]) * (w0[2 * j] * bflo(a0[j]) + w1[2 * j] * bflo(a1[j]) + w2[2 * j] * bflo(a2[j])), bfhi(ba[j]) * (w0[2 * j + 1] * bfhi(a0[j]) + w1[2 * j + 1] * bfhi(a1[j]) + w2[2 * j + 1] * bfhi(a2[j])));
            ob[j] = pk2(bflo(bb[j]) * (w0[2 * j] * bflo(b0[j]) + w1[2 * j] * bflo(b1[j]) + w2[2 * j] * bflo(b2[j])), bfhi(bb[j]) * (w0[2 * j + 1] * bfhi(b0[j]) + w1[2 * j + 1] * bfhi(b1[j]) + w2[2 * j + 1] * bfhi(b2[j]))); }
        *(v4u*)(BG + (size_t)rowa * 1024 + c0) = oa; *(v4u*)(BG + (size_t)rowb * 1024 + c0) = ob; }
}
__device__ __forceinline__ void phi2_phase(Frame& F, int task0, int tstep, int tend) {
    LAS float* hs = (LAS float*)(F.lds + RING_OFF + F.wave * 8192);
    for (int task = task0; task < tend; task += tstep) { const int side = task / (PHI_ROWS / 8), r0 = (task % (PHI_ROWS / 8)) * 8;
        const bf16* H = (const bf16*)(F.ws + WS_PHIH) + (size_t)side * PHI_ROWS * 256 + (size_t)r0 * 256; const float* w2 = F.in[side ? 16 : 14];
#pragma unroll
        for (int j = 0; j < 4; ++j) { const v4u w = *(const v4u*)(H + F.lane * 32 + j * 8);
#pragma unroll
            for (int q = 0; q < 4; ++q) { hs[F.lane * 32 + j * 8 + 2 * q] = bflo(w[q]); hs[F.lane * 32 + j * 8 + 2 * q + 1] = bfhi(w[q]); } }
        LDS_WAIT(); asm volatile("" ::: "memory");
        float acc[8] = {0.f, 0.f, 0.f, 0.f, 0.f, 0.f, 0.f, 0.f};
        for (int c = 0; c < 256; c += 4) { const float wa = w2[(c + 0) * 64 + F.lane], wb = w2[(c + 1) * 64 + F.lane], wc = w2[(c + 2) * 64 + F.lane], wd = w2[(c + 3) * 64 + F.lane];
#pragma unroll
            for (int i = 0; i < 8; ++i) { const f32x4 h = *(const LAS f32x4*)(hs + i * 256 + c); acc[i] += h.x * wa + h.y * wb + h.z * wc + h.w * wd; } }
        bf16* O = (bf16*)(F.ws + (side ? WS_VCMP : WS_KCMP));
#pragma unroll
        for (int i = 0; i < 8; ++i) O[(size_t)(r0 + i) * 64 + F.lane] = (bf16)f2bf(acc[i]);
        LDS_WAIT(); asm volatile("" ::: "memory"); }
}
__device__ __forceinline__ void vsel_transpose_phase(Frame& F, int task0, int tstep) {
    LAS unsigned short* ts = (LAS unsigned short*)(F.lds + RING_OFF + F.wave * 16384);
    const int lane = F.lane;
    const bf16* VSEL = (const bf16*)(F.ws + WS_KVQ) + 3 * KVQ_TSTRIDE; bf16* VT = (bf16*)(F.ws + WS_VT);
    const int key = lane, s = key >> 5, k5 = key & 31, e = ((k5 >> 4) << 2) | (k5 & 3), q4 = (k5 >> 2) & 3, slot = 32 * s + 8 * q4 + e;
    for (int task = task0; task < BATCH * NG * 128; task += tstep) { const int blk = task & 127, g = (task >> 7) & 3, b = task >> 9;
        const v4u* src = (const v4u*)(VSEL + ((size_t)b * SEQ + 64 * blk + key) * 256 + g * 64);
#pragma unroll
        for (int c = 0; c < 8; ++c) { const v4u w = src[c];
#pragma unroll
            for (int q = 0; q < 4; ++q) { ts[(8 * c + 2 * q) * 72 + slot] = (unsigned short)(w[q] & 0xffffu); ts[(8 * c + 2 * q + 1) * 72 + slot] = (unsigned short)(w[q] >> 16); } }
        LDS_WAIT(); asm volatile("" ::: "memory");
        v4u* dst = (v4u*)(VT + (size_t)task * 4096 + lane * 64);
#pragma unroll
        for (int c = 0; c < 8; ++c) dst[c] = *(const LAS v4u*)(ts + lane * 72 + 8 * c);
        LDS_WAIT(); asm volatile("" ::: "memory"); }
}
__device__ __forceinline__ void final_norm_phase(Frame& F) {
    const bool grp = (F.G == 256); const int mbase = grp ? (F.vcu >> 5) * 4096 : 0, mend = grp ? mbase + 4096 : T;
    const int gw = mbase + (grp ? (F.vcu & 31) : F.vcu) * NWAVES + F.wave, NGW = (grp ? 32 : F.G) * NWAVES; const float* ss = (const float*)(F.ws + WS_SS) + 4 * T; const float* gn = F.in[19]; const bf16* XB = (const bf16*)(F.ws + WS_XB);
    f32x4 g4[4];
#pragma unroll
    for (int j = 0; j < 4; ++j) g4[j] = *((const f32x4*)gn + F.lane + 64 * j);
    for (int m = gw; m < mend; m += 2 * NGW) { const int m2 = m + NGW;
        GAS f32x4* xr = (GAS f32x4*)(F.out + (size_t)m * DM) + F.lane; GAS f32x4* xr2 = (GAS f32x4*)(F.out + (size_t)m2 * DM) + F.lane;
        const GAS unsigned long long* xs = (const GAS unsigned long long*)(XB + (size_t)m * DM) + F.lane; const GAS unsigned long long* xs2 = (const GAS unsigned long long*)(XB + (size_t)m2 * DM) + F.lane;
        unsigned long long wa[4], wb[4];
#pragma unroll
        for (int j = 0; j < 4; ++j) { wa[j] = xs[64 * j]; wb[j] = xs2[64 * j]; }
        const float rs = __builtin_amdgcn_rsqf(ss[m] * (1.0f / 1024.0f) + 1e-6f), rs2 = __builtin_amdgcn_rsqf(ss[m2] * (1.0f / 1024.0f) + 1e-6f);
#pragma unroll
        for (int j = 0; j < 4; ++j) { f32x4 v = (f32x4){bflo((unsigned)wa[j]), bfhi((unsigned)wa[j]), bflo((unsigned)(wa[j] >> 32)), bfhi((unsigned)(wa[j] >> 32))}; xr[64 * j] = v * rs * g4[j];
            f32x4 w = (f32x4){bflo((unsigned)wb[j]), bfhi((unsigned)wb[j]), bflo((unsigned)(wb[j] >> 32)), bfhi((unsigned)(wb[j] >> 32))}; xr2[64 * j] = w * rs2 * g4[j]; } }
}

__device__ __forceinline__ int t5_bucket_dev(int d) {
    if (d < 16) return d;
    int b = 16;
    b += (d >= 19); b += (d >= 21); b += (d >= 24); b += (d >= 27); b += (d >= 31); b += (d >= 35); b += (d >= 40); b += (d >= 46);
    b += (d >= 52); b += (d >= 59); b += (d >= 67); b += (d >= 77); b += (d >= 87); b += (d >= 99); b += (d >= 113);
    return b;
}
__device__ __forceinline__ void build_bias_table(Frame& F, LAS float* BT) {
    for (int i = F.tid; i < 128 * 16; i += NWAVES * 64) BT[i] = F.in[1][t5_bucket_dev(i >> 4) * 16 + (i & 15)];
}
__device__ __forceinline__ void attn_naive_phase(Frame& F, bf16* O) {
    LAS float* BT = (LAS float*)(F.lds + RING_OFF);
    LAS float* qs = (LAS float*)(F.lds + RING_OFF + 8192 + F.wave * 4096);
    LAS float* imp = qs + 256;
    LAS int* selb = (LAS int*)(imp + 512);
    LAS float* MC = (LAS float*)(selb + 16);
    LAS float* LG = (LAS float*)(F.lds + RING_OFF + 8192 + 8 * 4096 + F.wave * 8192);
    build_bias_table(F, BT);
    __syncthreads();
    const bf16* KVQ = (const bf16*)(F.ws + WS_KVQ);
    const bf16* GATES = KVQ + 10 * KVQ_TSTRIDE; const bf16* KCMP = (const bf16*)(F.ws + WS_KCMP); const bf16* VCMP = (const bf16*)(F.ws + WS_VCMP);
    const int gw = F.vcu * NWAVES + F.wave, NGW = F.G * NWAVES, lane0 = F.lane;
#pragma unroll 1
    for (int task = gw; task < T * NG; task += NGW) {
        int lane = lane0; asm volatile("" : "+v"(lane));
        const int row = task >> 2, g = task & 3, b = row >> 13, pos = row & (SEQ - 1);
        { const bf16* qp = KVQ + (size_t)(6 + g) * KVQ_TSTRIDE + (size_t)row * 256 + lane * 4; const unsigned long long w = *(const unsigned long long*)qp;
          qs[lane * 4 + 0] = bflo((unsigned)w); qs[lane * 4 + 1] = bfhi((unsigned)w); qs[lane * 4 + 2] = bflo((unsigned)(w >> 32)); qs[lane * 4 + 3] = bfhi((unsigned)(w >> 32)); }
        LDS_WAIT(); asm volatile("" ::: "memory");
        const int nv = pos >= 31 ? ((pos - 31) >> 4) + 1 : 0;
        float oacc[4] = {0.f, 0.f, 0.f, 0.f};
#pragma unroll 1
        for (int br = 0; br < 3; ++br) {
            const bf16* Kt = br == 0 ? KCMP : KVQ + (size_t)(br == 1 ? 2 : 4) * KVQ_TSTRIDE; const bf16* Vt = br == 0 ? VCMP : KVQ + (size_t)(br == 1 ? 3 : 5) * KVQ_TSTRIDE;
            const int nc = br == 0 ? (nv + 63) >> 6 : (br == 1 ? 16 : 8);
            float m[4] = {-1e30f, -1e30f, -1e30f, -1e30f}, Z[4] = {0.f, 0.f, 0.f, 0.f}, o[4] = {0.f, 0.f, 0.f, 0.f};
#pragma unroll 1
            for (int c = 0; c < nc; ++c) { asm volatile("" ::: "memory");
                int ridx, dist; bool valid;
                if (br == 0) { const int n = c * 64 + lane; ridx = b * 512 + n; dist = pos - 16 * n - 31; valid = n < nv; }
                else if (br == 1) { const int bk = selb[c]; const int tok = bk * 64 + lane; ridx = b * SEQ + tok; dist = pos - tok; valid = (bk >= 0) && dist >= 0; }
                else { const int kp = pos - 511 + c * 64 + lane; ridx = b * SEQ + kp; dist = pos - kp; valid = kp >= 0; }
                const unsigned long long vmask = __ballot(valid);
                if (vmask == 0ull) continue;
                float l[4] = {0.f, 0.f, 0.f, 0.f};
                if (valid) { const v4u* kr = (const v4u*)(Kt + (size_t)ridx * 256 + g * 64);
#pragma unroll 2
                    for (int j = 0; j < 8; ++j) { asm volatile("" ::: "memory"); const v4u w = kr[j]; float f[8];
#pragma unroll
                        for (int q = 0; q < 4; ++q) { f[2 * q] = bflo(w[q]); f[2 * q + 1] = bfhi(w[q]); }
#pragma unroll
                        for (int h = 0; h < 4; ++h) { const f32x4 qa = *(const LAS f32x4*)(qs + h * 64 + 8 * j), qb = *(const LAS f32x4*)(qs + h * 64 + 8 * j + 4);
                            l[h] += (f[0] * qa.x + f[1] * qa.y) + (f[2] * qa.z + f[3] * qa.w) + (f[4] * qb.x + f[5] * qb.y) + (f[6] * qb.z + f[7] * qb.w); } }
                    const int dd = dist < 127 ? dist : 127;
#pragma unroll
                    for (int h = 0; h < 4; ++h) l[h] += BT[dd * 16 + g * 4 + h]; }
                float p[4];
#pragma unroll
                for (int h = 0; h < 4; ++h) { const float lv = valid ? l[h] : -1e30f; const float mn = fmaxf(m[h], wave_max(lv)); const float sc = __expf(m[h] - mn);
                    p[h] = valid ? __expf(lv - mn) : 0.f; Z[h] = Z[h] * sc + wave_sum(p[h]); o[h] *= sc; m[h] = mn; }
                if (br == 0) {
#pragma unroll
                    for (int h = 0; h < 4; ++h) { LG[h * 512 + c * 64 + lane] = p[h]; if (lane == 0) MC[c * 4 + h] = m[h]; } }
                unsigned long long vm = vmask;
                while (vm) { const int ll = __builtin_ctzll(vm); vm &= vm - 1ull;
                    const int r = __builtin_amdgcn_readlane(ridx, ll); const float v = bf2f(Vt[(size_t)r * 256 + g * 64 + lane]);
#pragma unroll
                    for (int h = 0; h < 4; ++h) o[h] += __uint_as_float(__builtin_amdgcn_readlane(__float_as_uint(p[h]), ll)) * v; } }
            { const bf16* gp = GATES + (size_t)row * 256 + g * 12 + br;
#pragma unroll
              for (int h = 0; h < 4; ++h) { const float zi = Z[h] > 0.f ? 1.0f / Z[h] : 0.f; Z[h] = zi; oacc[h] += bf2f(gp[h * 3]) * o[h] * zi; } }
            if (br == 0) {
                LDS_WAIT(); asm volatile("" ::: "memory");
#pragma unroll 1
                for (int c = 0; c < 8; ++c) { const int n = c * 64 + lane; float s = 0.f;
                    if (c < nc) {
#pragma unroll
                        for (int h = 0; h < 4; ++h) s += LG[h * 512 + n] * __expf(MC[c * 4 + h] - m[h]) * Z[h]; }
                    imp[n] = s; }
                LDS_WAIT(); asm volatile("" ::: "memory");
                unsigned khi[2], klo[2]; const int cb = pos >> 6;
#pragma unroll
                for (int k = 0; k < 2; ++k) { const int j = lane + 64 * k; float s = 2.0f * (imp[4 * j] + imp[4 * j + 1] + imp[4 * j + 2]) + imp[4 * j + 3]; if (j > 0) s += imp[4 * j - 1];
                    const bool forced = (j == 0) || (j == cb) || (j == cb - 1), future = j > cb; const float sc = forced ? 1e9f : s;
                    khi[k] = future ? 0u : (__float_as_uint(sc) + 1u); klo[k] = 128u - (unsigned)j; }
                LDS_WAIT(); asm volatile("" ::: "memory");
#pragma unroll 1
                for (int i = 0; i < 16; ++i) { unsigned h, l; const bool first = (khi[0] > khi[1]) || (khi[0] == khi[1] && klo[0] > klo[1]); h = first ? khi[0] : khi[1]; l = first ? klo[0] : klo[1];
#pragma unroll
                    for (int off = 1; off < 64; off <<= 1) { const unsigned oh = __shfl_xor(h, off), ol = __shfl_xor(l, off); if (oh > h || (oh == h && ol > l)) { h = oh; l = ol; } }
                    h = __builtin_amdgcn_readfirstlane(h); l = __builtin_amdgcn_readfirstlane(l);
                    if (lane == 0) selb[i] = (h != 0u) ? 128 - (int)l : -1;
#pragma unroll
                    for (int k = 0; k < 2; ++k) if (klo[k] == l) { khi[k] = 0u; klo[k] = 0u; } }
                LDS_WAIT(); asm volatile("" ::: "memory");
            }
        }
#pragma unroll
        for (int h = 0; h < 4; ++h) O[(size_t)row * 1024 + (g * 4 + h) * 64 + lane] = (bf16)f2bf(oacc[h]);
    }
}

namespace nsa {
typedef float f32x16 __attribute__((ext_vector_type(16)));
typedef short s16x4 __attribute__((ext_vector_type(4)));
typedef short v4i16_t __attribute__((ext_vector_type(4)));
constexpr float LOG2E = 1.4426950408889634f, MASKV = -3.0e30f, MINIT = -1.0e30f;
constexpr int KSTR = 144, VSTR = 136, KVBUF = 64 * KSTR + 64 * VSTR;
constexpr int L_KV = 0, L_SC = 35840, L_TB = 72704, L_WSF = L_TB + 8320, L_SELM = L_WSF + 2048, L_NMREF = L_SELM + 1024, L_GS = L_NMREF + 1024, L_FLAG = L_GS + 1024, L_QS = L_FLAG + 128, QS_STR = 144, L_PO = L_QS + 256 * QS_STR, L_G2 = L_PO + 256 * 128, L_LSD = L_G2 + 2048, L_END = L_LSD + 1024;
constexpr int SG = 2, ST_RSTR = 136, ST_LVAL = 256 * ST_RSTR, ST_TAGS = ST_LVAL + 1024, L_ST = 0, STBUF = ST_TAGS + 64;
constexpr int L_ZERO = 2 * STBUF;
static_assert(L_SC + 64 * 128 * 4 <= L_TB && L_ZERO + 4 * ST_RSTR + 16 <= L_TB && L_ZERO % 16 == 0 && (4 * ST_RSTR) % 16 == 0 && L_END <= 163328, "attention LDS map");
constexpr int LSTR = 400;
constexpr int TBN = 130;
__device__ __forceinline__ int crow(int r, int hi) { return (r & 3) + 8 * (r >> 2) + 4 * hi; }
__device__ __forceinline__ float swap_other(float x, int hi) { auto rr = __builtin_amdgcn_permlane32_swap(__float_as_uint(x), __float_as_uint(x), false, false); return hi ? __uint_as_float(rr[0]) : __uint_as_float(rr[1]); }
#define NSA_DPP(x, ctrl) __uint_as_float((unsigned)__builtin_amdgcn_update_dpp(0, (int)__float_as_uint(x), ctrl, 0xF, 0xF, true))
#define NSA_DPPU(x, ctrl) ((unsigned)__builtin_amdgcn_update_dpp(0, (int)(x), ctrl, 0xF, 0xF, true))
__device__ __forceinline__ unsigned cvtpk(float lo, float hi) { typedef float f2 __attribute__((ext_vector_type(2))); typedef __bf16 b2 __attribute__((ext_vector_type(2))); f2 v = {lo, hi}; b2 b = __builtin_convertvector(v, b2); return __builtin_bit_cast(unsigned, b); }

struct TileRegs { v4u k, v; };
__device__ __forceinline__ void tile_load(TileRegs& R, const bf16* Kt, const bf16* Vt, long row0, long rowmax, int tid) {
    long r = row0 + (tid >> 3); r = r < 0 ? 0 : (r > rowmax ? rowmax : r);
    R.k = *(const v4u*)(Kt + r * 256 + (tid & 7) * 8); R.v = *(const v4u*)(Vt + r * 256 + (tid & 7) * 8);
}
__device__ __forceinline__ void tile_store(const TileRegs& R, LAS unsigned char* buf, int tid) {
    *(LAS v4u*)(buf + (tid >> 3) * KSTR + (tid & 7) * 16) = R.k;
    typedef unsigned u2 __attribute__((ext_vector_type(2)));
    LAS unsigned char* vp = buf + 64 * KSTR + (tid >> 3) * VSTR + (tid & 7) * 16;
    *(LAS u2*)vp = (u2){R.v.x, R.v.y}; *(LAS u2*)(vp + 8) = (u2){R.v.z, R.v.w};
}
__device__ __forceinline__ void qkt(f32x16& p0, f32x16& p1, const LAS unsigned char* buf, const LAS unsigned char* qrow  , int r32, int hi) {
    const LAS unsigned char* kb = buf + r32 * KSTR + hi * 16;
    p0 = f32x16{}; p1 = f32x16{};
#pragma unroll
    for (int d0 = 0; d0 < 4; ++d0) { const bf16x8 a0 = *(const LAS bf16x8*)(kb + d0 * 32), a1 = *(const LAS bf16x8*)(kb + 32 * KSTR + d0 * 32), qf = *(const LAS bf16x8*)(qrow + d0 * 32);
        p0 = __builtin_amdgcn_mfma_f32_32x32x16_bf16(a0, qf, p0, 0, 0, 0); p1 = __builtin_amdgcn_mfma_f32_32x32x16_bf16(a1, qf, p1, 0, 0, 0); }
}
__device__ __forceinline__ s16x4 vtr(const LAS unsigned char* p) { return __builtin_bit_cast(s16x4, __builtin_amdgcn_ds_read_tr16_b64_v4i16((LAS v4i16_t*)p)); }
__device__ __forceinline__ void pv(f32x16 (&o)[2], const LAS unsigned char* buf, const unsigned (&pw)[16], int lane) {
    const int hi = lane >> 5; const LAS unsigned char* vb = buf + 64 * KSTR + (((lane & 15) >> 2) + 4 * hi) * VSTR + (lane & 3) * 8 + ((lane >> 4) & 1) * 32;
#pragma unroll
    for (int s = 0; s < 4; ++s) { const bf16x8 pa = __builtin_bit_cast(bf16x8, (v4u){pw[4 * s], pw[4 * s + 1], pw[4 * s + 2], pw[4 * s + 3]});
#pragma unroll
        for (int d0 = 0; d0 < 2; ++d0) { const s16x4 lo = vtr(vb + (16 * s) * VSTR + d0 * 64), hh = vtr(vb + (16 * s + 8) * VSTR + d0 * 64);
            const bf16x8 vf = (bf16x8){lo[0], lo[1], lo[2], lo[3], hh[0], hh[1], hh[2], hh[3]};
            o[d0] = __builtin_amdgcn_mfma_f32_32x32x16_bf16(pa, vf, o[d0], 0, 0, 0); } }
}
__device__ __forceinline__ float rowmax32(const f32x16& p0, const f32x16& p1, int hi) {
    float a = fmaxf(p0[0], p1[0]);
#pragma unroll
    for (int r = 1; r < 16; ++r) a = fmaxf(a, fmaxf(p0[r], p1[r]));
    return fmaxf(a, swap_other(a, hi));
}
template <int MULT, bool FAR>
__device__ __forceinline__ void bias_mask(f32x16& p0, f32x16& p1, int dl, const LAS float* tbl  ) {
#pragma unroll
    for (int r = 0; r < 16; ++r) { const int c = (r & 3) + 8 * (r >> 2);
        const int d0 = dl - MULT * c, d1 = dl - MULT * (c + 32);
        const int i0 = min(max(d0, -1), 128) + 1, i1 = min(max(d1, -1), 128) + 1;
        float b0 = tbl[i0 * 16], b1 = tbl[i1 * 16];
        if (FAR) { if (d0 >= 512) b0 = MASKV; if (d1 >= 512) b1 = MASKV; }
        p0[r] += b0; p1[r] += b1;
        if ((r & 3) == 3) asm volatile("" ::: "memory"); }
}
__device__ __forceinline__ void row_to_regs(float (&fr)[16], float f, LAS float* wsf, int r32, int hi) {
    if (hi == 0) wsf[r32] = f;
    asm volatile("s_waitcnt lgkmcnt(0)" ::: "memory");
#pragma unroll
    for (int r = 0; r < 16; ++r) fr[r] = wsf[crow(r, hi)];
    asm volatile("s_waitcnt lgkmcnt(0)" ::: "memory");
}
}

#ifndef TSEC
#define TSEC 0
#endif
#define TSB(id) do { if (TSEC == (id)) ts0_ = __builtin_amdgcn_s_memrealtime(); } while (0)
#define TSE(id) do { if (TSEC == (id)) tacc_ += __builtin_amdgcn_s_memrealtime() - ts0_; } while (0)
__device__ __forceinline__ void attn_dense_phase(Frame& F) {
    using namespace nsa;
    unsigned long long ts0_ = 0, tacc_ = 0; (void)ts0_;
    LAS unsigned char* L = F.lds + RING_OFF;
    LAS float* TB = (LAS float*)(L + L_TB); LAS float* wsf = (LAS float*)(L + L_WSF) + F.wave * 64; LAS float* SC = (LAS float*)(L + L_SC); LAS unsigned* SELM = (LAS unsigned*)(L + L_SELM);
    const int wave = F.wave;
    for (int i = F.tid; i < TBN * 16; i += NWAVES * 64) { const int idx = i >> 4, hh = i & 15; float v;
        if (idx == 0) v = MASKV; else if (idx == 129) v = 0.f; else v = F.in[1][t5_bucket_dev(idx - 1) * 16 + hh] - F.in[1][31 * 16 + hh];
        TB[i] = v; }
    for (int i = F.tid; i < (4 * ST_RSTR + 16) / 4; i += NWAVES * 64) ((LAS unsigned*)(L + L_ZERO))[i] = 0u;
    __syncthreads();
    const bf16* KVQ = (const bf16*)(F.ws + WS_KVQ); const bf16* GATES = KVQ + 10 * KVQ_TSTRIDE;
    const bf16* KCMP = (const bf16*)(F.ws + WS_KCMP); const bf16* VCMP = (const bf16*)(F.ws + WS_VCMP);
    bf16* O = (bf16*)(F.ws + WS_O);
    unsigned* UCTR0 = (unsigned*)(F.ws + WS_CTL) + 1024; LAS unsigned* UCUR = (LAS unsigned*)(L + L_FLAG) + 17; unsigned ugrp = (unsigned)(F.vcu >> 5) & 7u;
#define NSA_DEAL(dst) do { dst = 2048u; for (int tr_ = 0; tr_ < 8; ++tr_) { const unsigned u_ = atomicAdd(UCTR0 + 64 * ugrp, 1u); if (u_ < 256u) { dst = 256u * ugrp + u_; break; } ugrp = (ugrp + 1u) & 7u; } } while (0)
    if (F.tid == 0) { unsigned d0_; NSA_DEAL(d0_); UCUR[0] = d0_; }
    __syncthreads();
#pragma unroll 1
    for (unsigned ucur = UCUR[0]; ucur < 2048u; ucur = UCUR[0]) {
        const int lane = fresh_lane(), tid = wave * 64 + lane, r32 = lane & 31, hi = lane >> 5, ql = r32 >> 2, h = r32 & 3;
        unsigned unext = 2048u; if (tid == 0) NSA_DEAL(unext);
        const int bg = 2 * (int)(ucur >> 8) + (int)((ucur >> 7) & 1u), b = bg >> 2, g = bg & 3, qt = 127 - (int)(ucur & 127u), t0 = qt * 64, cb = qt;
        const int i = 8 * wave + ql, pos = t0 + i; const long row = (long)b * SEQ + pos;
        const LAS float* tbl = TB + g * 4 + h;
        const LAS unsigned char* qr = L + L_QS + (32 * wave + r32) * QS_STR + hi * 16;
        { const bf16* qp = KVQ + (size_t)(6 + g) * KVQ_TSTRIDE + row * 256 + h * 64 + hi * 8;
#pragma unroll
          for (int d0 = 0; d0 < 4; ++d0) *(LAS bf16x8*)(L + L_QS + (32 * wave + r32) * QS_STR + hi * 16 + d0 * 32) = *(const bf16x8*)(qp + d0 * 16); }
        if (hi == 0) { const bf16* gp = GATES + row * 256 + g * 12 + h * 3; LAS float* G2 = (LAS float*)(L + L_G2) + (32 * wave + r32) * 2; G2[0] = bf2f(gp[0]); G2[1] = bf2f(gp[2]); ((LAS float*)(L + L_GS))[32 * wave + r32] = bf2f(gp[1]); }
        float mwin;
        f32x16 oacc[2];
        TileRegs TR;
        TSB(1);
        { const bf16* Kt = KVQ + 4 * KVQ_TSTRIDE + g * 64; const bf16* Vt = KVQ + 5 * KVQ_TSTRIDE + g * 64; const long base = (long)b * SEQ, rmax = (long)T - 1;
          const int kt0 = t0 >= 512 ? 0 : 8 - cb;
          LAS float* LINE = (LAS float*)(L + L_SC);
          if (tid < LSTR) {
#pragma unroll
              for (int hh = 0; hh < 4; ++hh) { float v; if (tid < 260) { const int d = tid - 68; v = d < 0 ? MASKV : TB[(min(d, 128) + 1) * 16 + g * 4 + hh]; } else v = tid + 184 >= 512 ? MASKV : 0.f;
                  LINE[hh * LSTR + tid] = v; } }
          f32x16 (&o)[2] = oacc; o[0] = f32x16{}; o[1] = f32x16{}; float m = MINIT, l = 0.f;
          tile_load(TR, Kt, Vt, base + t0 - 512 + 64 * kt0, rmax, tid); tile_store(TR, L + L_KV, tid); __syncthreads();
#pragma unroll 1
          for (int kt = kt0; kt < 9; ++kt) { LAS unsigned char* buf = L + L_KV + ((kt - kt0) & 1) * KVBUF;
              if (kt < 8) tile_load(TR, Kt, Vt, base + t0 - 512 + 64 * (kt + 1), rmax, tid);
              f32x16 p0, p1; qkt(p0, p1, buf, qr, r32, hi);
              if (kt == 0 || kt >= 6) { const int dl = 512 - 64 * kt + i - 4 * hi;
                  const LAS float* lp = LINE + h * LSTR + (kt == 0 ? dl - 247 : dl + 5);
#pragma unroll
                  for (int r = 0; r < 16; ++r) { const int c = (r & 3) + 8 * (r >> 2); p0[r] += lp[63 - c]; p1[r] += lp[31 - c]; } }
              p0 *= LOG2E; p1 *= LOG2E;
              const float rm = rowmax32(p0, p1, hi), mn = fmaxf(m, rm), f = __builtin_amdgcn_exp2f(m - mn), nmn = -mn; m = mn; l *= f;
              if (__any(f != 1.0f)) { float fr[16]; row_to_regs(fr, f, wsf, r32, hi);
#pragma unroll
                  for (int r = 0; r < 16; ++r) { o[0][r] *= fr[r]; o[1][r] *= fr[r]; } }
              unsigned pw[16]; p0 += nmn; p1 += nmn;
#pragma unroll
              for (int r = 0; r < 16; ++r) { p0[r] = __builtin_amdgcn_exp2f(p0[r]); p1[r] = __builtin_amdgcn_exp2f(p1[r]); }
              { const f32x16 s = p0 + p1; typedef float f32x2 __attribute__((ext_vector_type(2))); f32x2 s2 = {s[0], s[1]};
#pragma unroll
                for (int r = 1; r < 8; ++r) s2 += (f32x2){s[2 * r], s[2 * r + 1]};
                l += s2.x + s2.y; }
#pragma unroll
              for (int r = 0; r < 8; ++r) { pw[r] = cvtpk(p0[2 * r], p0[2 * r + 1]); pw[8 + r] = cvtpk(p1[2 * r], p1[2 * r + 1]); }
              pv(o, buf, pw, lane);
              if (kt < 8) tile_store(TR, L + L_KV + ((kt - kt0 + 1) & 1) * KVBUF, tid);
              __syncthreads(); }
          const float g_w = ((const LAS float*)(L + L_G2))[(32 * wave + r32) * 2 + 1]; const float lt = l + swap_other(l, hi); float fr[16]; row_to_regs(fr, lt > 0.f ? g_w / lt : 0.f, wsf, r32, hi); mwin = m * (1.0f / LOG2E);
#pragma unroll
          for (int r = 0; r < 16; ++r) { oacc[0][r] *= fr[r]; oacc[1][r] *= fr[r]; } }
        TSE(1); TSB(2);
        { const bf16* Kt = KCMP + g * 64; const bf16* Vt = VCMP + g * 64; const long base = (long)b * 512, rmax = (long)BATCH * 512 - 1;
          const int nvmax = t0 + 63 >= 31 ? ((t0 + 32) >> 4) + 1 : 0, ntc = (nvmax + 63) >> 6;
          float m = MINIT, l = 0.f;
          if (ntc > 0) { tile_load(TR, Kt, Vt, base, rmax, tid); tile_store(TR, L + L_KV, tid); }
          __syncthreads();
#pragma unroll 1
          for (int tc = 0; tc < ntc; ++tc) { LAS unsigned char* buf = L + L_KV + (tc & 1) * KVBUF;
              tile_load(TR, Kt, Vt, base + 64 * (tc + 1 < ntc ? tc + 1 : 0), rmax, tid);
              f32x16 p0, p1; qkt(p0, p1, buf, qr, r32, hi);
              if (t0 - 1024 * tc - 1039 < 128) bias_mask<16, false>(p0, p1, pos - 31 - 1024 * tc - 64 * hi, tbl);
              p0 *= LOG2E; p1 *= LOG2E;
              const float rm = rowmax32(p0, p1, hi), mn = fmaxf(m, rm), nmn = -mn; l *= __builtin_amdgcn_exp2f(m - mn); m = mn;
              p0 += nmn; p1 += nmn;
#pragma unroll
              for (int r = 0; r < 16; ++r) { p0[r] = __builtin_amdgcn_exp2f(p0[r]); p1[r] = __builtin_amdgcn_exp2f(p1[r]); }
              { const f32x16 s = p0 + p1; typedef float f32x2 __attribute__((ext_vector_type(2))); f32x2 s2 = {s[0], s[1]};
#pragma unroll
                for (int r = 1; r < 8; ++r) s2 += (f32x2){s[2 * r], s[2 * r + 1]};
                l += s2.x + s2.y; }
              tile_store(TR, L + L_KV + ((tc + 1) & 1) * KVBUF, tid);
              __syncthreads(); }
          const float g_c = ((const LAS float*)(L + L_G2))[(32 * wave + r32) * 2]; const float lt = l + swap_other(l, hi), linv = lt > 0.f ? 1.0f / lt : 0.f, nm = -m;
          float carry = 0.f;
#pragma unroll 1
          for (int tc = 0; tc < ntc; ++tc) { LAS unsigned char* buf = L + L_KV + ((ntc + tc) & 1) * KVBUF;
              if (tc + 1 < ntc) tile_load(TR, Kt, Vt, base + 64 * (tc + 1), rmax, tid);
              f32x16 p0, p1; qkt(p0, p1, buf, qr, r32, hi);
              if (t0 - 1024 * tc - 1039 < 128) bias_mask<16, false>(p0, p1, pos - 31 - 1024 * tc - 64 * hi, tbl);
              unsigned pw[16];
#pragma unroll
              for (int r = 0; r < 16; ++r) { p0[r] = __builtin_amdgcn_exp2f(fmaf(p0[r], LOG2E, nm)); p1[r] = __builtin_amdgcn_exp2f(fmaf(p1[r], LOG2E, nm)); }
              p0 *= linv; p1 *= linv;
#pragma unroll
              for (int r = 0; r < 8; ++r) { pw[r] = cvtpk(p0[2 * r] * g_c, p0[2 * r + 1] * g_c); pw[8 + r] = cvtpk(p1[2 * r] * g_c, p1[2 * r + 1] * g_c); }
              pv(oacc, buf, pw, lane);
              float w8[8], c8[8];
#pragma unroll
              for (int kq = 0; kq < 8; ++kq) { float a[4];
#pragma unroll
                  for (int e = 0; e < 4; ++e) { float x = kq < 4 ? p0[4 * kq + e] : p1[4 * (kq - 4) + e]; x += NSA_DPP(x, 0xB1); x += NSA_DPP(x, 0x4E); a[e] = x; }
                  w8[kq] = 2.0f * (a[0] + a[1] + a[2]) + a[3]; c8[kq] = a[3]; }
#pragma unroll
              for (int kq = 0; kq < 8; ++kq) { const float ok = swap_other(c8[kq], hi); w8[kq] += hi ? ok : carry; carry = ok; }
              LAS float* scq = SC + i * 128 + 16 * tc;
#pragma unroll
              for (int kq = 0; kq < 8; ++kq) if ((kq & 3) == h) scq[2 * kq + hi] = w8[kq];
              if (tc + 1 < ntc) tile_store(TR, L + L_KV + ((ntc + tc + 1) & 1) * KVBUF, tid);
              __syncthreads(); }
        }
        TSE(2); TSB(3);
        { const int lq = lane >> 3, sub = lane & 7; unsigned msk[4] = {0u, 0u, 0u, 0u};
          if (cb <= 15) { msk[0] = (cb == 31) ? 0xffffffffu : ((1u << (cb + 1)) - 1u); }
          else { unsigned key[16]; const LAS float* scq = SC + (8 * wave + lq) * 128;
              asm volatile("s_waitcnt lgkmcnt(0)" ::: "memory");
#pragma unroll
              for (int kk = 0; kk < 16; ++kk) { const int j = sub + 8 * kk; const float s = scq[j]; key[kk] = (j >= 1 && j <= cb - 2) ? ((__float_as_uint(s) & 0xFFFFFF80u) | (unsigned)(127 - j)) : 0u; }
#pragma unroll 1
              for (int rd = 0; rd < 13; ++rd) { unsigned mx = key[0];
#pragma unroll
                  for (int kk = 1; kk < 16; ++kk) mx = mx > key[kk] ? mx : key[kk];
                  { unsigned o1 = NSA_DPPU(mx, 0xB1); mx = mx > o1 ? mx : o1; o1 = NSA_DPPU(mx, 0x4E); mx = mx > o1 ? mx : o1; o1 = NSA_DPPU(mx, 0x141); mx = mx > o1 ? mx : o1; }
                  const int j = 127 - (int)(mx & 127u);
#pragma unroll
                  for (int w4 = 0; w4 < 4; ++w4) if (mx != 0u && (j >> 5) == w4) msk[w4] |= 1u << (j & 31);
#pragma unroll
                  for (int kk = 0; kk < 16; ++kk) if (key[kk] == mx) key[kk] = 0u; }
              msk[0] |= 1u;
#pragma unroll
              for (int w4 = 0; w4 < 4; ++w4) { if (((cb - 1) >> 5) == w4) msk[w4] |= 1u << ((cb - 1) & 31); if ((cb >> 5) == w4) msk[w4] |= 1u << (cb & 31); } }
          if (sub < 4) { const unsigned mv = sub == 0 ? msk[0] : sub == 1 ? msk[1] : sub == 2 ? msk[2] : msk[3];
              SELM[(8 * wave + lq) * 4 + sub] = mv; } }
        TSE(3); TSB(4);
        { LAS unsigned short* PO = (LAS unsigned short*)(L + L_PO);
#pragma unroll
          for (int r = 0; r < 16; ++r) { const int rw = 32 * wave + crow(r, hi); PO[rw * 64 + r32] = (unsigned short)f2bf(oacc[0][r]); PO[rw * 64 + 32 + r32] = (unsigned short)f2bf(oacc[1][r]); } }
        { LAS float* NMREF = (LAS float*)(L + L_NMREF); LAS float* GS = (LAS float*)(L + L_GS); LAS unsigned char* QS = L + L_QS; LAS unsigned* FLAG = (LAS unsigned*)(L + L_FLAG);
          { const int l2 = fresh_lane(); if (l2 < 32) NMREF[32 * wave + l2] = -mwin * LOG2E; if (wave == 0 && l2 == 0) FLAG[16] = 1u; }
          __syncthreads();
          if (tid < 260) {
#pragma unroll
              for (int hh = 0; hh < 4; ++hh) { const int d = tid - 68; ((LAS float*)(L + L_SC))[hh * LSTR + tid] = d < 0 ? MASKV : TB[(min(d, 128) + 1) * 16 + g * 4 + hh]; } }
          f32x16 osel[2]; osel[0] = f32x16{}; osel[1] = f32x16{};
          { const bf16* Kt = KVQ + 2 * KVQ_TSTRIDE + g * 64; const bf16* Vt = KVQ + 3 * KVQ_TSTRIDE + g * 64; const long base = (long)b * SEQ, rmax = (long)T - 1;
            const int nd = cb <= 15 ? cb + 1 : 3; const float nmw = -mwin * LOG2E; float lsd = 0.f;
#define NSA_DBLK(ii) (cb <= 15 ? (ii) : ((ii) == 0 ? 0 : cb - 2 + (ii)))
            tile_load(TR, Kt, Vt, base + 64 * NSA_DBLK(0), rmax, tid); tile_store(TR, L + L_KV, tid); __syncthreads();
#pragma unroll 1
            for (int ii = 0; ii < nd; ++ii) { LAS unsigned char* buf = L + L_KV + (ii & 1) * KVBUF; const int blk = NSA_DBLK(ii);
                if (ii + 1 < nd) tile_load(TR, Kt, Vt, base + 64 * NSA_DBLK(ii + 1), rmax, tid);
                f32x16 p0, p1; qkt(p0, p1, buf, qr, r32, hi);
                if (blk >= cb - 2) { const LAS float* lp = (const LAS float*)(L + L_SC) + h * LSTR + (t0 + i - 64 * blk - 4 * hi) + 5;
#pragma unroll
                    for (int r = 0; r < 16; ++r) { const int c = (r & 3) + 8 * (r >> 2); p0[r] += lp[63 - c]; p1[r] += lp[31 - c]; } }
                unsigned pw[16]; float ls = 0.f;
#pragma unroll
                for (int r = 0; r < 16; ++r) { p0[r] = __builtin_amdgcn_exp2f(fminf(fmaf(p0[r], LOG2E, nmw), 100.f)); p1[r] = __builtin_amdgcn_exp2f(fminf(fmaf(p1[r], LOG2E, nmw), 100.f)); ls += p0[r] + p1[r]; }
                lsd += ls;
#pragma unroll
                for (int r = 0; r < 8; ++r) { pw[r] = cvtpk(p0[2 * r], p0[2 * r + 1]); pw[8 + r] = cvtpk(p1[2 * r], p1[2 * r + 1]); }
                pv(osel, buf, pw, lane);
                if (ii + 1 < nd) tile_store(TR, L + L_KV + ((ii + 1) & 1) * KVBUF, tid);
                __syncthreads(); }
#undef NSA_DBLK
            lsd += swap_other(lsd, hi); if (hi == 0) ((LAS float*)(L + L_LSD))[32 * wave + r32] = lsd; }
          float osp[4][8]; float lsp[4] = {0.f, 0.f, 0.f, 0.f};
          { LAS float* cv = (LAS float*)(L + L_ST) + wave * 2048;
#pragma unroll
            for (int r = 0; r < 16; ++r) { cv[crow(r, hi) * 64 + r32] = osel[0][r]; cv[crow(r, hi) * 64 + 32 + r32] = osel[1][r]; }
            asm volatile("s_waitcnt lgkmcnt(0)" ::: "memory");
            const LAS float* cr = cv + (4 * (lane >> 3)) * 64 + 8 * (lane & 7);
#pragma unroll
            for (int hh = 0; hh < 4; ++hh) { const f32x4 a = *(const LAS f32x4*)(cr + hh * 64), bq = *(const LAS f32x4*)(cr + hh * 64 + 4);
#pragma unroll
                for (int e = 0; e < 4; ++e) { osp[hh][e] = a[e]; osp[hh][4 + e] = bq[e]; } } }
          __syncthreads();
          const int fr16 = lane & 15, q4 = lane >> 4, qi = fr16 >> 2, hc = fr16 & 3;
          const bf16* Ks = KVQ + 2 * KVQ_TSTRIDE + ((long)b * SEQ) * 256 + g * 64; const bf16* VT = (const bf16*)(F.ws + WS_VT) + (size_t)((b * 4 + g) * 128) * 4096;
          bf16x8 Kf[4][2] = {}, Vf[4][2] = {}; unsigned long long qm = 0ull, qmn = 0ull; int jn = 0, jc = 0, jcn = 0;
#define NSA_SCAN_NEXT() do { qmn = 0ull; for (;;) { unsigned jx = 0u; if (lane == 0) jx = __hip_atomic_fetch_add(FLAG + 16, 1u, __ATOMIC_RELAXED, __HIP_MEMORY_SCOPE_WORKGROUP); \
              const int j = __builtin_amdgcn_readfirstlane((int)jx); if (j > cb - 2) break;                      \
              { const unsigned wv = SELM[lane * 4 + (j >> 5)]; qmn = __ballot((wv >> (j & 31)) & 1u); } \
              jcn = j; if (qmn) break; } } while (0)
#define NSA_LOAD_K(j) do { const bf16* kp = Ks + (size_t)(64 * (j) + fr16) * 256 + 8 * q4; \
              _Pragma("unroll") for (int a = 0; a < 4; ++a) _Pragma("unroll") for (int s2 = 0; s2 < 2; ++s2) Kf[a][s2] = *(const bf16x8*)(kp + a * 16 * 256 + s2 * 32); } while (0)
#define NSA_LOAD_V(j) do { const bf16* vp = VT + (size_t)(j) * 4096 + fr16 * 64 + 8 * q4; \
              _Pragma("unroll") for (int a = 0; a < 4; ++a) _Pragma("unroll") for (int s2 = 0; s2 < 2; ++s2) Vf[a][s2] = *(const bf16x8*)(vp + a * 16 * 64 + s2 * 32); } while (0)
#define NSA_LOAD_K_D(j, dep) do { const bf16* kp = Ks + (size_t)(64 * (j) + fr16) * 256 + 8 * q4 + (dep); \
              _Pragma("unroll") for (int a = 0; a < 4; ++a) _Pragma("unroll") for (int s2 = 0; s2 < 2; ++s2) Kf[a][s2] = *(const bf16x8*)(kp + a * 16 * 256 + s2 * 32); } while (0)
#define NSA_LOAD_V_D(j, dep) do { const bf16* vp = VT + (size_t)(j) * 4096 + fr16 * 64 + 8 * q4 + (dep); \
              _Pragma("unroll") for (int a = 0; a < 4; ++a) _Pragma("unroll") for (int s2 = 0; s2 < 2; ++s2) Vf[a][s2] = *(const bf16x8*)(vp + a * 16 * 64 + s2 * 32); } while (0)
          if (cb > 15) {
              int gi = 0, rd = 0; bool fin = false;
              auto consume = [&]() __attribute__((always_inline)) { const LAS unsigned char* sb = L + L_ST + (rd & 1) * STBUF;
                const unsigned tg = *(sb + ST_TAGS + lane);
                const int ql8 = lane >> 3; unsigned long long mym = 0ull;
#pragma unroll
                for (int q = 0; q < 8; ++q) { const unsigned long long bm = __ballot(tg == (unsigned)(8 * wave + q)); if (ql8 == q) mym = bm; }
                typedef unsigned u2 __attribute__((ext_vector_type(2)));
                auto pull2 = [&]() __attribute__((always_inline)) {
                    const bool a0 = mym != 0ull; const int j0 = a0 ? __builtin_ctzll(mym) : 0; mym &= mym - 1ull;
                    const bool a1 = mym != 0ull; const int j1 = a1 ? __builtin_ctzll(mym) : 0; mym &= mym - 1ull;
                    const LAS unsigned char* dp0 = (a0 ? sb + (4 * j0) * ST_RSTR : L + L_ZERO) + 16 * (lane & 7); const LAS unsigned char* dp1 = (a1 ? sb + (4 * j1) * ST_RSTR : L + L_ZERO) + 16 * (lane & 7);
                    const f32x4 lv0 = *(const LAS f32x4*)(a0 ? sb + ST_LVAL + 16 * j0 : L + L_ZERO + 4 * ST_RSTR), lv1 = *(const LAS f32x4*)(a1 ? sb + ST_LVAL + 16 * j1 : L + L_ZERO + 4 * ST_RSTR);
                    u2 d0[4][2], d1[4][2];
#pragma unroll
                    for (int hh = 0; hh < 4; ++hh) { d0[hh][0] = *(const LAS u2*)(dp0 + hh * ST_RSTR); d0[hh][1] = *(const LAS u2*)(dp0 + hh * ST_RSTR + 8); d1[hh][0] = *(const LAS u2*)(dp1 + hh * ST_RSTR); d1[hh][1] = *(const LAS u2*)(dp1 + hh * ST_RSTR + 8); }
#pragma unroll
                    for (int hh = 0; hh < 4; ++hh) {
#pragma unroll
                        for (int w = 0; w < 2; ++w) { const unsigned x0 = d0[hh][w].x, y0 = d0[hh][w].y, x1 = d1[hh][w].x, y1 = d1[hh][w].y;
                            osp[hh][4 * w + 0] += __uint_as_float(x0 << 16) + __uint_as_float(x1 << 16); osp[hh][4 * w + 1] += __uint_as_float(x0 & 0xFFFF0000u) + __uint_as_float(x1 & 0xFFFF0000u);
                            osp[hh][4 * w + 2] += __uint_as_float(y0 << 16) + __uint_as_float(y1 << 16); osp[hh][4 * w + 3] += __uint_as_float(y0 & 0xFFFF0000u) + __uint_as_float(y1 & 0xFFFF0000u); }
                        lsp[hh] += lv0[hh] + lv1[hh]; } };
                if (__ballot(mym != 0ull) != 0ull) { pull2();
                    if (__ballot(mym != 0ull) != 0ull) { pull2();
                        while (__ballot(mym != 0ull) != 0ull) pull2(); } } };
              auto round_end = [&](const bool more) __attribute__((always_inline)) -> bool {
                if (lane == 0) FLAG[(rd & 1) * 8 + wave] = more ? 1u : 0u;
                asm volatile("s_waitcnt lgkmcnt(0)" ::: "memory"); __builtin_amdgcn_s_barrier(); asm volatile("" ::: "memory");
                const unsigned any = FLAG[(rd & 1) * 8 + (lane & 7)];
                consume(); ++rd; gi = 0;
                return __ballot(any != 0u) == 0ull; };
              auto group = [&](const bool last) __attribute__((always_inline)) {
                  LAS unsigned char* stb = L + L_ST + (rd & 1) * STBUF; const int sidx = wave * SG + gi;
                  LAS unsigned char* sdat = stb + (16 * sidx + fr16) * ST_RSTR; LAS float* slv = (LAS float*)(stb + ST_LVAL) + 16 * sidx + fr16; LAS unsigned char* stg = stb + ST_TAGS + 4 * sidx;
                  int iq[4];
#pragma unroll
                  for (int e = 0; e < 4; ++e) { if (qm) { iq[e] = __builtin_ctzll(qm); qm &= qm - 1ull; } else iq[e] = -1; }
                  const int myq = qi == 0 ? iq[0] : qi == 1 ? iq[1] : qi == 2 ? iq[2] : iq[3]; const bool cval = myq >= 0; const int rowq = 4 * (cval ? myq : iq[0]) + hc;
                  const bf16x8 q0 = *(const LAS bf16x8*)(QS + rowq * QS_STR + q4 * 16), q1 = *(const LAS bf16x8*)(QS + rowq * QS_STR + 64 + q4 * 16);
                  const float nmr = NMREF[rowq];
                  f32x4 st[4];
#pragma unroll
                  for (int kt = 0; kt < 4; ++kt) { st[kt] = (f32x4){0.f, 0.f, 0.f, 0.f};
                      st[kt] = __builtin_amdgcn_mfma_f32_16x16x32_bf16(Kf[kt][0], q0, st[kt], 0, 0, 0); st[kt] = __builtin_amdgcn_mfma_f32_16x16x32_bf16(Kf[kt][1], q1, st[kt], 0, 0, 0); }
                  const int jnx = qmn ? jcn : jc;
                  if (last) { int dep = 0; asm volatile("" : "+v"(dep) : "v"(st[0]), "v"(st[1]), "v"(st[2]), "v"(st[3])); NSA_LOAD_K_D(jnx, dep); }
                  if (jc >= cb - 2) { const int dl = t0 + (cval ? myq : iq[0]) - 64 * jc - 4 * q4; const LAS float* tb2 = TB + g * 4 + hc;
#pragma unroll
                      for (int kt = 0; kt < 4; ++kt)
#pragma unroll
                          for (int r = 0; r < 4; ++r) { const int d = dl - 16 * kt - r; st[kt][r] += tb2[(min(max(d, -1), 128) + 1) * 16]; } }
                  float ls = 0.f;
#pragma unroll
                  for (int kt = 0; kt < 4; ++kt)
#pragma unroll
                      for (int r = 0; r < 4; ++r) { const float p = __builtin_amdgcn_exp2f(fminf(fmaf(st[kt][r], LOG2E, nmr), 100.f)); st[kt][r] = p; ls += p; }
                  { const auto s16 = __builtin_amdgcn_permlane16_swap(__float_as_uint(ls), __float_as_uint(ls), false, false); ls = __uint_as_float(s16[0]) + __uint_as_float(s16[1]);
                    const auto s32 = __builtin_amdgcn_permlane32_swap(__float_as_uint(ls), __float_as_uint(ls), false, false); ls = __uint_as_float(s32[0]) + __uint_as_float(s32[1]); }
                  if (q4 == 0) slv[0] = ls;
                  if (lane < 4) stg[lane] = (unsigned char)(lane == 0 ? iq[0] : lane == 1 ? iq[1] : lane == 2 ? iq[2] : iq[3]);
                  bf16x8 pf[2];
#pragma unroll
                  for (int s2 = 0; s2 < 2; ++s2) pf[s2] = __builtin_bit_cast(bf16x8, (v4u){cvtpk(st[2 * s2][0], st[2 * s2][1]), cvtpk(st[2 * s2][2], st[2 * s2][3]), cvtpk(st[2 * s2 + 1][0], st[2 * s2 + 1][1]), cvtpk(st[2 * s2 + 1][2], st[2 * s2 + 1][3])});
                  f32x4 ot[4];
#pragma unroll
                  for (int dt = 0; dt < 4; ++dt) { ot[dt] = (f32x4){0.f, 0.f, 0.f, 0.f};
                      ot[dt] = __builtin_amdgcn_mfma_f32_16x16x32_bf16(Vf[dt][0], pf[0], ot[dt], 0, 0, 0); ot[dt] = __builtin_amdgcn_mfma_f32_16x16x32_bf16(Vf[dt][1], pf[1], ot[dt], 0, 0, 0); }
                  if (last) { int dep = 0; asm volatile("" : "+v"(dep) : "v"(ot[0]), "v"(ot[1]), "v"(ot[2]), "v"(ot[3])); NSA_LOAD_V_D(jnx, dep); }
#pragma unroll
                  for (int dt = 0; dt < 4; ++dt) { typedef unsigned u2 __attribute__((ext_vector_type(2)));
                      *(LAS u2*)(sdat + (16 * dt + 4 * q4) * 2) = (u2){cvtpk(ot[dt][0], ot[dt][1]), cvtpk(ot[dt][2], ot[dt][3])}; } };
              NSA_SCAN_NEXT(); if (qmn) { NSA_LOAD_K(jcn); NSA_LOAD_V(jcn); }
#pragma unroll 1
              while (qmn != 0ull) { qm = qmn; jc = jcn;
#pragma unroll 1
                  while (__builtin_popcountll(qm) > 4) { group(false); if (++gi == SG) round_end(true); }
                  NSA_SCAN_NEXT();
                  group(true);
                  if (++gi == SG) fin = round_end(qmn != 0ull); }
#pragma unroll 1
              while (!fin) { LAS unsigned char* stb = L + L_ST + (rd & 1) * STBUF;
                  for (; gi < SG; ++gi) if (lane < 4) stb[ST_TAGS + 4 * (wave * SG + gi) + lane] = (unsigned char)255;
                  fin = round_end(false); }
          }
          { const int ln = fresh_lane(), q8 = ln >> 3, dg = ln & 7;
#pragma unroll
            for (int hh = 0; hh < 4; ++hh) { const int rw = 32 * wave + 4 * q8 + hh;
                const float lsum = lsp[hh] + ((const LAS float*)(L + L_LSD))[rw]; const float f = lsum > 0.f ? GS[rw] / lsum : 0.f;
                const v4u po = *(const LAS v4u*)(L + L_PO + rw * 128 + 16 * dg); v4u ov;
                ov.x = cvtpk(__uint_as_float(po.x << 16) + osp[hh][0] * f, __uint_as_float(po.x & 0xFFFF0000u) + osp[hh][1] * f); ov.y = cvtpk(__uint_as_float(po.y << 16) + osp[hh][2] * f, __uint_as_float(po.y & 0xFFFF0000u) + osp[hh][3] * f);
                ov.z = cvtpk(__uint_as_float(po.z << 16) + osp[hh][4] * f, __uint_as_float(po.z & 0xFFFF0000u) + osp[hh][5] * f); ov.w = cvtpk(__uint_as_float(po.w << 16) + osp[hh][6] * f, __uint_as_float(po.w & 0xFFFF0000u) + osp[hh][7] * f);
                *(v4u*)(O + ((long)b * SEQ + t0 + 8 * wave + q8) * 1024 + (g * 4 + hh) * 64 + 8 * dg) = ov; } } }
        TSE(4);
        if (tid == 0) UCUR[0] = unext;
        __syncthreads();
    }
    if (TSEC) { const unsigned long long tb_ = __builtin_amdgcn_s_memrealtime(); while (__builtin_amdgcn_s_memrealtime() - tb_ < tacc_) __builtin_amdgcn_s_sleep(4); }
}


#ifndef MK_PER_PHASE
#define MK_PER_PHASE 0
#endif
constexpr int N_PHASES = 14;
struct Args { const float* in[20]; float* out; unsigned char* ws; int ph_lo, ph_hi, li, pad; };
__global__ void __launch_bounds__(NWAVES * 64, 2) nsa_fwd(Args args) {
    extern __shared__ __attribute__((aligned(16))) unsigned char lds[];
    Frame F;
    F.lds = (LAS unsigned char*)lds;
    F.MISC = (volatile LAS unsigned*)(F.lds + MISC_OFF);
    F.tid = threadIdx.x; F.lane = F.tid & 63; F.wave = __builtin_amdgcn_readfirstlane(F.tid >> 6);
    F.G = gridDim.x; { const int bx = blockIdx.x; F.vcu = (F.G % 8 == 0) ? (bx % 8) * (F.G / 8) + bx / 8 : bx; }
    unsigned char* ws = args.ws; F.ws = ws; F.out = args.out;
    F.ctl = (gu32*)(ws + WS_CTL);
    F.in = args.in;
    for (int u = F.tid; u < (LDS_BYTES - LDSCTL_OFF) / 4; u += NWAVES * 64) ((LAS unsigned*)(F.lds + LDSCTL_OFF))[u] = 0u;
    __syncthreads();
    XcdBarrier bar; bar.bar = (unsigned*)(F.ctl + CW_BAR); bar.x = 0; bar.st = nullptr; bar.G = 0;
    if (!MK_PER_PHASE) bar = xcd_barrier_post((unsigned*)(F.ctl + CW_BAR), F.MISC + 8, F.tid == 0, gridDim.x);
    const bool use_gbar = !MK_PER_PHASE && F.G == 256;
    XcdBarrier gbar = bar;
    if (use_gbar) gbar = xcd_barrier_post((unsigned*)(F.ctl + CW_BAR) + XCD_BAR_WORDS * (1 + ((int)blockIdx.x & 7)), F.MISC + 10, F.tid == 0, gridDim.x / 8);
#define GROUP_BAR() do { if (use_gbar) xcd_barrier(gbar, F.wave == 0 && fresh_lane() == 0); else GRID_BAR(); } while (0)
#ifdef TBAR
    unsigned long long tbar_acc = 0;
#define GRID_BAR() do { const unsigned long long tq_ = __builtin_amdgcn_s_memrealtime(); xcd_barrier(bar, F.wave == 0 && fresh_lane() == 0); tbar_acc += __builtin_amdgcn_s_memrealtime() - tq_; } while (0)
#else
#define GRID_BAR() do { if (!MK_PER_PHASE) xcd_barrier(bar, F.wave == 0 && fresh_lane() == 0); } while (0)
#endif
    const int lo = args.ph_lo, hi = args.ph_hi;
#ifndef TPH_MASK
#define TPH_MASK 0
#endif
    unsigned long long tph_acc = 0, tph_t0 = 0; int tph_cur = -1; (void)tph_t0; (void)tph_cur;
#define TPH_MARK(k) (TPH_MASK ? (void)((tph_cur >= 0 && ((TPH_MASK >> tph_cur) & 1)) ? (tph_acc += __builtin_amdgcn_s_memrealtime() - tph_t0) : 0ull, tph_cur = (k), tph_t0 = __builtin_amdgcn_s_memrealtime()) : (void)0)
#ifndef TIMB
#define TIMB -1
#endif
    unsigned long long timb_t0 = 0; (void)timb_t0;
#define TIMB_MARK(k) ((TIMB >= 0 && (k) == TIMB) ? (void)(timb_t0 = __builtin_amdgcn_s_memrealtime()) : (void)0)
#define IN(k) (lo <= (k) && (k) < hi && (TPH_MARK(k), TIMB_MARK(k), F.lane = fresh_lane(), F.tid = F.wave * 64 + F.lane, true))
#define BOTH(k) ((TIMB >= 0 && (k) == TIMB) ? (void)((__syncthreads(), F.wave == 0 && fresh_lane() == 0) ? (atomicMax((unsigned*)(ws + WS_CTL) + 24, ~(unsigned)(__builtin_amdgcn_s_memrealtime() - timb_t0)), atomicMax((unsigned*)(ws + WS_CTL) + 25, (unsigned)(__builtin_amdgcn_s_memrealtime() - timb_t0)), 0) : 0) : (void)0, IN(k) && IN((k) + 1))
    bf16* XB = (bf16*)(ws + WS_XB); float* SS = (float*)(ws + WS_SS);
    const int bx = (int)blockIdx.x;

    if (IN(0)) { p0_prologue(F); if (BOTH(0)) GRID_BAR(); }
    if (IN(1)) {
        pg8::Gemm g{XB, (const bf16*)(ws + WS_WIN), T, 3072, DM, 0}; pg8::StaticOrder S; S.init(T, 3072, F.G, bx);
        pg8::EpiWin E{(bf16*)(ws + WS_BG), (bf16*)(ws + WS_V), SS};
        pg8::gemm_phase<pg8::EpiWin, pg8::StaticOrder, true, true>(F.lds + RING_OFF, g, S, E, F.wave);
#ifdef DUP1
        GRID_BAR(); pg8::gemm_phase<pg8::EpiWin, pg8::StaticOrder, true, true>(F.lds + RING_OFF, g, S, E, F.wave);
#endif
        if (BOTH(1)) GRID_BAR(); }
    if (IN(2)) { conv_gate_phase(F); if (BOTH(2)) GROUP_BAR(); }
    if (IN(3)) {
        pg8::Gemm g{(const bf16*)(ws + WS_BG), (const bf16*)(ws + WS_WOUT), T, DM, DM, 0}; pg8::StaticOrder S; S.init(T, DM, F.G, bx);
        pg8::EpiRes E{XB, SS + T};
        pg8::gemm_phase<pg8::EpiRes, pg8::StaticOrder, true, true>(F.lds + RING_OFF, g, S, E, F.wave);
        if (BOTH(3)) GRID_BAR(); }
    if (IN(4)) {
        pg8::Gemm g{XB, (const bf16*)(ws + WS_W1), T, FF, DM, 0}; pg8::StaticOrder S; S.init(T, FF, F.G, bx);
        pg8::EpiRelu2 E{(bf16*)(ws + WS_H), FF, SS + T};
        pg8::gemm_phase<pg8::EpiRelu2, pg8::StaticOrder, true, true>(F.lds + RING_OFF, g, S, E, F.wave);
#ifdef DUP4
        GRID_BAR(); pg8::gemm_phase<pg8::EpiRelu2, pg8::StaticOrder, true, true>(F.lds + RING_OFF, g, S, E, F.wave);
#endif
        if (BOTH(4)) GROUP_BAR(); }
    if (IN(5)) {
        pg8::Gemm g{(const bf16*)(ws + WS_H), (const bf16*)(ws + WS_W2), T, DM, FF, 0}; pg8::StaticOrder S; S.init(T, DM, F.G, bx);
        pg8::EpiRes E{XB, SS + 2 * T};
        pg8::gemm_phase<pg8::EpiRes, pg8::StaticOrder, true, true>(F.lds + RING_OFF, g, S, E, F.wave);
        if (BOTH(5)) GRID_BAR(); }
    if (IN(6)) {
        pg8::Gemm g{XB, (const bf16*)(ws + WS_WKVQ), T, NKVQ - 256, DM, 0}; pg8::StaticOrder S; S.init(T, NKVQ - 256, F.G, bx);
        pg8::EpiKvq E{(bf16*)(ws + WS_KVQ), KVQ_TSTRIDE, SS + 2 * T};
        pg8::gemm_phase<pg8::EpiKvq, pg8::StaticOrder, true, true>(F.lds + RING_OFF, g, S, E, F.wave);
        if (BOTH(6)) GRID_BAR(); }
    if (IN(7)) {
        const int c = F.vcu, side = (c >> 5) & 1;
        if (c < 64 || F.G != 256) {
            pg8::Gemm g{(const bf16*)(ws + WS_KVQ) + (size_t)side * KVQ_TSTRIDE, (const bf16*)(ws + WS_PW1 + (size_t)side * MiB), PHI_ROWS, 256, 2048, 1}; pg8::PhiOrder S{c};
            pg8::EpiPhi E{(bf16*)(ws + WS_PHIH) + (size_t)side * PHI_ROWS * 256, (const float*)(ws + WS_PHIB) + side * 256};
            pg8::gemm_phase<pg8::EpiPhi, pg8::PhiOrder, false, true>(F.lds + RING_OFF, g, S, E, F.wave); }
        if (c >= 64 || F.G != 256) {
            pg8::Gemm g{XB, (const bf16*)(ws + WS_WKVQ), T, NKVQ, DM, 0}; pg8::EpiKvq E{(bf16*)(ws + WS_KVQ), KVQ_TSTRIDE, SS + 2 * T};
            if (F.G == 256) { pg8::GatesOrder S{c}; pg8::gemm_phase<pg8::EpiKvq, pg8::GatesOrder, true, true>(F.lds + RING_OFF, g, S, E, F.wave); }
            else { pg8::GatesAll S{c, F.G}; pg8::gemm_phase<pg8::EpiKvq, pg8::GatesAll, true, true>(F.lds + RING_OFF, g, S, E, F.wave); } }
        if (BOTH(7)) GRID_BAR(); }
    if (IN(8)) { phi2_phase(F, F.vcu * NWAVES + F.wave, F.G * NWAVES, 2 * (PHI_ROWS / 8)); __syncthreads(); vsel_transpose_phase(F, F.vcu * NWAVES + F.wave, F.G * NWAVES); if (BOTH(8)) GRID_BAR(); }
#ifdef TMIN9
    unsigned long long t9_ = 0;
    if (IN(9)) { t9_ = __builtin_amdgcn_s_memrealtime(); }
#endif
    if (IN(9)) { if (F.G == 256) attn_dense_phase(F); else attn_naive_phase(F, (bf16*)(ws + WS_O));
#ifdef TMIN9
        __syncthreads(); if (F.tid == 0) { const unsigned dt = (unsigned)(__builtin_amdgcn_s_memrealtime() - t9_); atomicMax((unsigned*)(ws + WS_CTL) + 20, ~dt); atomicMax((unsigned*)(ws + WS_CTL) + 21, dt); }
#endif
        if (BOTH(9)) GRID_BAR(); }
    if (IN(10)) {
        pg8::Gemm g{(const bf16*)(ws + WS_O), (const bf16*)(ws + WS_WO), T, DM, DM, 0}; pg8::StaticOrder S; S.init(T, DM, F.G, bx);
        pg8::EpiRes E{XB, SS + 3 * T};
        pg8::gemm_phase<pg8::EpiRes, pg8::StaticOrder, true, true>(F.lds + RING_OFF, g, S, E, F.wave);
        if (BOTH(10)) GROUP_BAR(); }
    if (IN(11)) {
        pg8::Gemm g{XB, (const bf16*)(ws + WS_W1 + 8 * MiB), T, FF, DM, 0}; pg8::StaticOrder S; S.init(T, FF, F.G, bx);
        pg8::EpiRelu2 E{(bf16*)(ws + WS_H), FF, SS + 3 * T};
        pg8::gemm_phase<pg8::EpiRelu2, pg8::StaticOrder, true, true>(F.lds + RING_OFF, g, S, E, F.wave);
        if (BOTH(11)) GROUP_BAR(); }
    if (IN(12)) {
        pg8::Gemm g{(const bf16*)(ws + WS_H), (const bf16*)(ws + WS_W2 + 8 * MiB), T, DM, FF, 0}; pg8::StaticOrder S; S.init(T, DM, F.G, bx);
        pg8::EpiRes E{XB, SS + 4 * T};
        pg8::gemm_phase<pg8::EpiRes, pg8::StaticOrder, true, true>(F.lds + RING_OFF, g, S, E, F.wave);
        if (BOTH(12)) GROUP_BAR(); }
    if (IN(13)) { final_norm_phase(F);
    }
    if (TIMB >= 0) { const unsigned mn = ~((const unsigned*)(ws + WS_CTL))[24], mx = ((const unsigned*)(ws + WS_CTL))[25]; const unsigned long long tb_ = __builtin_amdgcn_s_memrealtime(); while (__builtin_amdgcn_s_memrealtime() - tb_ < (unsigned long long)(mx - mn)) __builtin_amdgcn_s_sleep(4); }
#ifdef TMIN9
    { const unsigned mn = ~((const unsigned*)(ws + WS_CTL))[20]; const unsigned long long tb_ = __builtin_amdgcn_s_memrealtime(); while (__builtin_amdgcn_s_memrealtime() - tb_ < (unsigned long long)mn) __builtin_amdgcn_s_sleep(4); }
#endif
#ifdef TBAR
    { const unsigned long long tb_ = __builtin_amdgcn_s_memrealtime(); while (__builtin_amdgcn_s_memrealtime() - tb_ < tbar_acc) __builtin_amdgcn_s_sleep(4); }
#endif
    if (TPH_MASK) { TPH_MARK(14); const unsigned long long tb_ = __builtin_amdgcn_s_memrealtime(); while (__builtin_amdgcn_s_memrealtime() - tb_ < tph_acc) __builtin_amdgcn_s_sleep(4); }
#undef IN
#undef BOTH
}

extern "C" void kernel_launch(void* const* d_in, const int* in_sizes, int n_in, void* d_out, int out_size, void* d_ws, size_t ws_size, hipStream_t stream) {
    static int grid = 0;
    if (grid == 0) {
        if (n_in != 20 || in_sizes[0] != T * DM || out_size != T * DM || ws_size < WS_END) { fprintf(stderr, "kernel_launch: unexpected shapes (n_in %d, in0 %d, out %d, ws %zu)\n", n_in, n_in > 0 ? in_sizes[0] : -1, out_size, ws_size); grid = -1; return; }
        int dev = 0, cus = 0, per_cu = 0;
        if (hipGetDevice(&dev) != hipSuccess || hipDeviceGetAttribute(&cus, hipDeviceAttributeMultiprocessorCount, dev) != hipSuccess) { grid = -1; return; }
        if (hipFuncSetAttribute((const void*)nsa_fwd, hipFuncAttributeMaxDynamicSharedMemorySize, LDS_BYTES) != hipSuccess) { fprintf(stderr, "kernel_launch: hipFuncSetAttribute failed\n"); grid = -1; return; }
        if (hipOccupancyMaxActiveBlocksPerMultiprocessor(&per_cu, (const void*)nsa_fwd, NWAVES * 64, LDS_BYTES) != hipSuccess || per_cu < 1) fprintf(stderr, "kernel_launch: occupancy query reports %d\n", per_cu);
        (void)hipGetLastError();
        grid = cus;
        if (grid != 256) fprintf(stderr, "kernel_launch: %d CUs (built for 256)\n", grid);
    }
    if (grid < 0) return;
    if (hipMemsetAsync((char*)d_ws + WS_CTL, 0, CTL_ZERO_BYTES, stream) != hipSuccess) return;
    Args a{};
    for (int i = 0; i < 20; ++i) a.in[i] = (const float*)d_in[i];
    a.out = (float*)d_out; a.ws = (unsigned char*)d_ws;
#if MK_PER_PHASE
    for (int p = 0; p < N_PHASES; ++p) { a.ph_lo = p; a.ph_hi = p + 1; a.li = p; hipLaunchKernelGGL(nsa_fwd, dim3(grid), dim3(NWAVES * 64), LDS_BYTES, stream, a); }
#else
    a.ph_lo = 0; a.ph_hi = N_PHASES; a.li = 0;
    hipLaunchKernelGGL(nsa_fwd, dim3(grid), dim3(NWAVES * 64), LDS_BYTES, stream, a);
#endif
}
```

```cpp
#include <hip/hip_runtime.h>
#include <cstdio>
#include <cstdint>
__device__ __forceinline__ int fresh_lane() { int l; asm volatile("v_mbcnt_lo_u32_b32 %0, -1, 0\n\tv_mbcnt_hi_u32_b32 %0, -1, %0" : "=v"(l)); return l; }
namespace pg8 {
#define PG8_LAS __attribute__((address_space(3)))
typedef unsigned short bf16_t;
typedef short bf16x8 __attribute__((ext_vector_type(8)));
typedef float f32x4 __attribute__((ext_vector_type(4)));
typedef unsigned u32x4 __attribute__((ext_vector_type(4)));
constexpr int BM = 256, BK = 64, HALF = 128, HTB = HALF * BK * 2  , STAGE_BYTES = 8 * HTB, NXCD = 8, WGM = 8;

__host__ __device__ __forceinline__ int lds_byte(int r, int c) { const int st = (r >> 4) * 2 + (c >> 5), rr = r & 15, cc = c & 31, ob = rr * 64 + cc * 2; return st * 1024 + (ob ^ (((ob >> 9) & 1) << 5)); }
__host__ __device__ __forceinline__ void stage_rc(int b, int& R, int& C) { const int st = b / 1024, sb = b % 1024, swz = sb ^ (((sb >> 9) & 1) << 5); R = (st >> 1) * 16 + swz / 64; C = (st & 1) * 32 + (swz % 64) / 2; }
__host__ __device__ __forceinline__ int perm32(int rho) { const int n = rho >> 4, i = rho & 15; return 8 * (i >> 2) + 4 * n + (i & 3); }

struct Unit { int pm, pn; };
struct Gemm { const bf16_t* A; const bf16_t* Bt; int M, N, K; int a_gather; };

struct StaticOrder {
    int nM, nN, nwg, G, c;
    __host__ __device__ void init(int M, int N, int G_, int c_) { nM = M / BM; nN = N / BM; nwg = nM * nN; G = G_; c = c_; }
    __host__ __device__ bool next(int i, Unit& u) const {
        const long L = (long)i * G + c; if (L >= nwg) return false;
        int wgid = (int)L; { const int q = nwg / NXCD, r = nwg % NXCD, xcd = wgid % NXCD, off = wgid / NXCD; wgid = (xcd < r ? xcd * (q + 1) : r * (q + 1) + (xcd - r) * q) + off; }
        const int nig = WGM * nN, gid = wgid / nig, fm = gid * WGM, gsz = (nM - fm) < WGM ? (nM - fm) : WGM;
        u.pm = fm + ((wgid % nig) % gsz); u.pn = (wgid % nig) / gsz; return true;
    }
    __device__ __forceinline__ void a_ready(const Unit&) const {}
    __device__ __forceinline__ void done(const Unit&) const {}
};

__device__ __forceinline__ unsigned cvt_pk_bf16(float lo, float hi) { unsigned r; asm volatile("v_cvt_pk_bf16_f32 %0, %1, %2" : "=v"(r) : "v"(lo), "v"(hi)); return r; }
typedef float f32x2 __attribute__((ext_vector_type(2)));
typedef unsigned u32x2 __attribute__((ext_vector_type(2)));
constexpr float RMS_EPS = 1e-6f;
__device__ __forceinline__ float row_rstd(const float* ss, int r) { return __builtin_amdgcn_rsqf(ss[r] * (1.0f / 1024.0f) + RMS_EPS); }

struct EpiRes {
    static constexpr bool PERM = true, AFTER_DRAIN = false;
    bf16_t* xb; float* ss;
    __device__ __forceinline__ void operator()(const f32x4 (&acc)[2][2][4][2], const Unit& u, int wr, int wc, int fr, int fq) const {
        const int col0 = u.pn * BM + wc * 32 + 8 * fq;
#pragma unroll
        for (int ai = 0; ai < 2; ++ai)
#pragma unroll
            for (int m = 0; m < 4; ++m) { const int r = u.pm * BM + ai * HALF + wr * 64 + m * 16 + fr; bf16_t* rowp = xb + (size_t)r * 1024 + col0; float s = 0.f;
#pragma unroll
                for (int bj = 0; bj < 2; ++bj) { const u32x4 b = *(const u32x4*)(rowp + bj * HALF); const f32x4 a0 = acc[ai][bj][m][0], a1 = acc[ai][bj][m][1];
                    const unsigned w0 = cvt_pk_bf16(__uint_as_float(b.x << 16) + a0[0], __uint_as_float(b.x & 0xffff0000u) + a0[1]), w1 = cvt_pk_bf16(__uint_as_float(b.y << 16) + a0[2], __uint_as_float(b.y & 0xffff0000u) + a0[3]);
                    const unsigned w2 = cvt_pk_bf16(__uint_as_float(b.z << 16) + a1[0], __uint_as_float(b.z & 0xffff0000u) + a1[1]), w3 = cvt_pk_bf16(__uint_as_float(b.w << 16) + a1[2], __uint_as_float(b.w & 0xffff0000u) + a1[3]);
                    u32x4 w; w.x = w0; w.y = w1; w.z = w2; w.w = w3; *(u32x4*)(rowp + bj * HALF) = w;
                    const float e0 = __uint_as_float(w0 << 16), e1 = __uint_as_float(w0 & 0xffff0000u), e2 = __uint_as_float(w1 << 16), e3 = __uint_as_float(w1 & 0xffff0000u);
                    const float e4 = __uint_as_float(w2 << 16), e5 = __uint_as_float(w2 & 0xffff0000u), e6 = __uint_as_float(w3 << 16), e7 = __uint_as_float(w3 & 0xffff0000u);
                    s += ((e0 * e0 + e1 * e1) + (e2 * e2 + e3 * e3)) + ((e4 * e4 + e5 * e5) + (e6 * e6 + e7 * e7)); }
                s += __shfl_xor(s, 16); s += __shfl_xor(s, 32);
                if (fq == 0) atomicAdd(ss + r, s); }
    }
};
struct EpiRelu2 {
    static constexpr bool PERM = true, AFTER_DRAIN = false;
    bf16_t* O; int ldc; const float* ss;
    __device__ __forceinline__ void operator()(const f32x4 (&acc)[2][2][4][2], const Unit& u, int wr, int wc, int fr, int fq) const {
        const int col0 = u.pn * BM + wc * 32 + 8 * fq;
#pragma unroll
        for (int ai = 0; ai < 2; ++ai)
#pragma unroll
            for (int m = 0; m < 4; ++m) { const int r = u.pm * BM + ai * HALF + wr * 64 + m * 16 + fr; const float rs = row_rstd(ss, r), s2 = rs * rs; bf16_t* rowp = O + (size_t)r * ldc + col0;
#pragma unroll
                for (int bj = 0; bj < 2; ++bj) { f32x4 v0 = acc[ai][bj][m][0], v1 = acc[ai][bj][m][1];
#pragma unroll
                    for (int j = 0; j < 4; ++j) { const float a = fmaxf(v0[j], 0.f), b = fmaxf(v1[j], 0.f); v0[j] = a * a * s2; v1[j] = b * b * s2; }
                    u32x4 w; w.x = cvt_pk_bf16(v0[0], v0[1]); w.y = cvt_pk_bf16(v0[2], v0[3]); w.z = cvt_pk_bf16(v1[0], v1[1]); w.w = cvt_pk_bf16(v1[2], v1[3]);
                    *(u32x4*)(rowp + bj * HALF) = w; } }
    }
};
struct EpiWin {
    static constexpr bool PERM = true, AFTER_DRAIN = false;
    bf16_t* BG; bf16_t* V; const float* ss;
    __device__ __forceinline__ void operator()(const f32x4 (&acc)[2][2][4][2], const Unit& u, int wr, int wc, int fr, int fq) const {
#pragma unroll
        for (int ai = 0; ai < 2; ++ai)
#pragma unroll
            for (int m = 0; m < 4; ++m) { const int r = u.pm * BM + ai * HALF + wr * 64 + m * 16 + fr; const float rs = row_rstd(ss, r);
                if (u.pn < 4) { bf16_t* rowp = BG + (size_t)r * 1024 + u.pn * BM + wc * 32 + 8 * fq;
#pragma unroll
                    for (int bj = 0; bj < 2; ++bj) { const f32x4 v0 = acc[ai][bj][m][0] * rs, v1 = acc[ai][bj][m][1] * rs;
                        u32x4 w; w.x = cvt_pk_bf16(v0[0], v0[1]); w.y = cvt_pk_bf16(v0[2], v0[3]); w.z = cvt_pk_bf16(v1[0], v1[1]); w.w = cvt_pk_bf16(v1[2], v1[3]);
                        *(u32x4*)(rowp + bj * HALF) = w; }
                } else { bf16_t* rowp = V + (size_t)r * 1024 + (u.pn - 4) * HALF + wc * 32 + 8 * fq; const float s2 = rs * rs;
                    const f32x4 v0 = acc[ai][0][m][0] * acc[ai][1][m][0] * s2, v1 = acc[ai][0][m][1] * acc[ai][1][m][1] * s2;
                    u32x4 w; w.x = cvt_pk_bf16(v0[0], v0[1]); w.y = cvt_pk_bf16(v0[2], v0[3]); w.z = cvt_pk_bf16(v1[0], v1[1]); w.w = cvt_pk_bf16(v1[2], v1[3]);
                    *(u32x4*)rowp = w; } }
    }
};
struct EpiKvq {
    static constexpr bool PERM = true, AFTER_DRAIN = false;
    bf16_t* O; size_t tstride; const float* ss;
    __device__ __forceinline__ void operator()(const f32x4 (&acc)[2][2][4][2], const Unit& u, int wr, int wc, int fr, int fq) const {
        bf16_t* base = O + (size_t)u.pn * tstride + wc * 32 + 8 * fq; const bool sig = (u.pn == 10);
#pragma unroll
        for (int ai = 0; ai < 2; ++ai)
#pragma unroll
            for (int m = 0; m < 4; ++m) { const int r = u.pm * BM + ai * HALF + wr * 64 + m * 16 + fr; const float rs = row_rstd(ss, r); bf16_t* rowp = base + (size_t)r * 256;
#pragma unroll
                for (int bj = 0; bj < 2; ++bj) { f32x4 v0 = acc[ai][bj][m][0] * rs, v1 = acc[ai][bj][m][1] * rs;
                    if (sig) {
#pragma unroll
                        for (int j = 0; j < 4; ++j) { v0[j] = 1.0f / (1.0f + __expf(-v0[j])); v1[j] = 1.0f / (1.0f + __expf(-v1[j])); } }
                    u32x4 w; w.x = cvt_pk_bf16(v0[0], v0[1]); w.y = cvt_pk_bf16(v0[2], v0[3]); w.z = cvt_pk_bf16(v1[0], v1[1]); w.w = cvt_pk_bf16(v1[2], v1[3]);
                    *(u32x4*)(rowp + bj * HALF) = w; } }
    }
};
struct EpiPhi {
    static constexpr bool PERM = true, AFTER_DRAIN = false;
    bf16_t* O; const float* bias;
    __device__ __forceinline__ void operator()(const f32x4 (&acc)[2][2][4][2], const Unit& u, int wr, int wc, int fr, int fq) const {
        const int col0 = wc * 32 + 8 * fq;
        f32x4 bv[2][2];
#pragma unroll
        for (int bj = 0; bj < 2; ++bj)
#pragma unroll
            for (int n = 0; n < 2; ++n) bv[bj][n] = *(const f32x4*)(bias + col0 + bj * HALF + 4 * n);
#pragma unroll
        for (int ai = 0; ai < 2; ++ai)
#pragma unroll
            for (int m = 0; m < 4; ++m) { const int r = u.pm * BM + ai * HALF + wr * 64 + m * 16 + fr; bf16_t* rowp = O + (size_t)r * 256 + col0;
#pragma unroll
                for (int bj = 0; bj < 2; ++bj) { f32x4 v0 = acc[ai][bj][m][0] + bv[bj][0], v1 = acc[ai][bj][m][1] + bv[bj][1];
#pragma unroll
                    for (int j = 0; j < 4; ++j) { v0[j] = v0[j] / (1.0f + __expf(-v0[j])); v1[j] = v1[j] / (1.0f + __expf(-v1[j])); }
                    u32x4 w; w.x = cvt_pk_bf16(v0[0], v0[1]); w.y = cvt_pk_bf16(v0[2], v0[3]); w.z = cvt_pk_bf16(v1[0], v1[1]); w.w = cvt_pk_bf16(v1[2], v1[3]);
                    *(u32x4*)(rowp + bj * HALF) = w; } }
    }
};
struct PhiOrder {
    int c;
    __device__ __forceinline__ bool next(int i, Unit& u) const { if (i > 0 || c >= 64) return false; u.pm = c & 31; u.pn = 0; return true; }
    __device__ __forceinline__ void a_ready(const Unit&) const {}
    __device__ __forceinline__ void done(const Unit&) const {}
};
struct GatesOrder {
    int c;
    __device__ __forceinline__ bool next(int i, Unit& u) const { if (i > 0 || c < 64 || c >= 192) return false; u.pm = c - 64; u.pn = 10; return true; }
    __device__ __forceinline__ void a_ready(const Unit&) const {}
    __device__ __forceinline__ void done(const Unit&) const {}
};
struct GatesAll {
    int c, G;
    __device__ __forceinline__ bool next(int i, Unit& u) const { const int p = i * G + c; if (p >= 128) return false; u.pm = p; u.pn = 10; return true; }
    __device__ __forceinline__ void a_ready(const Unit&) const {}
    __device__ __forceinline__ void done(const Unit&) const {}
};
template <class Epi, class Sched, bool ALIGN_EPI = false, bool SP2 = false>
__device__ __forceinline__ void gemm_phase(PG8_LAS unsigned char* lds, const Gemm g, const Sched& S, const Epi& E, const int wid  ) {
    const int lane = fresh_lane(), tid = wid * 64 + lane, wr = wid >> 2, wc = wid & 3, fr = lane & 15, fq = lane >> 4;
    const int K = g.K, nt = K / BK;
    unsigned voffA[2], voffB[2];
#pragma unroll
    for (int i = 0; i < 2; ++i) { int R, C; stage_rc(tid * 16 + i * 8192, R, C); const int Rb = Epi::PERM ? ((R & ~31) + perm32(R & 31)) : R;
        voffA[i] = g.a_gather ? (unsigned)((R >> 2) * 8192 + (R & 3) * 128 + C * 2) : (unsigned)(R * K + C) * 2u; voffB[i] = (unsigned)(Rb * K + C) * 2u; }
    const size_t kstep = (size_t)(BK * 2);
    const size_t hstep = (size_t)HALF * K * 2;
    const size_t tstep = 2 * hstep;
    const size_t kstepA = g.a_gather ? (size_t)512 : kstep, hstepA = g.a_gather ? (size_t)262144 : hstep, tstepA = g.a_gather ? (size_t)524288 : tstep;
    const unsigned ldsw = (unsigned)wid * 1024u;
    const int aoff = lds_byte(wr * 64 + fr, fq * 8), boff = lds_byte(wc * 32 + fr, fq * 8);
#define PG8_SA(b, h) (((b) * 2 + (h)) * HTB)
#define PG8_SB(b, h) ((4 + (b) * 2 + (h)) * HTB)
#define PG8_STAGE(bufoff, gbase, voff) do { _Pragma("unroll") for (int _i = 0; _i < 2; ++_i) \
        __builtin_amdgcn_global_load_lds((const unsigned*)((const char*)(gbase) + (voff)[_i]), (PG8_LAS unsigned*)(lds + (bufoff) + ldsw + _i * 8192), 16, 0, 0); } while (0)
#define PG8_LDA(dst, b, h) do { _Pragma("unroll") for (int m = 0; m < 4; ++m) _Pragma("unroll") for (int k = 0; k < 2; ++k) dst[m][k] = *(const PG8_LAS bf16x8*)(lds + PG8_SA(b, h) + aoff + m * 2048 + k * 1024); } while (0)
#define PG8_LDB(dst, b, h) do { _Pragma("unroll") for (int n = 0; n < 2; ++n) _Pragma("unroll") for (int k = 0; k < 2; ++k) dst[n][k] = *(const PG8_LAS bf16x8*)(lds + PG8_SB(b, h) + boff + n * 2048 + k * 1024); } while (0)
#define PG8_MMA(ai, bj, At, Bt) do { __builtin_amdgcn_s_setprio(1); _Pragma("unroll") for (int m = 0; m < 4; ++m) _Pragma("unroll") for (int n = 0; n < 2; ++n) _Pragma("unroll") for (int k = 0; k < 2; ++k) \
        acc[ai][bj][m][n] = __builtin_amdgcn_mfma_f32_16x16x32_bf16(Bt[n][k], At[m][k], acc[ai][bj][m][n], 0, 0, 0); __builtin_amdgcn_s_setprio(0); } while (0)
#define PG8_WAIT_V(n) asm volatile("s_waitcnt vmcnt(" #n ")" ::: "memory")
#define PG8_WAIT_L(n) asm volatile("s_waitcnt lgkmcnt(" #n ")" ::: "memory")
#define PG8_BAR __builtin_amdgcn_s_barrier()
#define PG8_SCHED __builtin_amdgcn_sched_barrier(0)
    Unit cur, nxt; int ui = 0;
    if (!S.next(0, cur)) return;
    f32x4 acc[2][2][4][2];
#pragma unroll
    for (int a = 0; a < 2; ++a)
#pragma unroll
        for (int b = 0; b < 2; ++b)
#pragma unroll
            for (int m = 0; m < 4; ++m)
#pragma unroll
                for (int n = 0; n < 2; ++n) acc[a][b][m][n] = (f32x4){0.f, 0.f, 0.f, 0.f};
    bf16x8 At[4][2], B0[2][2], B1[2][2];
    const char* cA = (const char*)g.A + (size_t)cur.pm * tstepA; const char* cB = (const char*)g.Bt + (size_t)cur.pn * tstep;
    S.a_ready(cur);
    if constexpr (SP2) {
        PG8_STAGE(PG8_SB(0, 0), cB, voffB); PG8_STAGE(PG8_SB(0, 1), cB + hstep, voffB); PG8_STAGE(PG8_SA(0, 0), cA, voffA); PG8_STAGE(PG8_SA(0, 1), cA + hstepA, voffA);
        if (wr == 1) PG8_BAR;
        PG8_WAIT_V(2); PG8_BAR;
        PG8_STAGE(PG8_SB(1, 0), cB + kstep, voffB); PG8_STAGE(PG8_SA(1, 0), cA + kstepA, voffA); PG8_STAGE(PG8_SB(1, 1), cB + hstep + kstep, voffB);
        PG8_WAIT_V(6); PG8_BAR;
    } else {
        PG8_STAGE(PG8_SB(0, 0), cB, voffB); PG8_STAGE(PG8_SA(0, 0), cA, voffA); PG8_STAGE(PG8_SB(0, 1), cB + hstep, voffB); PG8_STAGE(PG8_SA(0, 1), cA + hstepA, voffA);
        if (wr == 1) PG8_BAR;
        PG8_WAIT_V(4); PG8_BAR;
        PG8_STAGE(PG8_SB(1, 0), cB + kstep, voffB); PG8_STAGE(PG8_SA(1, 0), cA + kstepA, voffA); PG8_STAGE(PG8_SB(1, 1), cB + hstep + kstep, voffB);
        PG8_WAIT_V(6); PG8_BAR;
    }
    for (;;) {
        const bool has_next = S.next(ui + 1, nxt);
        const char* nA = has_next ? (const char*)g.A + (size_t)nxt.pm * tstepA : cA; const char* nB = has_next ? (const char*)g.Bt + (size_t)nxt.pn * tstep : cB;
        for (int t = 0; t < nt; t += 2) {
            const bool last = (t == nt - 2);
            const char* a1 = cA + (size_t)(t + 1) * kstepA;
            const char* a2 = last ? nA : cA + (size_t)(t + 2) * kstepA; const char* b2 = last ? nB : cB + (size_t)(t + 2) * kstep;
            const char* a3 = a2 + kstepA; const char* b3 = b2 + kstep;
            if (last && has_next) S.a_ready(nxt);
            if constexpr (SP2) {
            PG8_LDB(B0, 0, 0); PG8_LDB(B1, 0, 1); PG8_SCHED; PG8_LDA(At, 0, 0); PG8_STAGE(PG8_SA(1, 1), a1 + hstepA, voffA);
            PG8_WAIT_V(8); PG8_WAIT_L(0); PG8_BAR; PG8_MMA(0, 0, At, B0); PG8_MMA(0, 1, At, B1); PG8_BAR; PG8_SCHED;
            PG8_LDA(At, 0, 1); PG8_STAGE(PG8_SB(0, 0), b2, voffB); PG8_STAGE(PG8_SB(0, 1), b2 + hstep, voffB); PG8_STAGE(PG8_SA(0, 0), a2, voffA);
            PG8_WAIT_V(8); PG8_WAIT_L(0); PG8_BAR; PG8_MMA(1, 0, At, B0); PG8_MMA(1, 1, At, B1); PG8_BAR; PG8_SCHED;
            PG8_LDB(B0, 1, 0); PG8_LDB(B1, 1, 1); PG8_SCHED; PG8_LDA(At, 1, 0); PG8_STAGE(PG8_SA(0, 1), a2 + hstepA, voffA);
            PG8_WAIT_V(8); PG8_WAIT_L(0); PG8_BAR; PG8_MMA(0, 0, At, B0); PG8_MMA(0, 1, At, B1); PG8_BAR; PG8_SCHED;
            PG8_LDA(At, 1, 1); PG8_STAGE(PG8_SB(1, 0), b3, voffB); PG8_STAGE(PG8_SB(1, 1), b3 + hstep, voffB); PG8_STAGE(PG8_SA(1, 0), a3, voffA);
            PG8_WAIT_V(8); PG8_WAIT_L(0); PG8_BAR; PG8_MMA(1, 0, At, B0); PG8_MMA(1, 1, At, B1); PG8_BAR; PG8_SCHED;
            } else {
            PG8_LDB(B0, 0, 0); PG8_SCHED; PG8_LDA(At, 0, 0); PG8_STAGE(PG8_SA(1, 1), a1 + hstepA, voffA);
            PG8_WAIT_L(8); PG8_BAR; PG8_WAIT_L(0); PG8_MMA(0, 0, At, B0); PG8_BAR; PG8_SCHED;
            PG8_LDB(B1, 0, 1); PG8_STAGE(PG8_SB(0, 0), b2, voffB);
            PG8_BAR; PG8_WAIT_L(0); PG8_MMA(0, 1, At, B1); PG8_BAR;
            PG8_LDA(At, 0, 1); PG8_STAGE(PG8_SA(0, 0), a2, voffA);
            PG8_BAR; PG8_WAIT_L(0); PG8_MMA(1, 0, At, B0); PG8_BAR; PG8_SCHED;
            PG8_STAGE(PG8_SB(0, 1), b2 + hstep, voffB);
            PG8_WAIT_V(6); PG8_BAR; PG8_MMA(1, 1, At, B1); PG8_BAR;
            PG8_LDB(B0, 1, 0); PG8_SCHED; PG8_LDA(At, 1, 0); PG8_STAGE(PG8_SA(0, 1), a2 + hstepA, voffA);
            PG8_WAIT_L(8); PG8_BAR; PG8_WAIT_L(0); PG8_MMA(0, 0, At, B0); PG8_BAR; PG8_SCHED;
            PG8_LDB(B1, 1, 1); PG8_STAGE(PG8_SB(1, 0), b3, voffB);
            PG8_BAR; PG8_WAIT_L(0); PG8_MMA(0, 1, At, B1); PG8_BAR;
            PG8_LDA(At, 1, 1); PG8_STAGE(PG8_SA(1, 0), a3, voffA);
            PG8_BAR; PG8_WAIT_L(0); PG8_MMA(1, 0, At, B0); PG8_BAR; PG8_SCHED;
            PG8_STAGE(PG8_SB(1, 1), b3 + hstep, voffB);
            PG8_WAIT_V(6); PG8_BAR; PG8_MMA(1, 1, At, B1); PG8_BAR;
            }
        }
        if constexpr (ALIGN_EPI) { if (wr == 0) PG8_BAR; }
        if constexpr (!Epi::AFTER_DRAIN) { E(acc, cur, wr, wc, fr, fq); S.done(cur); }
        if (!has_next) break;
#pragma unroll
        for (int a = 0; a < 2; ++a)
#pragma unroll
            for (int b = 0; b < 2; ++b)
#pragma unroll
                for (int m = 0; m < 4; ++m)
#pragma unroll
                    for (int n = 0; n < 2; ++n) acc[a][b][m][n] = (f32x4){0.f, 0.f, 0.f, 0.f};
        cur = nxt; cA = nA; cB = nB; ++ui;
        if constexpr (ALIGN_EPI) { if (wr == 1) PG8_BAR; }
    }
    PG8_WAIT_V(0);
    if constexpr (!ALIGN_EPI) { if (wr == 0) PG8_BAR; }
    PG8_BAR;
    if constexpr (Epi::AFTER_DRAIN) { E.fused(acc, cur, wr, wc, fr, fq, lds, wid, lane); S.done(cur); }
#undef PG8_SA
#undef PG8_SB
#undef PG8_STAGE
#undef PG8_LDA
#undef PG8_LDB
#undef PG8_MMA
#undef PG8_WAIT_V
#undef PG8_WAIT_L
#undef PG8_BAR
#undef PG8_SCHED
}
}

constexpr int NWAVES = 8;
constexpr int BATCH = 4, SEQ = 8192, DM = 1024, T = BATCH * SEQ, FF = 4096, NH = 16, HD = 64, NG = 4;
constexpr int NKVQ = 2816;
constexpr int PHI_ROWS = 8192;
constexpr size_t MiB = 1u << 20;
constexpr size_t WS_CTL = 0, CTL_ZERO_BYTES = 2 * MiB;
constexpr size_t WS_SS = 1 * MiB;
constexpr size_t WS_PHIB = WS_SS + 5 * 128 * 1024;
constexpr size_t WS_WIN = 2 * MiB, WS_WOUT = 8 * MiB, WS_W1 = 10 * MiB  , WS_W2 = 26 * MiB  , WS_WKVQ = 42 * MiB  , WS_WO = 48 * MiB, WS_PW1 = 50 * MiB  ;
constexpr size_t WS_KCMP = 53 * MiB, WS_VCMP = 54 * MiB;
constexpr size_t WS_PHIH = 56 * MiB;
constexpr size_t WS_XB = 64 * MiB;
constexpr size_t WS_H = 128 * MiB;
constexpr size_t WS_BG = 128 * MiB, WS_V = 192 * MiB;
constexpr size_t WS_KVQ = 128 * MiB, KVQ_TSTRIDE = (size_t)T * 256;
constexpr size_t WS_O = 448 * MiB;
constexpr size_t WS_SELM = 384 * MiB;
constexpr size_t WS_VT = 400 * MiB;
constexpr size_t WS_END = 512 * MiB;
static_assert(WS_KVQ + 11 * KVQ_TSTRIDE * 2 <= WS_H + (size_t)T * FF * 2 && WS_H + (size_t)T * FF * 2 <= 384 * MiB && WS_O + (size_t)T * 1024 * 2 <= WS_END, "ws map");
constexpr int CW_BAR = 4096;
constexpr int RING_OFF = 0, RING_BYTES = 131072;
constexpr int LDS_BYTES = 163840;
constexpr int LDSCTL_OFF = LDS_BYTES - 512, MISC_OFF = LDSCTL_OFF + 320;
#define GAS __attribute__((address_space(1)))
#define LAS __attribute__((address_space(3)))
typedef unsigned short bf16;
typedef unsigned v4u __attribute__((ext_vector_type(4)));
typedef float f32x4 __attribute__((ext_vector_type(4)));
typedef short bf16x8 __attribute__((ext_vector_type(8)));
typedef GAS unsigned gu32;
typedef GAS unsigned long long gu64;
#define RLX_AGENT __ATOMIC_RELAXED, __HIP_MEMORY_SCOPE_AGENT
#define LDS_WAIT() asm volatile("s_waitcnt lgkmcnt(0)" ::: "memory")
#define VM_WAIT() asm volatile("s_waitcnt vmcnt(0)" ::: "memory")
__device__ __forceinline__ unsigned long long rt() { return __builtin_amdgcn_s_memrealtime(); }
__device__ __forceinline__ unsigned f2bf(float f) { unsigned u = __builtin_bit_cast(unsigned, f); return (u + 0x7fffu + ((u >> 16) & 1u)) >> 16; }
__device__ __forceinline__ unsigned pk2(float lo, float hi) { return f2bf(lo) | (f2bf(hi) << 16); }

#define XB_TMO      128
#define XB_XCNT(j)  (256  + 64 * (j))
#define XB_XSUB(j)  (1280 + 64 * (j))
#define XB_XGEN(j)  (2304 + 64 * (j))
#define XB_TOP      3328
#define XB_TOPGEN   3392
#define XCD_BAR_WORDS 3456
#define XB_SPIN_CAP (1u << 18)

__device__ __forceinline__ unsigned xb_ld(unsigned* p)              { return __hip_atomic_load(p, __ATOMIC_RELAXED, __HIP_MEMORY_SCOPE_AGENT); }
__device__ __forceinline__ unsigned xb_add(unsigned* p, unsigned v) { return __hip_atomic_fetch_add(p, v, __ATOMIC_RELAXED, __HIP_MEMORY_SCOPE_AGENT); }
__device__ __forceinline__ unsigned xb_xcc_id() { return (unsigned)__builtin_amdgcn_s_getreg((3 << 11) | 20) & 0xFu; }
#define XB_SPIN(cond, bar) do { unsigned _sp = 0; while (cond) { __builtin_amdgcn_s_sleep(1); \
    if ((++_sp & 255u) == 0u) { if (xb_ld(&(bar)[XB_TMO])) break; if (_sp > XB_SPIN_CAP) { atomicAdd(&(bar)[XB_TMO], 1u); break; } } } } while (0)

struct XcdBarrier {
    unsigned* bar; unsigned x; unsigned G;
    volatile LAS unsigned* st;
};

__device__ __forceinline__ XcdBarrier xcd_barrier_post(unsigned* bar, volatile LAS unsigned* st, bool leader  , unsigned G  ) {
    XcdBarrier b; b.bar = bar; b.x = xb_xcc_id(); b.st = st; b.G = G;
    if (leader) (void)xb_add(&bar[XB_XCNT(b.x)], 1u);
    return b;
}
__device__ __forceinline__ void xcd_barrier_complete(unsigned* bar, unsigned x, unsigned& nloc, unsigned& nx, const unsigned G) {
    unsigned sum, cnt, mine, sp = 0u;
    for (;;) {
        sum = 0u; cnt = 0u; mine = 0u;
#pragma unroll
        for (unsigned j = 0; j < 16; ++j) { const unsigned c = xb_ld(&bar[XB_XCNT(j)]); sum += c; cnt += (c > 0u) ? 1u : 0u; mine = (j == x) ? c : mine; }
        if (sum == G) break;
        __builtin_amdgcn_s_sleep(1);
        if ((++sp & 255u) == 0u) { if (xb_ld(&bar[XB_TMO])) break; if (sp > XB_SPIN_CAP) { atomicAdd(&bar[XB_TMO], 1u); break; } }
    }
    nloc = mine > 0u ? mine : 1u; nx = cnt > 0u ? cnt : 1u;
}

__device__ __forceinline__ void xcd_barrier(const XcdBarrier& b, bool leader  ) {
    asm volatile("s_waitcnt vmcnt(0)" ::: "memory");
    __syncthreads();
    if (leader) {
        unsigned* bar = b.bar;
        __builtin_amdgcn_s_waitcnt(0);
        unsigned nloc = b.st[0], nx = b.st[1];
        if (nloc == 0u) { xcd_barrier_complete(bar, b.x, nloc, nx, b.G); b.st[0] = nloc; b.st[1] = nx; }
        const unsigned old = xb_add(&bar[XB_XSUB(b.x)], 1u);
        const unsigned gen = old / nloc;
        if (old + 1u == (gen + 1u) * nloc) {
            __builtin_amdgcn_fence(__ATOMIC_RELEASE, "agent");
            asm volatile("s_waitcnt vmcnt(0)" ::: "memory");
            const unsigned og = xb_add(&bar[XB_TOP], 1u);
            const unsigned tg = og / nx;
            if (og + 1u == (tg + 1u) * nx) xb_add(&bar[XB_TOPGEN], 1u);
            else XB_SPIN(xb_ld(&bar[XB_TOPGEN]) == tg, bar);
            __builtin_amdgcn_fence(__ATOMIC_ACQUIRE, "agent");
            xb_add(&bar[XB_XGEN(b.x)], 1u);
            asm volatile("s_waitcnt vmcnt(0)" ::: "memory");
        } else {
            XB_SPIN(xb_ld(&bar[XB_XGEN(b.x)]) == gen, bar);
            __builtin_amdgcn_fence(__ATOMIC_ACQUIRE, "agent");
            asm volatile("s_waitcnt vmcnt(0)" ::: "memory");
        }
    }
    __syncthreads();
}

struct Frame {
    LAS unsigned char* lds;
    volatile LAS unsigned* MISC;
    gu32* ctl;
    int tid, lane, wave;
    int vcu, G;
    const float* const* in;
    float* out; unsigned char* ws;
};
__device__ __forceinline__ float wave_sum(float v) {
#pragma unroll
    for (int o = 1; o < 64; o <<= 1) v += __shfl_xor(v, o);
    return v;
}
__device__ __forceinline__ float wave_max(float v) {
#pragma unroll
    for (int o = 1; o < 64; o <<= 1) v = fmaxf(v, __shfl_xor(v, o));
    return v;
}
__device__ __forceinline__ float bf2f(unsigned short b) { return __uint_as_float(((unsigned)b) << 16); }
__device__ __forceinline__ float bflo(unsigned w) { return __uint_as_float(w << 16); }
__device__ __forceinline__ float bfhi(unsigned w) { return __uint_as_float(w & 0xffff0000u); }

__device__ __forceinline__ void p0_transpose_item(const float* W, int ldw, int nvalid, const float* gain, float scale, bf16* WT, int K, int drow, int k0, int n0, LAS float* scr, int lane) {
    float wv[32];
#pragma unroll
    for (int i = 0; i < 32; ++i) { const int kk = 2 * i + (lane >> 5), n = n0 + (lane & 31); wv[i] = (n < nvalid) ? W[(size_t)(k0 + kk) * ldw + n] : 0.f; }
#pragma unroll
    for (int i = 0; i < 32; ++i) { const int kk = 2 * i + (lane >> 5); float v = wv[i]; if (gain) v *= gain[k0 + kk]; scr[kk * 33 + (lane & 31)] = v * scale; }
    LDS_WAIT(); asm volatile("" ::: "memory");
    const int c = lane & 7;
#pragma unroll
    for (int j = 0; j < 4; ++j) { const int n = (lane >> 3) + 8 * j; const LAS float* s = scr + (8 * c) * 33 + n;
        v4u o; o.x = pk2(s[0 * 33], s[1 * 33]); o.y = pk2(s[2 * 33], s[3 * 33]); o.z = pk2(s[4 * 33], s[5 * 33]); o.w = pk2(s[6 * 33], s[7 * 33]);
        *(GAS v4u*)(WT + (size_t)(drow + n) * K + k0 + 8 * c) = o; }
    LDS_WAIT(); asm volatile("" ::: "memory");
}
struct MatSpec { const float* W; int K, ldw, nvalid, niter; const float* gain; bf16* WT; int kind; };
__device__ __forceinline__ void p0_matrix_item(const MatSpec& m, int item, LAS float* scr, int lane) {
    const int nblk = m.niter / 32, kb = item / nblk, nb = item % nblk, k0 = 64 * kb, n0 = 32 * nb;
    int drow = n0; float scale = 1.f;
    if (m.kind == 1) { if (n0 >= 1024) { const int isu = n0 >= 2048, j = n0 - (isu ? 2048 : 1024); drow = 1024 + (j >> 7) * 256 + isu * 128 + (j & 127); } }
    else if (m.kind == 2) { if (n0 < 1024) { drow = 1536 + n0; scale = 0.125f; } else drow = 2560 + (n0 - 1024); }
    p0_transpose_item(m.W, m.ldw, m.nvalid, m.gain, scale, m.WT, m.K, drow, k0, n0, scr, lane);
}
__device__ __forceinline__ void p0_prologue(Frame& F) {
    LAS float* scr = (LAS float*)(F.lds + RING_OFF + F.wave * 16384);
    const int gw = F.vcu * NWAVES + F.wave, NGW = F.G * NWAVES;
    unsigned char* ws = F.ws;
    int it = gw;
#define DO_MAT(...) do { const MatSpec m_ = MatSpec{__VA_ARGS__}; const int n_ = (m_.K / 64) * (m_.niter / 32); _Pragma("unroll 1") for (; it < n_; it += NGW) p0_matrix_item(m_, it, scr, F.lane); it -= n_; } while (0)
    DO_MAT(F.in[6],  1024, 3072, 3072, 3072, F.in[2],           (bf16*)(ws + WS_WIN), 1);
    DO_MAT(F.in[8],  1024, 1024, 1024, 1024, nullptr,           (bf16*)(ws + WS_WOUT), 0);
    DO_MAT(F.in[4],  1024, 4096, 4096, 4096, F.in[3],           (bf16*)(ws + WS_W1), 0);
    DO_MAT(F.in[4] + (size_t)1024 * 4096, 1024, 4096, 4096, 4096, F.in[3] + 1024, (bf16*)(ws + WS_W1 + 8 * MiB), 0);
    DO_MAT(F.in[5],  4096, 1024, 1024, 1024, nullptr,           (bf16*)(ws + WS_W2), 0);
    DO_MAT(F.in[5] + (size_t)4096 * 1024, 4096, 1024, 1024, 1024, nullptr, (bf16*)(ws + WS_W2 + 8 * MiB), 0);
    DO_MAT(F.in[10], 1024, 1536, 1536, 1536, F.in[9],           (bf16*)(ws + WS_WKVQ), 0);
    DO_MAT(F.in[17], 1024, 1072, 1072, 1280, F.in[2] + 1024,    (bf16*)(ws + WS_WKVQ), 2);
    DO_MAT(F.in[18], 1024, 1024, 1024, 1024, nullptr,           (bf16*)(ws + WS_WO), 0);
    DO_MAT(F.in[13], 2048, 256, 256, 256, nullptr,              (bf16*)(ws + WS_PW1), 0);
    DO_MAT(F.in[15], 2048, 256, 256, 256, nullptr,              (bf16*)(ws + WS_PW1 + 1 * MiB), 0);
#undef DO_MAT
    { bf16* XB = (bf16*)(ws + WS_XB); float* ss0 = (float*)(ws + WS_SS);
      for (int m = gw; m < T; m += 2 * NGW) { const int m2 = m + NGW;
          const GAS f32x4* xr = (const GAS f32x4*)(F.in[0] + (size_t)m * DM) + F.lane; const GAS f32x4* xr2 = (const GAS f32x4*)(F.in[0] + (size_t)m2 * DM) + F.lane;
          GAS unsigned long long* o8 = (GAS unsigned long long*)(XB + (size_t)m * DM) + F.lane; GAS unsigned long long* o82 = (GAS unsigned long long*)(XB + (size_t)m2 * DM) + F.lane;
          f32x4 va[4], vb[4];
#pragma unroll
          for (int j = 0; j < 4; ++j) { va[j] = xr[64 * j]; vb[j] = xr2[64 * j]; }
          float s = 0.f, s2 = 0.f;
#pragma unroll
          for (int j = 0; j < 4; ++j) { const f32x4 v = va[j], w = vb[j];
              const unsigned long long pa = (unsigned long long)pk2(v.x, v.y) | ((unsigned long long)pk2(v.z, v.w) << 32), pb = (unsigned long long)pk2(w.x, w.y) | ((unsigned long long)pk2(w.z, w.w) << 32);
              o8[64 * j] = pa; o82[64 * j] = pb;
              const float a0 = bflo((unsigned)pa), a1 = bfhi((unsigned)pa), a2 = bflo((unsigned)(pa >> 32)), a3 = bfhi((unsigned)(pa >> 32)); s += (a0 * a0 + a1 * a1) + (a2 * a2 + a3 * a3);
              const float b0 = bflo((unsigned)pb), b1 = bfhi((unsigned)pb), b2 = bflo((unsigned)(pb >> 32)), b3 = bfhi((unsigned)(pb >> 32)); s2 += (b0 * b0 + b1 * b1) + (b2 * b2 + b3 * b3); }
          s = wave_sum(s); s2 = wave_sum(s2); if (F.lane == 0) { ss0[m] = s; ss0[m2] = s2; } } }
    { float* pb = (float*)(ws + WS_PHIB);
      for (int task = gw; task < 2 * 32 * 4; task += NGW) { const int side = task >> 7, kc = (task >> 2) & 31, cc = task & 3; const float* pe = F.in[side ? 12 : 11]; const float* w1 = F.in[side ? 15 : 13]; float a = 0.f;
          for (int kk = kc * 64; kk < kc * 64 + 64; ++kk) a += pe[kk] * w1[(size_t)kk * 256 + cc * 64 + F.lane];
          atomicAdd(pb + side * 256 + cc * 64 + F.lane, a); } }
}
__device__ __forceinline__ void conv_gate_phase(Frame& F) {
    bf16* BG = (bf16*)(F.ws + WS_BG); const bf16* V = (const bf16*)(F.ws + WS_V); const float* cw = F.in[7];
    const bool grp = (F.G == 256); const int rbase = grp ? (F.vcu >> 5) * 4096 * 128 : 0, nit = grp ? 4096 * 128 : T * 128;
    const int gt = (grp ? (F.vcu & 31) : F.vcu) * (NWAVES * 64) + F.tid, NGT = (grp ? 32 : F.G) * NWAVES * 64;
    const int c0 = (gt & 127) * 8;
    float w0[8], w1[8], w2[8];
#pragma unroll
    for (int j = 0; j < 8; ++j) { w0[j] = cw[c0 + j]; w1[j] = cw[1024 + c0 + j]; w2[j] = cw[2048 + c0 + j]; }
    const v4u z = {0u, 0u, 0u, 0u};
    for (int it = gt; it < nit; it += 2 * NGT) { const int rowa = (rbase + it) >> 7, rowb = (rbase + it + NGT) >> 7, ta = rowa & (SEQ - 1), tb = rowb & (SEQ - 1);
        const v4u a2 = *(const v4u*)(V + (size_t)rowa * 1024 + c0), a1 = ta >= 1 ? *(const v4u*)(V + (size_t)(rowa - 1) * 1024 + c0) : z, a0 = ta >= 2 ? *(const v4u*)(V + (size_t)(rowa - 2) * 1024 + c0) : z, ba = *(const v4u*)(BG + (size_t)rowa * 1024 + c0);
        const v4u b2 = *(const v4u*)(V + (size_t)rowb * 1024 + c0), b1 = tb >= 1 ? *(const v4u*)(V + (size_t)(rowb - 1) * 1024 + c0) : z, b0 = tb >= 2 ? *(const v4u*)(V + (size_t)(rowb - 2) * 1024 + c0) : z, bb = *(const v4u*)(BG + (size_t)rowb * 1024 + c0);
        v4u oa, ob;
#pragma unroll
        for (int j = 0; j < 4; ++j) {
            oa[j] = pk2(bflo(ba[j]) * (w0[2 * j] * bflo(a0[j]) + w1[2 * j] * bflo(a1[j]) + w2[2 * j] * bflo(a2[j])), bfhi(ba[j]) * (w0[2 * j + 1] * bfhi(a0[j]) + w1[2 * j + 1] * bfhi(a1[j]) + w2[2 * j + 1] * bfhi(a2[j])));
            ob[j] = pk2(bflo(bb[j]) * (w0[2 * j] * bflo(b0[j]) + w1[2 * j] * bflo(b1[j]) + w2[2 * j] * bflo(b2[j])), bfhi(bb[j]) * (w0[2 * j + 1] * bfhi(b0[j]) + w1[2 * j + 1] * bfhi(b1[j]) + w2[2 * j + 1] * bfhi(b2[j]))); }
        *(v4u*)(BG + (size_t)rowa * 1024 + c0) = oa; *(v4u*)(BG + (size_t)rowb * 1024 + c0) = ob; }
}
__device__ __forceinline__ void phi2_phase(Frame& F, int task0, int tstep, int tend) {
    LAS float* hs = (LAS float*)(F.lds + RING_OFF + F.wave * 8192);
    for (int task = task0; task < tend; task += tstep) { const int side = task / (PHI_ROWS / 8), r0 = (task % (PHI_ROWS / 8)) * 8;
        const bf16* H = (const bf16*)(F.ws + WS_PHIH) + (size_t)side * PHI_ROWS * 256 + (size_t)r0 * 256; const float* w2 = F.in[side ? 16 : 14];
#pragma unroll
        for (int j = 0; j < 4; ++j) { const v4u w = *(const v4u*)(H + F.lane * 32 + j * 8);
#pragma unroll
            for (int q = 0; q < 4; ++q) { hs[F.lane * 32 + j * 8 + 2 * q] = bflo(w[q]); hs[F.lane * 32 + j * 8 + 2 * q + 1] = bfhi(w[q]); } }
        LDS_WAIT(); asm volatile("" ::: "memory");
        float acc[8] = {0.f, 0.f, 0.f, 0.f, 0.f, 0.f, 0.f, 0.f};
        for (int c = 0; c < 256; c += 4) { const float wa = w2[(c + 0) * 64 + F.lane], wb = w2[(c + 1) * 64 + F.lane], wc = w2[(c + 2) * 64 + F.lane], wd = w2[(c + 3) * 64 + F.lane];
#pragma unroll
            for (int i = 0; i < 8; ++i) { const f32x4 h = *(const LAS f32x4*)(hs + i * 256 + c); acc[i] += h.x * wa + h.y * wb + h.z * wc + h.w * wd; } }
        bf16* O = (bf16*)(F.ws + (side ? WS_VCMP : WS_KCMP));
#pragma unroll
        for (int i = 0; i < 8; ++i) O[(size_t)(r0 + i) * 64 + F.lane] = (bf16)f2bf(acc[i]);
        LDS_WAIT(); asm volatile("" ::: "memory"); }
}
__device__ __forceinline__ void vsel_transpose_phase(Frame& F, int task0, int tstep) {
    LAS unsigned short* ts = (LAS unsigned short*)(F.lds + RING_OFF + F.wave * 16384);
    const int lane = F.lane;
    const bf16* VSEL = (const bf16*)(F.ws + WS_KVQ) + 3 * KVQ_TSTRIDE; bf16* VT = (bf16*)(F.ws + WS_VT);
    const int key = lane, s = key >> 5, k5 = key & 31, e = ((k5 >> 4) << 2) | (k5 & 3), q4 = (k5 >> 2) & 3, slot = 32 * s + 8 * q4 + e;
    for (int task = task0; task < BATCH * NG * 128; task += tstep) { const int blk = task & 127, g = (task >> 7) & 3, b = task >> 9;
        const v4u* src = (const v4u*)(VSEL + ((size_t)b * SEQ + 64 * blk + key) * 256 + g * 64);
#pragma unroll
        for (int c = 0; c < 8; ++c) { const v4u w = src[c];
#pragma unroll
            for (int q = 0; q < 4; ++q) { ts[(8 * c + 2 * q) * 72 + slot] = (unsigned short)(w[q] & 0xffffu); ts[(8 * c + 2 * q + 1) * 72 + slot] = (unsigned short)(w[q] >> 16); } }
        LDS_WAIT(); asm volatile("" ::: "memory");
        v4u* dst = (v4u*)(VT + (size_t)task * 4096 + lane * 64);
#pragma unroll
        for (int c = 0; c < 8; ++c) dst[c] = *(const LAS v4u*)(ts + lane * 72 + 8 * c);
        LDS_WAIT(); asm volatile("" ::: "memory"); }
}
__device__ __forceinline__ void final_norm_phase(Frame& F) {
    const bool grp = (F.G == 256); const int mbase = grp ? (F.vcu >> 5) * 4096 : 0, mend = grp ? mbase + 4096 : T;
    const int gw = mbase + (grp ? (F.vcu & 31) : F.vcu) * NWAVES + F.wave, NGW = (grp ? 32 : F.G) * NWAVES; const float* ss = (const float*)(F.ws + WS_SS) + 4 * T; const float* gn = F.in[19]; const bf16* XB = (const bf16*)(F.ws + WS_XB);
    f32x4 g4[4];
#pragma unroll
    for (int j = 0; j < 4; ++j) g4[j] = *((const f32x4*)gn + F.lane + 64 * j);
    for (int m = gw; m < mend; m += 2 * NGW) { const int m2 = m + NGW;
        GAS f32x4* xr = (GAS f32x4*)(F.out + (size_t)m * DM) + F.lane; GAS f32x4* xr2 = (GAS f32x4*)(F.out + (size_t)m2 * DM) + F.lane;
        const GAS unsigned long long* xs = (const GAS unsigned long long*)(XB + (size_t)m * DM) + F.lane; const GAS unsigned long long* xs2 = (const GAS unsigned long long*)(XB + (size_t)m2 * DM) + F.lane;
        unsigned long long wa[4], wb[4];
#pragma unroll
        for (int j = 0; j < 4; ++j) { wa[j] = xs[64 * j]; wb[j] = xs2[64 * j]; }
        const float rs = __builtin_amdgcn_rsqf(ss[m] * (1.0f / 1024.0f) + 1e-6f), rs2 = __builtin_amdgcn_rsqf(ss[m2] * (1.0f / 1024.0f) + 1e-6f);
#pragma unroll
        for (int j = 0; j < 4; ++j) { f32x4 v = (f32x4){bflo((unsigned)wa[j]), bfhi((unsigned)wa[j]), bflo((unsigned)(wa[j] >> 32)), bfhi((unsigned)(wa[j] >> 32))}; xr[64 * j] = v * rs * g4[j];
            f32x4 w = (f32x4){bflo((unsigned)wb[j]), bfhi((unsigned)wb[j]), bflo((unsigned)(wb[j] >> 32)), bfhi((unsigned)(wb[j] >> 32))}; xr2[64 * j] = w * rs2 * g4[j]; } }
}

__device__ __forceinline__ int t5_bucket_dev(int d) {
    if (d < 16) return d;
    int b = 16;
    b += (d >= 19); b += (d >= 21); b += (d >= 24); b += (d >= 27); b += (d >= 31); b += (d >= 35); b += (d >= 40); b += (d >= 46);
    b += (d >= 52); b += (d >= 59); b += (d >= 67); b += (d >= 77); b += (d >= 87); b += (d >= 99); b += (d >= 113);
    return b;
}
__device__ __forceinline__ void build_bias_table(Frame& F, LAS float* BT) {
    for (int i = F.tid; i < 128 * 16; i += NWAVES * 64) BT[i] = F.in[1][t5_bucket_dev(i >> 4) * 16 + (i & 15)];
}
__device__ __forceinline__ void attn_naive_phase(Frame& F, bf16* O) {
    LAS float* BT = (LAS float*)(F.lds + RING_OFF);
    LAS float* qs = (LAS float*)(F.lds + RING_OFF + 8192 + F.wave * 4096);
    LAS float* imp = qs + 256;
    LAS int* selb = (LAS int*)(imp + 512);
    LAS float* MC = (LAS float*)(selb + 16);
    LAS float* LG = (LAS float*)(F.lds + RING_OFF + 8192 + 8 * 4096 + F.wave * 8192);
    build_bias_table(F, BT);
    __syncthreads();
    const bf16* KVQ = (const bf16*)(F.ws + WS_KVQ);
    const bf16* GATES = KVQ + 10 * KVQ_TSTRIDE; const bf16* KCMP = (const bf16*)(F.ws + WS_KCMP); const bf16* VCMP = (const bf16*)(F.ws + WS_VCMP);
    const int gw = F.vcu * NWAVES + F.wave, NGW = F.G * NWAVES, lane0 = F.lane;
#pragma unroll 1
    for (int task = gw; task < T * NG; task += NGW) {
        int lane = lane0; asm volatile("" : "+v"(lane));
        const int row = task >> 2, g = task & 3, b = row >> 13, pos = row & (SEQ - 1);
        { const bf16* qp = KVQ + (size_t)(6 + g) * KVQ_TSTRIDE + (size_t)row * 256 + lane * 4; const unsigned long long w = *(const unsigned long long*)qp;
          qs[lane * 4 + 0] = bflo((unsigned)w); qs[lane * 4 + 1] = bfhi((unsigned)w); qs[lane * 4 + 2] = bflo((unsigned)(w >> 32)); qs[lane * 4 + 3] = bfhi((unsigned)(w >> 32)); }
        LDS_WAIT(); asm volatile("" ::: "memory");
        const int nv = pos >= 31 ? ((pos - 31) >> 4) + 1 : 0;
        float oacc[4] = {0.f, 0.f, 0.f, 0.f};
#pragma unroll 1
        for (int br = 0; br < 3; ++br) {
            const bf16* Kt = br == 0 ? KCMP : KVQ + (size_t)(br == 1 ? 2 : 4) * KVQ_TSTRIDE; const bf16* Vt = br == 0 ? VCMP : KVQ + (size_t)(br == 1 ? 3 : 5) * KVQ_TSTRIDE;
            const int nc = br == 0 ? (nv + 63) >> 6 : (br == 1 ? 16 : 8);
            float m[4] = {-1e30f, -1e30f, -1e30f, -1e30f}, Z[4] = {0.f, 0.f, 0.f, 0.f}, o[4] = {0.f, 0.f, 0.f, 0.f};
#pragma unroll 1
            for (int c = 0; c < nc; ++c) { asm volatile("" ::: "memory");
                int ridx, dist; bool valid;
                if (br == 0) { const int n = c * 64 + lane; ridx = b * 512 + n; dist = pos - 16 * n - 31; valid = n < nv; }
                else if (br == 1) { const int bk = selb[c]; const int tok = bk * 64 + lane; ridx = b * SEQ + tok; dist = pos - tok; valid = (bk >= 0) && dist >= 0; }
                else { const int kp = pos - 511 + c * 64 + lane; ridx = b * SEQ + kp; dist = pos - kp; valid = kp >= 0; }
                const unsigned long long vmask = __ballot(valid);
                if (vmask == 0ull) continue;
                float l[4] = {0.f, 0.f, 0.f, 0.f};
                if (valid) { const v4u* kr = (const v4u*)(Kt + (size_t)ridx * 256 + g * 64);
#pragma unroll 2
                    for (int j = 0; j < 8; ++j) { asm volatile("" ::: "memory"); const v4u w = kr[j]; float f[8];
#pragma unroll
                        for (int q = 0; q < 4; ++q) { f[2 * q] = bflo(w[q]); f[2 * q + 1] = bfhi(w[q]); }
#pragma unroll
                        for (int h = 0; h < 4; ++h) { const f32x4 qa = *(const LAS f32x4*)(qs + h * 64 + 8 * j), qb = *(const LAS f32x4*)(qs + h * 64 + 8 * j + 4);
                            l[h] += (f[0] * qa.x + f[1] * qa.y) + (f[2] * qa.z + f[3] * qa.w) + (f[4] * qb.x + f[5] * qb.y) + (f[6] * qb.z + f[7] * qb.w); } }
                    const int dd = dist < 127 ? dist : 127;
#pragma unroll
                    for (int h = 0; h < 4; ++h) l[h] += BT[dd * 16 + g * 4 + h]; }
                float p[4];
#pragma unroll
                for (int h = 0; h < 4; ++h) { const float lv = valid ? l[h] : -1e30f; const float mn = fmaxf(m[h], wave_max(lv)); const float sc = __expf(m[h] - mn);
                    p[h] = valid ? __expf(lv - mn) : 0.f; Z[h] = Z[h] * sc + wave_sum(p[h]); o[h] *= sc; m[h] = mn; }
                if (br == 0) {
#pragma unroll
                    for (int h = 0; h < 4; ++h) { LG[h * 512 + c * 64 + lane] = p[h]; if (lane == 0) MC[c * 4 + h] = m[h]; } }
                unsigned long long vm = vmask;
                while (vm) { const int ll = __builtin_ctzll(vm); vm &= vm - 1ull;
                    const int r = __builtin_amdgcn_readlane(ridx, ll); const float v = bf2f(Vt[(size_t)r * 256 + g * 64 + lane]);
#pragma unroll
                    for (int h = 0; h < 4; ++h) o[h] += __uint_as_float(__builtin_amdgcn_readlane(__float_as_uint(p[h]), ll)) * v; } }
            { const bf16* gp = GATES + (size_t)row * 256 + g * 12 + br;
#pragma unroll
              for (int h = 0; h < 4; ++h) { const float zi = Z[h] > 0.f ? 1.0f / Z[h] : 0.f; Z[h] = zi; oacc[h] += bf2f(gp[h * 3]) * o[h] * zi; } }
            if (br == 0) {
                LDS_WAIT(); asm volatile("" ::: "memory");
#pragma unroll 1
                for (int c = 0; c < 8; ++c) { const int n = c * 64 + lane; float s = 0.f;
                    if (c < nc) {
#pragma unroll
                        for (int h = 0; h < 4; ++h) s += LG[h * 512 + n] * __expf(MC[c * 4 + h] - m[h]) * Z[h]; }
                    imp[n] = s; }
                LDS_WAIT(); asm volatile("" ::: "memory");
                unsigned khi[2], klo[2]; const int cb = pos >> 6;
#pragma unroll
                for (int k = 0; k < 2; ++k) { const int j = lane + 64 * k; float s = 2.0f * (imp[4 * j] + imp[4 * j + 1] + imp[4 * j + 2]) + imp[4 * j + 3]; if (j > 0) s += imp[4 * j - 1];
                    const bool forced = (j == 0) || (j == cb) || (j == cb - 1), future = j > cb; const float sc = forced ? 1e9f : s;
                    khi[k] = future ? 0u : (__float_as_uint(sc) + 1u); klo[k] = 128u - (unsigned)j; }
                LDS_WAIT(); asm volatile("" ::: "memory");
#pragma unroll 1
                for (int i = 0; i < 16; ++i) { unsigned h, l; const bool first = (khi[0] > khi[1]) || (khi[0] == khi[1] && klo[0] > klo[1]); h = first ? khi[0] : khi[1]; l = first ? klo[0] : klo[1];
#pragma unroll
                    for (int off = 1; off < 64; off <<= 1) { const unsigned oh = __shfl_xor(h, off), ol = __shfl_xor(l, off); if (oh > h || (oh == h && ol > l)) { h = oh; l = ol; } }
                    h = __builtin_amdgcn_readfirstlane(h); l = __builtin_amdgcn_readfirstlane(l);
                    if (lane == 0) selb[i] = (h != 0u) ? 128 - (int)l : -1;
#pragma unroll
                    for (int k = 0; k < 2; ++k) if (klo[k] == l) { khi[k] = 0u; klo[k] = 0u; } }
                LDS_WAIT(); asm volatile("" ::: "memory");
            }
        }
#pragma unroll
        for (int h = 0; h < 4; ++h) O[(size_t)row * 1024 + (g * 4 + h) * 64 + lane] = (bf16)f2bf(oacc[h]);
    }
}

namespace nsa {
typedef float f32x16 __attribute__((ext_vector_type(16)));
typedef short s16x4 __attribute__((ext_vector_type(4)));
typedef short v4i16_t __attribute__((ext_vector_type(4)));
constexpr float LOG2E = 1.4426950408889634f, MASKV = -3.0e30f, MINIT = -1.0e30f;
constexpr int KSTR = 144, VSTR = 136, KVBUF = 64 * KSTR + 64 * VSTR;
constexpr int L_KV = 0, L_SC = 35840, L_TB = 72704, L_WSF = L_TB + 8320, L_SELM = L_WSF + 2048, L_NMREF = L_SELM + 1024, L_GS = L_NMREF + 1024, L_FLAG = L_GS + 1024, L_QS = L_FLAG + 128, QS_STR = 144, L_PO = L_QS + 256 * QS_STR, L_G2 = L_PO + 256 * 128, L_LSD = L_G2 + 2048, L_END = L_LSD + 1024;
constexpr int SG = 2, ST_RSTR = 136, ST_LVAL = 256 * ST_RSTR, ST_TAGS = ST_LVAL + 1024, L_ST = 0, STBUF = ST_TAGS + 64;
constexpr int L_ZERO = 2 * STBUF;
static_assert(L_SC + 64 * 128 * 4 <= L_TB && L_ZERO + 4 * ST_RSTR + 16 <= L_TB && L_ZERO % 16 == 0 && (4 * ST_RSTR) % 16 == 0 && L_END <= 163328, "attention LDS map");
constexpr int LSTR = 400;
constexpr int TBN = 130;
__device__ __forceinline__ int crow(int r, int hi) { return (r & 3) + 8 * (r >> 2) + 4 * hi; }
__device__ __forceinline__ float swap_other(float x, int hi) { auto rr = __builtin_amdgcn_permlane32_swap(__float_as_uint(x), __float_as_uint(x), false, false); return hi ? __uint_as_float(rr[0]) : __uint_as_float(rr[1]); }
#define NSA_DPP(x, ctrl) __uint_as_float((unsigned)__builtin_amdgcn_update_dpp(0, (int)__float_as_uint(x), ctrl, 0xF, 0xF, true))
#define NSA_DPPU(x, ctrl) ((unsigned)__builtin_amdgcn_update_dpp(0, (int)(x), ctrl, 0xF, 0xF, true))
__device__ __forceinline__ unsigned cvtpk(float lo, float hi) { typedef float f2 __attribute__((ext_vector_type(2))); typedef __bf16 b2 __attribute__((ext_vector_type(2))); f2 v = {lo, hi}; b2 b = __builtin_convertvector(v, b2); return __builtin_bit_cast(unsigned, b); }

struct TileRegs { v4u k, v; };
__device__ __forceinline__ void tile_load(TileRegs& R, const bf16* Kt, const bf16* Vt, long row0, long rowmax, int tid) {
    long r = row0 + (tid >> 3); r = r < 0 ? 0 : (r > rowmax ? rowmax : r);
    R.k = *(const v4u*)(Kt + r * 256 + (tid & 7) * 8); R.v = *(const v4u*)(Vt + r * 256 + (tid & 7) * 8);
}
__device__ __forceinline__ void tile_store(const TileRegs& R, LAS unsigned char* buf, int tid) {
    *(LAS v4u*)(buf + (tid >> 3) * KSTR + (tid & 7) * 16) = R.k;
    typedef unsigned u2 __attribute__((ext_vector_type(2)));
    LAS unsigned char* vp = buf + 64 * KSTR + (tid >> 3) * VSTR + (tid & 7) * 16;
    *(LAS u2*)vp = (u2){R.v.x, R.v.y}; *(LAS u2*)(vp + 8) = (u2){R.v.z, R.v.w};
}
__device__ __forceinline__ void qkt(f32x16& p0, f32x16& p1, const LAS unsigned char* buf, const LAS unsigned char* qrow  , int r32, int hi) {
    const LAS unsigned char* kb = buf + r32 * KSTR + hi * 16;
    p0 = f32x16{}; p1 = f32x16{};
#pragma unroll
    for (int d0 = 0; d0 < 4; ++d0) { const bf16x8 a0 = *(const LAS bf16x8*)(kb + d0 * 32), a1 = *(const LAS bf16x8*)(kb + 32 * KSTR + d0 * 32), qf = *(const LAS bf16x8*)(qrow + d0 * 32);
        p0 = __builtin_amdgcn_mfma_f32_32x32x16_bf16(a0, qf, p0, 0, 0, 0); p1 = __builtin_amdgcn_mfma_f32_32x32x16_bf16(a1, qf, p1, 0, 0, 0); }
}
__device__ __forceinline__ s16x4 vtr(const LAS unsigned char* p) { return __builtin_bit_cast(s16x4, __builtin_amdgcn_ds_read_tr16_b64_v4i16((LAS v4i16_t*)p)); }
__device__ __forceinline__ void pv(f32x16 (&o)[2], const LAS unsigned char* buf, const unsigned (&pw)[16], int lane) {
    const int hi = lane >> 5; const LAS unsigned char* vb = buf + 64 * KSTR + (((lane & 15) >> 2) + 4 * hi) * VSTR + (lane & 3) * 8 + ((lane >> 4) & 1) * 32;
#pragma unroll
    for (int s = 0; s < 4; ++s) { const bf16x8 pa = __builtin_bit_cast(bf16x8, (v4u){pw[4 * s], pw[4 * s + 1], pw[4 * s + 2], pw[4 * s + 3]});
#pragma unroll
        for (int d0 = 0; d0 < 2; ++d0) { const s16x4 lo = vtr(vb + (16 * s) * VSTR + d0 * 64), hh = vtr(vb + (16 * s + 8) * VSTR + d0 * 64);
            const bf16x8 vf = (bf16x8){lo[0], lo[1], lo[2], lo[3], hh[0], hh[1], hh[2], hh[3]};
            o[d0] = __builtin_amdgcn_mfma_f32_32x32x16_bf16(pa, vf, o[d0], 0, 0, 0); } }
}
__device__ __forceinline__ float rowmax32(const f32x16& p0, const f32x16& p1, int hi) {
    float a = fmaxf(p0[0], p1[0]);
#pragma unroll
    for (int r = 1; r < 16; ++r) a = fmaxf(a, fmaxf(p0[r], p1[r]));
    return fmaxf(a, swap_other(a, hi));
}
template <int MULT, bool FAR>
__device__ __forceinline__ void bias_mask(f32x16& p0, f32x16& p1, int dl, const LAS float* tbl  ) {
#pragma unroll
    for (int r = 0; r < 16; ++r) { const int c = (r & 3) + 8 * (r >> 2);
        const int d0 = dl - MULT * c, d1 = dl - MULT * (c + 32);
        const int i0 = min(max(d0, -1), 128) + 1, i1 = min(max(d1, -1), 128) + 1;
        float b0 = tbl[i0 * 16], b1 = tbl[i1 * 16];
        if (FAR) { if (d0 >= 512) b0 = MASKV; if (d1 >= 512) b1 = MASKV; }
        p0[r] += b0; p1[r] += b1;
        if ((r & 3) == 3) asm volatile("" ::: "memory"); }
}
__device__ __forceinline__ void row_to_regs(float (&fr)[16], float f, LAS float* wsf, int r32, int hi) {
    if (hi == 0) wsf[r32] = f;
    asm volatile("s_waitcnt lgkmcnt(0)" ::: "memory");
#pragma unroll
    for (int r = 0; r < 16; ++r) fr[r] = wsf[crow(r, hi)];
    asm volatile("s_waitcnt lgkmcnt(0)" ::: "memory");
}
}

#ifndef TSEC
#define TSEC 0
#endif
#define TSB(id) do { if (TSEC == (id)) ts0_ = __builtin_amdgcn_s_memrealtime(); } while (0)
#define TSE(id) do { if (TSEC == (id)) tacc_ += __builtin_amdgcn_s_memrealtime() - ts0_; } while (0)
__device__ __forceinline__ void attn_dense_phase(Frame& F) {
    using namespace nsa;
    unsigned long long ts0_ = 0, tacc_ = 0; (void)ts0_;
    LAS unsigned char* L = F.lds + RING_OFF;
    LAS float* TB = (LAS float*)(L + L_TB); LAS float* wsf = (LAS float*)(L + L_WSF) + F.wave * 64; LAS float* SC = (LAS float*)(L + L_SC); LAS unsigned* SELM = (LAS unsigned*)(L + L_SELM);
    const int wave = F.wave;
    for (int i = F.tid; i < TBN * 16; i += NWAVES * 64) { const int idx = i >> 4, hh = i & 15; float v;
        if (idx == 0) v = MASKV; else if (idx == 129) v = 0.f; else v = F.in[1][t5_bucket_dev(idx - 1) * 16 + hh] - F.in[1][31 * 16 + hh];
        TB[i] = v; }
    for (int i = F.tid; i < (4 * ST_RSTR + 16) / 4; i += NWAVES * 64) ((LAS unsigned*)(L + L_ZERO))[i] = 0u;
    __syncthreads();
    const bf16* KVQ = (const bf16*)(F.ws + WS_KVQ); const bf16* GATES = KVQ + 10 * KVQ_TSTRIDE;
    const bf16* KCMP = (const bf16*)(F.ws + WS_KCMP); const bf16* VCMP = (const bf16*)(F.ws + WS_VCMP);
    bf16* O = (bf16*)(F.ws + WS_O);
    unsigned* UCTR0 = (unsigned*)(F.ws + WS_CTL) + 1024; LAS unsigned* UCUR = (LAS unsigned*)(L + L_FLAG) + 17; unsigned ugrp = (unsigned)(F.vcu >> 5) & 7u;
#define NSA_DEAL(dst) do { dst = 2048u; for (int tr_ = 0; tr_ < 8; ++tr_) { const unsigned u_ = atomicAdd(UCTR0 + 64 * ugrp, 1u); if (u_ < 256u) { dst = 256u * ugrp + u_; break; } ugrp = (ugrp + 1u) & 7u; } } while (0)
    if (F.tid == 0) { unsigned d0_; NSA_DEAL(d0_); UCUR[0] = d0_; }
    __syncthreads();
#pragma unroll 1
    for (unsigned ucur = UCUR[0]; ucur < 2048u; ucur = UCUR[0]) {
        const int lane = fresh_lane(), tid = wave * 64 + lane, r32 = lane & 31, hi = lane >> 5, ql = r32 >> 2, h = r32 & 3;
        unsigned unext = 2048u; if (tid == 0) NSA_DEAL(unext);
        const int bg = 2 * (int)(ucur >> 8) + (int)((ucur >> 7) & 1u), b = bg >> 2, g = bg & 3, qt = 127 - (int)(ucur & 127u), t0 = qt * 64, cb = qt;
        const int i = 8 * wave + ql, pos = t0 + i; const long row = (long)b * SEQ + pos;
        const LAS float* tbl = TB + g * 4 + h;
        const LAS unsigned char* qr = L + L_QS + (32 * wave + r32) * QS_STR + hi * 16;
        { const bf16* qp = KVQ + (size_t)(6 + g) * KVQ_TSTRIDE + row * 256 + h * 64 + hi * 8;
#pragma unroll
          for (int d0 = 0; d0 < 4; ++d0) *(LAS bf16x8*)(L + L_QS + (32 * wave + r32) * QS_STR + hi * 16 + d0 * 32) = *(const bf16x8*)(qp + d0 * 16); }
        if (hi == 0) { const bf16* gp = GATES + row * 256 + g * 12 + h * 3; LAS float* G2 = (LAS float*)(L + L_G2) + (32 * wave + r32) * 2; G2[0] = bf2f(gp[0]); G2[1] = bf2f(gp[2]); ((LAS float*)(L + L_GS))[32 * wave + r32] = bf2f(gp[1]); }
        float mwin;
        f32x16 oacc[2];
        TileRegs TR;
        TSB(1);
        { const bf16* Kt = KVQ + 4 * KVQ_TSTRIDE + g * 64; const bf16* Vt = KVQ + 5 * KVQ_TSTRIDE + g * 64; const long base = (long)b * SEQ, rmax = (long)T - 1;
          const int kt0 = t0 >= 512 ? 0 : 8 - cb;
          LAS float* LINE = (LAS float*)(L + L_SC);
          if (tid < LSTR) {
#pragma unroll
              for (int hh = 0; hh < 4; ++hh) { float v; if (tid < 260) { const int d = tid - 68; v = d < 0 ? MASKV : TB[(min(d, 128) + 1) * 16 + g * 4 + hh]; } else v = tid + 184 >= 512 ? MASKV : 0.f;
                  LINE[hh * LSTR + tid] = v; } }
          f32x16 (&o)[2] = oacc; o[0] = f32x16{}; o[1] = f32x16{}; float m = MINIT, l = 0.f;
          tile_load(TR, Kt, Vt, base + t0 - 512 + 64 * kt0, rmax, tid); tile_store(TR, L + L_KV, tid); __syncthreads();
#pragma unroll 1
          for (int kt = kt0; kt < 9; ++kt) { LAS unsigned char* buf = L + L_KV + ((kt - kt0) & 1) * KVBUF;
              if (kt < 8) tile_load(TR, Kt, Vt, base + t0 - 512 + 64 * (kt + 1), rmax, tid);
              f32x16 p0, p1; qkt(p0, p1, buf, qr, r32, hi);
              if (kt == 0 || kt >= 6) { const int dl = 512 - 64 * kt + i - 4 * hi;
                  const LAS float* lp = LINE + h * LSTR + (kt == 0 ? dl - 247 : dl + 5);
#pragma unroll
                  for (int r = 0; r < 16; ++r) { const int c = (r & 3) + 8 * (r >> 2); p0[r] += lp[63 - c]; p1[r] += lp[31 - c]; } }
              p0 *= LOG2E; p1 *= LOG2E;
              const float rm = rowmax32(p0, p1, hi), mn = fmaxf(m, rm), f = __builtin_amdgcn_exp2f(m - mn), nmn = -mn; m = mn; l *= f;
              if (__any(f != 1.0f)) { float fr[16]; row_to_regs(fr, f, wsf, r32, hi);
#pragma unroll
                  for (int r = 0; r < 16; ++r) { o[0][r] *= fr[r]; o[1][r] *= fr[r]; } }
              unsigned pw[16]; p0 += nmn; p1 += nmn;
#pragma unroll
              for (int r = 0; r < 16; ++r) { p0[r] = __builtin_amdgcn_exp2f(p0[r]); p1[r] = __builtin_amdgcn_exp2f(p1[r]); }
              { const f32x16 s = p0 + p1; typedef float f32x2 __attribute__((ext_vector_type(2))); f32x2 s2 = {s[0], s[1]};
#pragma unroll
                for (int r = 1; r < 8; ++r) s2 += (f32x2){s[2 * r], s[2 * r + 1]};
                l += s2.x + s2.y; }
#pragma unroll
              for (int r = 0; r < 8; ++r) { pw[r] = cvtpk(p0[2 * r], p0[2 * r + 1]); pw[8 + r] = cvtpk(p1[2 * r], p1[2 * r + 1]); }
              pv(o, buf, pw, lane);
              if (kt < 8) tile_store(TR, L + L_KV + ((kt - kt0 + 1) & 1) * KVBUF, tid);
              __syncthreads(); }
          const float g_w = ((const LAS float*)(L + L_G2))[(32 * wave + r32) * 2 + 1]; const float lt = l + swap_other(l, hi); float fr[16]; row_to_regs(fr, lt > 0.f ? g_w / lt : 0.f, wsf, r32, hi); mwin = m * (1.0f / LOG2E);
#pragma unroll
          for (int r = 0; r < 16; ++r) { oacc[0][r] *= fr[r]; oacc[1][r] *= fr[r]; } }
        TSE(1); TSB(2);
        { const bf16* Kt = KCMP + g * 64; const bf16* Vt = VCMP + g * 64; const long base = (long)b * 512, rmax = (long)BATCH * 512 - 1;
          const int nvmax = t0 + 63 >= 31 ? ((t0 + 32) >> 4) + 1 : 0, ntc = (nvmax + 63) >> 6;
          float m = MINIT, l = 0.f;
          if (ntc > 0) { tile_load(TR, Kt, Vt, base, rmax, tid); tile_store(TR, L + L_KV, tid); }
          __syncthreads();
#pragma unroll 1
          for (int tc = 0; tc < ntc; ++tc) { LAS unsigned char* buf = L + L_KV + (tc & 1) * KVBUF;
              tile_load(TR, Kt, Vt, base + 64 * (tc + 1 < ntc ? tc + 1 : 0), rmax, tid);
              f32x16 p0, p1; qkt(p0, p1, buf, qr, r32, hi);
              if (t0 - 1024 * tc - 1039 < 128) bias_mask<16, false>(p0, p1, pos - 31 - 1024 * tc - 64 * hi, tbl);
              p0 *= LOG2E; p1 *= LOG2E;
              const float rm = rowmax32(p0, p1, hi), mn = fmaxf(m, rm), nmn = -mn; l *= __builtin_amdgcn_exp2f(m - mn); m = mn;
              p0 += nmn; p1 += nmn;
#pragma unroll
              for (int r = 0; r < 16; ++r) { p0[r] = __builtin_amdgcn_exp2f(p0[r]); p1[r] = __builtin_amdgcn_exp2f(p1[r]); }
              { const f32x16 s = p0 + p1; typedef float f32x2 __attribute__((ext_vector_type(2))); f32x2 s2 = {s[0], s[1]};
#pragma unroll
                for (int r = 1; r < 8; ++r) s2 += (f32x2){s[2 * r], s[2 * r + 1]};
                l += s2.x + s2.y; }
              tile_store(TR, L + L_KV + ((tc + 1) & 1) * KVBUF, tid);
              __syncthreads(); }
          const float g_c = ((const LAS float*)(L + L_G2))[(32 * wave + r32) * 2]; const float lt = l + swap_other(l, hi), linv = lt > 0.f ? 1.0f / lt : 0.f, nm = -m;
          float carry = 0.f;
#pragma unroll 1
          for (int tc = 0; tc < ntc; ++tc) { LAS unsigned char* buf = L + L_KV + ((ntc + tc) & 1) * KVBUF;
              if (tc + 1 < ntc) tile_load(TR, Kt, Vt, base + 64 * (tc + 1), rmax, tid);
              f32x16 p0, p1; qkt(p0, p1, buf, qr, r32, hi);
              if (t0 - 1024 * tc - 1039 < 128) bias_mask<16, false>(p0, p1, pos - 31 - 1024 * tc - 64 * hi, tbl);
              unsigned pw[16];
#pragma unroll
              for (int r = 0; r < 16; ++r) { p0[r] = __builtin_amdgcn_exp2f(fmaf(p0[r], LOG2E, nm)); p1[r] = __builtin_amdgcn_exp2f(fmaf(p1[r], LOG2E, nm)); }
              p0 *= linv; p1 *= linv;
#pragma unroll
              for (int r = 0; r < 8; ++r) { pw[r] = cvtpk(p0[2 * r] * g_c, p0[2 * r + 1] * g_c); pw[8 + r] = cvtpk(p1[2 * r] * g_c, p1[2 * r + 1] * g_c); }
              pv(oacc, buf, pw, lane);
              float w8[8], c8[8];
#pragma unroll
              for (int kq = 0; kq < 8; ++kq) { float a[4];
#pragma unroll
                  for (int e = 0; e < 4; ++e) { float x = kq < 4 ? p0[4 * kq + e] : p1[4 * (kq - 4) + e]; x += NSA_DPP(x, 0xB1); x += NSA_DPP(x, 0x4E); a[e] = x; }
                  w8[kq] = 2.0f * (a[0] + a[1] + a[2]) + a[3]; c8[kq] = a[3]; }
#pragma unroll
              for (int kq = 0; kq < 8; ++kq) { const float ok = swap_other(c8[kq], hi); w8[kq] += hi ? ok : carry; carry = ok; }
              LAS float* scq = SC + i * 128 + 16 * tc;
#pragma unroll
              for (int kq = 0; kq < 8; ++kq) if ((kq & 3) == h) scq[2 * kq + hi] = w8[kq];
              if (tc + 1 < ntc) tile_store(TR, L + L_KV + ((ntc + tc + 1) & 1) * KVBUF, tid);
              __syncthreads(); }
        }
        TSE(2); TSB(3);
        { const int lq = lane >> 3, sub = lane & 7; unsigned msk[4] = {0u, 0u, 0u, 0u};
          if (cb <= 15) { msk[0] = (cb == 31) ? 0xffffffffu : ((1u << (cb + 1)) - 1u); }
          else { unsigned key[16]; const LAS float* scq = SC + (8 * wave + lq) * 128;
              asm volatile("s_waitcnt lgkmcnt(0)" ::: "memory");
#pragma unroll
              for (int kk = 0; kk < 16; ++kk) { const int j = sub + 8 * kk; const float s = scq[j]; key[kk] = (j >= 1 && j <= cb - 2) ? ((__float_as_uint(s) & 0xFFFFFF80u) | (unsigned)(127 - j)) : 0u; }
#pragma unroll 1
              for (int rd = 0; rd < 13; ++rd) { unsigned mx = key[0];
#pragma unroll
                  for (int kk = 1; kk < 16; ++kk) mx = mx > key[kk] ? mx : key[kk];
                  { unsigned o1 = NSA_DPPU(mx, 0xB1); mx = mx > o1 ? mx : o1; o1 = NSA_DPPU(mx, 0x4E); mx = mx > o1 ? mx : o1; o1 = NSA_DPPU(mx, 0x141); mx = mx > o1 ? mx : o1; }
                  const int j = 127 - (int)(mx & 127u);
#pragma unroll
                  for (int w4 = 0; w4 < 4; ++w4) if (mx != 0u && (j >> 5) == w4) msk[w4] |= 1u << (j & 31);
#pragma unroll
                  for (int kk = 0; kk < 16; ++kk) if (key[kk] == mx) key[kk] = 0u; }
              msk[0] |= 1u;
#pragma unroll
              for (int w4 = 0; w4 < 4; ++w4) { if (((cb - 1) >> 5) == w4) msk[w4] |= 1u << ((cb - 1) & 31); if ((cb >> 5) == w4) msk[w4] |= 1u << (cb & 31); } }
          if (sub < 4) { const unsigned mv = sub == 0 ? msk[0] : sub == 1 ? msk[1] : sub == 2 ? msk[2] : msk[3];
              SELM[(8 * wave + lq) * 4 + sub] = mv; } }
        TSE(3); TSB(4);
        { LAS unsigned short* PO = (LAS unsigned short*)(L + L_PO);
#pragma unroll
          for (int r = 0; r < 16; ++r) { const int rw = 32 * wave + crow(r, hi); PO[rw * 64 + r32] = (unsigned short)f2bf(oacc[0][r]); PO[rw * 64 + 32 + r32] = (unsigned short)f2bf(oacc[1][r]); } }
        { LAS float* NMREF = (LAS float*)(L + L_NMREF); LAS float* GS = (LAS float*)(L + L_GS); LAS unsigned char* QS = L + L_QS; LAS unsigned* FLAG = (LAS unsigned*)(L + L_FLAG);
          { const int l2 = fresh_lane(); if (l2 < 32) NMREF[32 * wave + l2] = -mwin * LOG2E; if (wave == 0 && l2 == 0) FLAG[16] = 1u; }
          __syncthreads();
          if (tid < 260) {
#pragma unroll
              for (int hh = 0; hh < 4; ++hh) { const int d = tid - 68; ((LAS float*)(L + L_SC))[hh * LSTR + tid] = d < 0 ? MASKV : TB[(min(d, 128) + 1) * 16 + g * 4 + hh]; } }
          f32x16 osel[2]; osel[0] = f32x16{}; osel[1] = f32x16{};
          { const bf16* Kt = KVQ + 2 * KVQ_TSTRIDE + g * 64; const bf16* Vt = KVQ + 3 * KVQ_TSTRIDE + g * 64; const long base = (long)b * SEQ, rmax = (long)T - 1;
            const int nd = cb <= 15 ? cb + 1 : 3; const float nmw = -mwin * LOG2E; float lsd = 0.f;
#define NSA_DBLK(ii) (cb <= 15 ? (ii) : ((ii) == 0 ? 0 : cb - 2 + (ii)))
            tile_load(TR, Kt, Vt, base + 64 * NSA_DBLK(0), rmax, tid); tile_store(TR, L + L_KV, tid); __syncthreads();
#pragma unroll 1
            for (int ii = 0; ii < nd; ++ii) { LAS unsigned char* buf = L + L_KV + (ii & 1) * KVBUF; const int blk = NSA_DBLK(ii);
                if (ii + 1 < nd) tile_load(TR, Kt, Vt, base + 64 * NSA_DBLK(ii + 1), rmax, tid);
                f32x16 p0, p1; qkt(p0, p1, buf, qr, r32, hi);
                if (blk >= cb - 2) { const LAS float* lp = (const LAS float*)(L + L_SC) + h * LSTR + (t0 + i - 64 * blk - 4 * hi) + 5;
#pragma unroll
                    for (int r = 0; r < 16; ++r) { const int c = (r & 3) + 8 * (r >> 2); p0[r] += lp[63 - c]; p1[r] += lp[31 - c]; } }
                unsigned pw[16]; float ls = 0.f;
#pragma unroll
                for (int r = 0; r < 16; ++r) { p0[r] = __builtin_amdgcn_exp2f(fminf(fmaf(p0[r], LOG2E, nmw), 100.f)); p1[r] = __builtin_amdgcn_exp2f(fminf(fmaf(p1[r], LOG2E, nmw), 100.f)); ls += p0[r] + p1[r]; }
                lsd += ls;
#pragma unroll
                for (int r = 0; r < 8; ++r) { pw[r] = cvtpk(p0[2 * r], p0[2 * r + 1]); pw[8 + r] = cvtpk(p1[2 * r], p1[2 * r + 1]); }
                pv(osel, buf, pw, lane);
                if (ii + 1 < nd) tile_store(TR, L + L_KV + ((ii + 1) & 1) * KVBUF, tid);
                __syncthreads(); }
#undef NSA_DBLK
            lsd += swap_other(lsd, hi); if (hi == 0) ((LAS float*)(L + L_LSD))[32 * wave + r32] = lsd; }
          float osp[4][8]; float lsp[4] = {0.f, 0.f, 0.f, 0.f};
          { LAS float* cv = (LAS float*)(L + L_ST) + wave * 2048;
#pragma unroll
            for (int r = 0; r < 16; ++r) { cv[crow(r, hi) * 64 + r32] = osel[0][r]; cv[crow(r, hi) * 64 + 32 + r32] = osel[1][r]; }
            asm volatile("s_waitcnt lgkmcnt(0)" ::: "memory");
            const LAS float* cr = cv + (4 * (lane >> 3)) * 64 + 8 * (lane & 7);
#pragma unroll
            for (int hh = 0; hh < 4; ++hh) { const f32x4 a = *(const LAS f32x4*)(cr + hh * 64), bq = *(const LAS f32x4*)(cr + hh * 64 + 4);
#pragma unroll
                for (int e = 0; e < 4; ++e) { osp[hh][e] = a[e]; osp[hh][4 + e] = bq[e]; } } }
          __syncthreads();
          const int fr16 = lane & 15, q4 = lane >> 4, qi = fr16 >> 2, hc = fr16 & 3;
          const bf16* Ks = KVQ + 2 * KVQ_TSTRIDE + ((long)b * SEQ) * 256 + g * 64; const bf16* VT = (const bf16*)(F.ws + WS_VT) + (size_t)((b * 4 + g) * 128) * 4096;
          bf16x8 Kf[4][2] = {}, Vf[4][2] = {}; unsigned long long qm = 0ull, qmn = 0ull; int jn = 0, jc = 0, jcn = 0;
#define NSA_SCAN_NEXT() do { qmn = 0ull; for (;;) { unsigned jx = 0u; if (lane == 0) jx = __hip_atomic_fetch_add(FLAG + 16, 1u, __ATOMIC_RELAXED, __HIP_MEMORY_SCOPE_WORKGROUP); \
              const int j = __builtin_amdgcn_readfirstlane((int)jx); if (j > cb - 2) break;                      \
              { const unsigned wv = SELM[lane * 4 + (j >> 5)]; qmn = __ballot((wv >> (j & 31)) & 1u); } \
              jcn = j; if (qmn) break; } } while (0)
#define NSA_LOAD_K(j) do { const bf16* kp = Ks + (size_t)(64 * (j) + fr16) * 256 + 8 * q4; \
              _Pragma("unroll") for (int a = 0; a < 4; ++a) _Pragma("unroll") for (int s2 = 0; s2 < 2; ++s2) Kf[a][s2] = *(const bf16x8*)(kp + a * 16 * 256 + s2 * 32); } while (0)
#define NSA_LOAD_V(j) do { const bf16* vp = VT + (size_t)(j) * 4096 + fr16 * 64 + 8 * q4; \
              _Pragma("unroll") for (int a = 0; a < 4; ++a) _Pragma("unroll") for (int s2 = 0; s2 < 2; ++s2) Vf[a][s2] = *(const bf16x8*)(vp + a * 16 * 64 + s2 * 32); } while (0)
#define NSA_LOAD_K_D(j, dep) do { const bf16* kp = Ks + (size_t)(64 * (j) + fr16) * 256 + 8 * q4 + (dep); \
              _Pragma("unroll") for (int a = 0; a < 4; ++a) _Pragma("unroll") for (int s2 = 0; s2 < 2; ++s2) Kf[a][s2] = *(const bf16x8*)(kp + a * 16 * 256 + s2 * 32); } while (0)
#define NSA_LOAD_V_D(j, dep) do { const bf16* vp = VT + (size_t)(j) * 4096 + fr16 * 64 + 8 * q4 + (dep); \
              _Pragma("unroll") for (int a = 0; a < 4; ++a) _Pragma("unroll") for (int s2 = 0; s2 < 2; ++s2) Vf[a][s2] = *(const bf16x8*)(vp + a * 16 * 64 + s2 * 32); } while (0)
          if (cb > 15) {
              int gi = 0, rd = 0; bool fin = false;
              auto consume = [&]() __attribute__((always_inline)) { const LAS unsigned char* sb = L + L_ST + (rd & 1) * STBUF;
                const unsigned tg = *(sb + ST_TAGS + lane);
                const int ql8 = lane >> 3; unsigned long long mym = 0ull;
#pragma unroll
                for (int q = 0; q < 8; ++q) { const unsigned long long bm = __ballot(tg == (unsigned)(8 * wave + q)); if (ql8 == q) mym = bm; }
                typedef unsigned u2 __attribute__((ext_vector_type(2)));
                auto pull2 = [&]() __attribute__((always_inline)) {
                    const bool a0 = mym != 0ull; const int j0 = a0 ? __builtin_ctzll(mym) : 0; mym &= mym - 1ull;
                    const bool a1 = mym != 0ull; const int j1 = a1 ? __builtin_ctzll(mym) : 0; mym &= mym - 1ull;
                    const LAS unsigned char* dp0 = (a0 ? sb + (4 * j0) * ST_RSTR : L + L_ZERO) + 16 * (lane & 7); const LAS unsigned char* dp1 = (a1 ? sb + (4 * j1) * ST_RSTR : L + L_ZERO) + 16 * (lane & 7);
                    const f32x4 lv0 = *(const LAS f32x4*)(a0 ? sb + ST_LVAL + 16 * j0 : L + L_ZERO + 4 * ST_RSTR), lv1 = *(const LAS f32x4*)(a1 ? sb + ST_LVAL + 16 * j1 : L + L_ZERO + 4 * ST_RSTR);
                    u2 d0[4][2], d1[4][2];
#pragma unroll
                    for (int hh = 0; hh < 4; ++hh) { d0[hh][0] = *(const LAS u2*)(dp0 + hh * ST_RSTR); d0[hh][1] = *(const LAS u2*)(dp0 + hh * ST_RSTR + 8); d1[hh][0] = *(const LAS u2*)(dp1 + hh * ST_RSTR); d1[hh][1] = *(const LAS u2*)(dp1 + hh * ST_RSTR + 8); }
#pragma unroll
                    for (int hh = 0; hh < 4; ++hh) {
#pragma unroll
                        for (int w = 0; w < 2; ++w) { const unsigned x0 = d0[hh][w].x, y0 = d0[hh][w].y, x1 = d1[hh][w].x, y1 = d1[hh][w].y;
                            osp[hh][4 * w + 0] += __uint_as_float(x0 << 16) + __uint_as_float(x1 << 16); osp[hh][4 * w + 1] += __uint_as_float(x0 & 0xFFFF0000u) + __uint_as_float(x1 & 0xFFFF0000u);
                            osp[hh][4 * w + 2] += __uint_as_float(y0 << 16) + __uint_as_float(y1 << 16); osp[hh][4 * w + 3] += __uint_as_float(y0 & 0xFFFF0000u) + __uint_as_float(y1 & 0xFFFF0000u); }
                        lsp[hh] += lv0[hh] + lv1[hh]; } };
                if (__ballot(mym != 0ull) != 0ull) { pull2();
                    if (__ballot(mym != 0ull) != 0ull) { pull2();
                        while (__ballot(mym != 0ull) != 0ull) pull2(); } } };
              auto round_end = [&](const bool more) __attribute__((always_inline)) -> bool {
                if (lane == 0) FLAG[(rd & 1) * 8 + wave] = more ? 1u : 0u;
                asm volatile("s_waitcnt lgkmcnt(0)" ::: "memory"); __builtin_amdgcn_s_barrier(); asm volatile("" ::: "memory");
                const unsigned any = FLAG[(rd & 1) * 8 + (lane & 7)];
                consume(); ++rd; gi = 0;
                return __ballot(any != 0u) == 0ull; };
              auto group = [&](const bool last) __attribute__((always_inline)) {
                  LAS unsigned char* stb = L + L_ST + (rd & 1) * STBUF; const int sidx = wave * SG + gi;
                  LAS unsigned char* sdat = stb + (16 * sidx + fr16) * ST_RSTR; LAS float* slv = (LAS float*)(stb + ST_LVAL) + 16 * sidx + fr16; LAS unsigned char* stg = stb + ST_TAGS + 4 * sidx;
                  int iq[4];
#pragma unroll
                  for (int e = 0; e < 4; ++e) { if (qm) { iq[e] = __builtin_ctzll(qm); qm &= qm - 1ull; } else iq[e] = -1; }
                  const int myq = qi == 0 ? iq[0] : qi == 1 ? iq[1] : qi == 2 ? iq[2] : iq[3]; const bool cval = myq >= 0; const int rowq = 4 * (cval ? myq : iq[0]) + hc;
                  const bf16x8 q0 = *(const LAS bf16x8*)(QS + rowq * QS_STR + q4 * 16), q1 = *(const LAS bf16x8*)(QS + rowq * QS_STR + 64 + q4 * 16);
                  const float nmr = NMREF[rowq];
                  f32x4 st[4];
#pragma unroll
                  for (int kt = 0; kt < 4; ++kt) { st[kt] = (f32x4){0.f, 0.f, 0.f, 0.f};
                      st[kt] = __builtin_amdgcn_mfma_f32_16x16x32_bf16(Kf[kt][0], q0, st[kt], 0, 0, 0); st[kt] = __builtin_amdgcn_mfma_f32_16x16x32_bf16(Kf[kt][1], q1, st[kt], 0, 0, 0); }
                  const int jnx = qmn ? jcn : jc;
                  if (last) { int dep = 0; asm volatile("" : "+v"(dep) : "v"(st[0]), "v"(st[1]), "v"(st[2]), "v"(st[3])); NSA_LOAD_K_D(jnx, dep); }
                  if (jc >= cb - 2) { const int dl = t0 + (cval ? myq : iq[0]) - 64 * jc - 4 * q4; const LAS float* tb2 = TB + g * 4 + hc;
#pragma unroll
                      for (int kt = 0; kt < 4; ++kt)
#pragma unroll
                          for (int r = 0; r < 4; ++r) { const int d = dl - 16 * kt - r; st[kt][r] += tb2[(min(max(d, -1), 128) + 1) * 16]; } }
                  float ls = 0.f;
#pragma unroll
                  for (int kt = 0; kt < 4; ++kt)
#pragma unroll
                      for (int r = 0; r < 4; ++r) { const float p = __builtin_amdgcn_exp2f(fminf(fmaf(st[kt][r], LOG2E, nmr), 100.f)); st[kt][r] = p; ls += p; }
                  { const auto s16 = __builtin_amdgcn_permlane16_swap(__float_as_uint(ls), __float_as_uint(ls), false, false); ls = __uint_as_float(s16[0]) + __uint_as_float(s16[1]);
                    const auto s32 = __builtin_amdgcn_permlane32_swap(__float_as_uint(ls), __float_as_uint(ls), false, false); ls = __uint_as_float(s32[0]) + __uint_as_float(s32[1]); }
                  if (q4 == 0) slv[0] = ls;
                  if (lane < 4) stg[lane] = (unsigned char)(lane == 0 ? iq[0] : lane == 1 ? iq[1] : lane == 2 ? iq[2] : iq[3]);
                  bf16x8 pf[2];
#pragma unroll
                  for (int s2 = 0; s2 < 2; ++s2) pf[s2] = __builtin_bit_cast(bf16x8, (v4u){cvtpk(st[2 * s2][0], st[2 * s2][1]), cvtpk(st[2 * s2][2], st[2 * s2][3]), cvtpk(st[2 * s2 + 1][0], st[2 * s2 + 1][1]), cvtpk(st[2 * s2 + 1][2], st[2 * s2 + 1][3])});
                  f32x4 ot[4];
#pragma unroll
                  for (int dt = 0; dt < 4; ++dt) { ot[dt] = (f32x4){0.f, 0.f, 0.f, 0.f};
                      ot[dt] = __builtin_amdgcn_mfma_f32_16x16x32_bf16(Vf[dt][0], pf[0], ot[dt], 0, 0, 0); ot[dt] = __builtin_amdgcn_mfma_f32_16x16x32_bf16(Vf[dt][1], pf[1], ot[dt], 0, 0, 0); }
                  if (last) { int dep = 0; asm volatile("" : "+v"(dep) : "v"(ot[0]), "v"(ot[1]), "v"(ot[2]), "v"(ot[3])); NSA_LOAD_V_D(jnx, dep); }
#pragma unroll
                  for (int dt = 0; dt < 4; ++dt) { typedef unsigned u2 __attribute__((ext_vector_type(2)));
                      *(LAS u2*)(sdat + (16 * dt + 4 * q4) * 2) = (u2){cvtpk(ot[dt][0], ot[dt][1]), cvtpk(ot[dt][2], ot[dt][3])}; } };
              NSA_SCAN_NEXT(); if (qmn) { NSA_LOAD_K(jcn); NSA_LOAD_V(jcn); }
#pragma unroll 1
              while (qmn != 0ull) { qm = qmn; jc = jcn;
#pragma unroll 1
                  while (__builtin_popcountll(qm) > 4) { group(false); if (++gi == SG) round_end(true); }
                  NSA_SCAN_NEXT();
                  group(true);
                  if (++gi == SG) fin = round_end(qmn != 0ull); }
#pragma unroll 1
              while (!fin) { LAS unsigned char* stb = L + L_ST + (rd & 1) * STBUF;
                  for (; gi < SG; ++gi) if (lane < 4) stb[ST_TAGS + 4 * (wave * SG + gi) + lane] = (unsigned char)255;
                  fin = round_end(false); }
          }
          { const int ln = fresh_lane(), q8 = ln >> 3, dg = ln & 7;
#pragma unroll
            for (int hh = 0; hh < 4; ++hh) { const int rw = 32 * wave + 4 * q8 + hh;
                const float lsum = lsp[hh] + ((const LAS float*)(L + L_LSD))[rw]; const float f = lsum > 0.f ? GS[rw] / lsum : 0.f;
                const v4u po = *(const LAS v4u*)(L + L_PO + rw * 128 + 16 * dg); v4u ov;
                ov.x = cvtpk(__uint_as_float(po.x << 16) + osp[hh][0] * f, __uint_as_float(po.x & 0xFFFF0000u) + osp[hh][1] * f); ov.y = cvtpk(__uint_as_float(po.y << 16) + osp[hh][2] * f, __uint_as_float(po.y & 0xFFFF0000u) + osp[hh][3] * f);
                ov.z = cvtpk(__uint_as_float(po.z << 16) + osp[hh][4] * f, __uint_as_float(po.z & 0xFFFF0000u) + osp[hh][5] * f); ov.w = cvtpk(__uint_as_float(po.w << 16) + osp[hh][6] * f, __uint_as_float(po.w & 0xFFFF0000u) + osp[hh][7] * f);
                *(v4u*)(O + ((long)b * SEQ + t0 + 8 * wave + q8) * 1024 + (g * 4 + hh) * 64 + 8 * dg) = ov; } } }
        TSE(4);
        if (tid == 0) UCUR[0] = unext;
        __syncthreads();
    }
    if (TSEC) { const unsigned long long tb_ = __builtin_amdgcn_s_memrealtime(); while (__builtin_amdgcn_s_memrealtime() - tb_ < tacc_) __builtin_amdgcn_s_sleep(4); }
}


#ifndef MK_PER_PHASE
#define MK_PER_PHASE 0
#endif
constexpr int N_PHASES = 14;
struct Args { const float* in[20]; float* out; unsigned char* ws; int ph_lo, ph_hi, li, pad; };
__global__ void __launch_bounds__(NWAVES * 64, 2) nsa_fwd(Args args) {
    extern __shared__ __attribute__((aligned(16))) unsigned char lds[];
    Frame F;
    F.lds = (LAS unsigned char*)lds;
    F.MISC = (volatile LAS unsigned*)(F.lds + MISC_OFF);
    F.tid = threadIdx.x; F.lane = F.tid & 63; F.wave = __builtin_amdgcn_readfirstlane(F.tid >> 6);
    F.G = gridDim.x; { const int bx = blockIdx.x; F.vcu = (F.G % 8 == 0) ? (bx % 8) * (F.G / 8) + bx / 8 : bx; }
    unsigned char* ws = args.ws; F.ws = ws; F.out = args.out;
    F.ctl = (gu32*)(ws + WS_CTL);
    F.in = args.in;
    for (int u = F.tid; u < (LDS_BYTES - LDSCTL_OFF) / 4; u += NWAVES * 64) ((LAS unsigned*)(F.lds + LDSCTL_OFF))[u] = 0u;
    __syncthreads();
    XcdBarrier bar; bar.bar = (unsigned*)(F.ctl + CW_BAR); bar.x = 0; bar.st = nullptr; bar.G = 0;
    if (!MK_PER_PHASE) bar = xcd_barrier_post((unsigned*)(F.ctl + CW_BAR), F.MISC + 8, F.tid == 0, gridDim.x);
    const bool use_gbar = !MK_PER_PHASE && F.G == 256;
    XcdBarrier gbar = bar;
    if (use_gbar) gbar = xcd_barrier_post((unsigned*)(F.ctl + CW_BAR) + XCD_BAR_WORDS * (1 + ((int)blockIdx.x & 7)), F.MISC + 10, F.tid == 0, gridDim.x / 8);
#define GROUP_BAR() do { if (use_gbar) xcd_barrier(gbar, F.wave == 0 && fresh_lane() == 0); else GRID_BAR(); } while (0)
#ifdef TBAR
    unsigned long long tbar_acc = 0;
#define GRID_BAR() do { const unsigned long long tq_ = __builtin_amdgcn_s_memrealtime(); xcd_barrier(bar, F.wave == 0 && fresh_lane() == 0); tbar_acc += __builtin_amdgcn_s_memrealtime() - tq_; } while (0)
#else
#define GRID_BAR() do { if (!MK_PER_PHASE) xcd_barrier(bar, F.wave == 0 && fresh_lane() == 0); } while (0)
#endif
    const int lo = args.ph_lo, hi = args.ph_hi;
#ifndef TPH_MASK
#define TPH_MASK 0
#endif
    unsigned long long tph_acc = 0, tph_t0 = 0; int tph_cur = -1; (void)tph_t0; (void)tph_cur;
#define TPH_MARK(k) (TPH_MASK ? (void)((tph_cur >= 0 && ((TPH_MASK >> tph_cur) & 1)) ? (tph_acc += __builtin_amdgcn_s_memrealtime() - tph_t0) : 0ull, tph_cur = (k), tph_t0 = __builtin_amdgcn_s_memrealtime()) : (void)0)
#ifndef TIMB
#define TIMB -1
#endif
    unsigned long long timb_t0 = 0; (void)timb_t0;
#define TIMB_MARK(k) ((TIMB >= 0 && (k) == TIMB) ? (void)(timb_t0 = __builtin_amdgcn_s_memrealtime()) : (void)0)
#define IN(k) (lo <= (k) && (k) < hi && (TPH_MARK(k), TIMB_MARK(k), F.lane = fresh_lane(), F.tid = F.wave * 64 + F.lane, true))
#define BOTH(k) ((TIMB >= 0 && (k) == TIMB) ? (void)((__syncthreads(), F.wave == 0 && fresh_lane() == 0) ? (atomicMax((unsigned*)(ws + WS_CTL) + 24, ~(unsigned)(__builtin_amdgcn_s_memrealtime() - timb_t0)), atomicMax((unsigned*)(ws + WS_CTL) + 25, (unsigned)(__builtin_amdgcn_s_memrealtime() - timb_t0)), 0) : 0) : (void)0, IN(k) && IN((k) + 1))
    bf16* XB = (bf16*)(ws + WS_XB); float* SS = (float*)(ws + WS_SS);
    const int bx = (int)blockIdx.x;

    if (IN(0)) { p0_prologue(F); if (BOTH(0)) GRID_BAR(); }
    if (IN(1)) {
        pg8::Gemm g{XB, (const bf16*)(ws + WS_WIN), T, 3072, DM, 0}; pg8::StaticOrder S; S.init(T, 3072, F.G, bx);
        pg8::EpiWin E{(bf16*)(ws + WS_BG), (bf16*)(ws + WS_V), SS};
        pg8::gemm_phase<pg8::EpiWin, pg8::StaticOrder, true, true>(F.lds + RING_OFF, g, S, E, F.wave);
#ifdef DUP1
        GRID_BAR(); pg8::gemm_phase<pg8::EpiWin, pg8::StaticOrder, true, true>(F.lds + RING_OFF, g, S, E, F.wave);
#endif
        if (BOTH(1)) GRID_BAR(); }
    if (IN(2)) { conv_gate_phase(F); if (BOTH(2)) GROUP_BAR(); }
    if (IN(3)) {
        pg8::Gemm g{(const bf16*)(ws + WS_BG), (const bf16*)(ws + WS_WOUT), T, DM, DM, 0}; pg8::StaticOrder S; S.init(T, DM, F.G, bx);
        pg8::EpiRes E{XB, SS + T};
        pg8::gemm_phase<pg8::EpiRes, pg8::StaticOrder, true, true>(F.lds + RING_OFF, g, S, E, F.wave);
        if (BOTH(3)) GRID_BAR(); }
    if (IN(4)) {
        pg8::Gemm g{XB, (const bf16*)(ws + WS_W1), T, FF, DM, 0}; pg8::StaticOrder S; S.init(T, FF, F.G, bx);
        pg8::EpiRelu2 E{(bf16*)(ws + WS_H), FF, SS + T};
        pg8::gemm_phase<pg8::EpiRelu2, pg8::StaticOrder, true, true>(F.lds + RING_OFF, g, S, E, F.wave);
#ifdef DUP4
        GRID_BAR(); pg8::gemm_phase<pg8::EpiRelu2, pg8::StaticOrder, true, true>(F.lds + RING_OFF, g, S, E, F.wave);
#endif
        if (BOTH(4)) GROUP_BAR(); }
    if (IN(5)) {
        pg8::Gemm g{(const bf16*)(ws + WS_H), (const bf16*)(ws + WS_W2), T, DM, FF, 0}; pg8::StaticOrder S; S.init(T, DM, F.G, bx);
        pg8::EpiRes E{XB, SS + 2 * T};
        pg8::gemm_phase<pg8::EpiRes, pg8::StaticOrder, true, true>(F.lds + RING_OFF, g, S, E, F.wave);
        if (BOTH(5)) GRID_BAR(); }
    if (IN(6)) {
        pg8::Gemm g{XB, (const bf16*)(ws + WS_WKVQ), T, NKVQ - 256, DM, 0}; pg8::StaticOrder S; S.init(T, NKVQ - 256, F.G, bx);
        pg8::EpiKvq E{(bf16*)(ws + WS_KVQ), KVQ_TSTRIDE, SS + 2 * T};
        pg8::gemm_phase<pg8::EpiKvq, pg8::StaticOrder, true, true>(F.lds + RING_OFF, g, S, E, F.wave);
        if (BOTH(6)) GRID_BAR(); }
    if (IN(7)) {
        const int c = F.vcu, side = (c >> 5) & 1;
        if (c < 64 || F.G != 256) {
            pg8::Gemm g{(const bf16*)(ws + WS_KVQ) + (size_t)side * KVQ_TSTRIDE, (const bf16*)(ws + WS_PW1 + (size_t)side * MiB), PHI_ROWS, 256, 2048, 1}; pg8::PhiOrder S{c};
            pg8::EpiPhi E{(bf16*)(ws + WS_PHIH) + (size_t)side * PHI_ROWS * 256, (const float*)(ws + WS_PHIB) + side * 256};
            pg8::gemm_phase<pg8::EpiPhi, pg8::PhiOrder, false, true>(F.lds + RING_OFF, g, S, E, F.wave); }
        if (c >= 64 || F.G != 256) {
            pg8::Gemm g{XB, (const bf16*)(ws + WS_WKVQ), T, NKVQ, DM, 0}; pg8::EpiKvq E{(bf16*)(ws + WS_KVQ), KVQ_TSTRIDE, SS + 2 * T};
            if (F.G == 256) { pg8::GatesOrder S{c}; pg8::gemm_phase<pg8::EpiKvq, pg8::GatesOrder, true, true>(F.lds + RING_OFF, g, S, E, F.wave); }
            else { pg8::GatesAll S{c, F.G}; pg8::gemm_phase<pg8::EpiKvq, pg8::GatesAll, true, true>(F.lds + RING_OFF, g, S, E, F.wave); } }
        if (F.G == 256) { if (c >= 64) { __syncthreads(); vsel_transpose_phase(F, (c - 64) * NWAVES + F.wave, 192 * NWAVES); } }
        else { __syncthreads(); vsel_transpose_phase(F, c * NWAVES + F.wave, F.G * NWAVES); }
        if (BOTH(7)) GRID_BAR(); }
    if (IN(8)) { phi2_phase(F, F.vcu * NWAVES + F.wave, F.G * NWAVES, 2 * (PHI_ROWS / 8)); if (BOTH(8)) GRID_BAR(); }
#ifdef TMIN9
    unsigned long long t9_ = 0;
    if (IN(9)) { t9_ = __builtin_amdgcn_s_memrealtime(); }
#endif
    if (IN(9)) { if (F.G == 256) attn_dense_phase(F); else attn_naive_phase(F, (bf16*)(ws + WS_O));
#ifdef TMIN9
        __syncthreads(); if (F.tid == 0) { const unsigned dt = (unsigned)(__builtin_amdgcn_s_memrealtime() - t9_); atomicMax((unsigned*)(ws + WS_CTL) + 20, ~dt); atomicMax((unsigned*)(ws + WS_CTL) + 21, dt); }
#endif
        if (BOTH(9)) GRID_BAR(); }
    if (IN(10)) {
        pg8::Gemm g{(const bf16*)(ws + WS_O), (const bf16*)(ws + WS_WO), T, DM, DM, 0}; pg8::StaticOrder S; S.init(T, DM, F.G, bx);
        pg8::EpiRes E{XB, SS + 3 * T};
        pg8::gemm_phase<pg8::EpiRes, pg8::StaticOrder, true, true>(F.lds + RING_OFF, g, S, E, F.wave);
        if (BOTH(10)) GROUP_BAR(); }
    if (IN(11)) {
        pg8::Gemm g{XB, (const bf16*)(ws + WS_W1 + 8 * MiB), T, FF, DM, 0}; pg8::StaticOrder S; S.init(T, FF, F.G, bx);
        pg8::EpiRelu2 E{(bf16*)(ws + WS_H), FF, SS + 3 * T};
        pg8::gemm_phase<pg8::EpiRelu2, pg8::StaticOrder, true, true>(F.lds + RING_OFF, g, S, E, F.wave);
        if (BOTH(11)) GROUP_BAR(); }
    if (IN(12)) {
        pg8::Gemm g{(const bf16*)(ws + WS_H), (const bf16*)(ws + WS_W2 + 8 * MiB), T, DM, FF, 0}; pg8::StaticOrder S; S.init(T, DM, F.G, bx);
        pg8::EpiRes E{XB, SS + 4 * T};
        pg8::gemm_phase<pg8::EpiRes, pg8::StaticOrder, true, true>(F.lds + RING_OFF, g, S, E, F.wave);
        if (BOTH(12)) GROUP_BAR(); }
    if (IN(13)) { final_norm_phase(F);
    }
    if (TIMB >= 0) { const unsigned mn = ~((const unsigned*)(ws + WS_CTL))[24], mx = ((const unsigned*)(ws + WS_CTL))[25]; const unsigned long long tb_ = __builtin_amdgcn_s_memrealtime(); while (__builtin_amdgcn_s_memrealtime() - tb_ < (unsigned long long)(mx - mn)) __builtin_amdgcn_s_sleep(4); }
#ifdef TMIN9
    { const unsigned mn = ~((const unsigned*)(ws + WS_CTL))[20]; const unsigned long long tb_ = __builtin_amdgcn_s_memrealtime(); while (__builtin_amdgcn_s_memrealtime() - tb_ < (unsigned long long)mn) __builtin_amdgcn_s_sleep(4); }
#endif
#ifdef TBAR
    { const unsigned long long tb_ = __builtin_amdgcn_s_memrealtime(); while (__builtin_amdgcn_s_memrealtime() - tb_ < tbar_acc) __builtin_amdgcn_s_sleep(4); }
#endif
    if (TPH_MASK) { TPH_MARK(14); const unsigned long long tb_ = __builtin_amdgcn_s_memrealtime(); while (__builtin_amdgcn_s_memrealtime() - tb_ < tph_acc) __builtin_amdgcn_s_sleep(4); }
#undef IN
#undef BOTH
}

extern "C" void kernel_launch(void* const* d_in, const int* in_sizes, int n_in, void* d_out, int out_size, void* d_ws, size_t ws_size, hipStream_t stream) {
    static int grid = 0;
    if (grid == 0) {
        if (n_in != 20 || in_sizes[0] != T * DM || out_size != T * DM || ws_size < WS_END) { fprintf(stderr, "kernel_launch: unexpected shapes (n_in %d, in0 %d, out %d, ws %zu)\n", n_in, n_in > 0 ? in_sizes[0] : -1, out_size, ws_size); grid = -1; return; }
        int dev = 0, cus = 0, per_cu = 0;
        if (hipGetDevice(&dev) != hipSuccess || hipDeviceGetAttribute(&cus, hipDeviceAttributeMultiprocessorCount, dev) != hipSuccess) { grid = -1; return; }
        if (hipFuncSetAttribute((const void*)nsa_fwd, hipFuncAttributeMaxDynamicSharedMemorySize, LDS_BYTES) != hipSuccess) { fprintf(stderr, "kernel_launch: hipFuncSetAttribute failed\n"); grid = -1; return; }
        if (hipOccupancyMaxActiveBlocksPerMultiprocessor(&per_cu, (const void*)nsa_fwd, NWAVES * 64, LDS_BYTES) != hipSuccess || per_cu < 1) fprintf(stderr, "kernel_launch: occupancy query reports %d\n", per_cu);
        (void)hipGetLastError();
        grid = cus;
        if (grid != 256) fprintf(stderr, "kernel_launch: %d CUs (built for 256)\n", grid);
    }
    if (grid < 0) return;
    if (hipMemsetAsync((char*)d_ws + WS_CTL, 0, CTL_ZERO_BYTES, stream) != hipSuccess) return;
    Args a{};
    for (int i = 0; i < 20; ++i) a.in[i] = (const float*)d_in[i];
    a.out = (float*)d_out; a.ws = (unsigned char*)d_ws;
#if MK_PER_PHASE
    for (int p = 0; p < N_PHASES; ++p) { a.ph_lo = p; a.ph_hi = p + 1; a.li = p; hipLaunchKernelGGL(nsa_fwd, dim3(grid), dim3(NWAVES * 64), LDS_BYTES, stream, a); }
#else
    a.ph_lo = 0; a.ph_hi = N_PHASES; a.li = 0;
    hipLaunchKernelGGL(nsa_fwd, dim3(grid), dim3(NWAVES * 64), LDS_BYTES, stream, a);
#endif
}
```
